# Optimizing an MI355X kernel written in HIP

```python
import math
import jax, jax.numpy as jnp
from jax import lax
import numpy as np

D_MODEL = 1024
BATCH = 8
SEQ = 2048
DEPTH = 1

D_MIX = D_MODEL
S5_WIDTH = D_MIX // 2
S5_GROUP = 16
S5_GROUPS = S5_WIDTH // S5_GROUP
S5_STATE = 64
GDN_HEADS = 4
GDN_HEAD_DIM = 128
GDN_WIDTH = GDN_HEADS * GDN_HEAD_DIM
GDN_CONV = 5
GDN_CHUNK = 64
MEM_LEN = 256
XA_HEADS = 4
XA_HEAD_DIM = D_MODEL // XA_HEADS
MOE_GROUPS = 4
MOE_PER_GROUP = 8
MOE_EXPERTS = MOE_GROUPS * MOE_PER_GROUP
MOE_TOPK = 2
D_EXPERT = D_MODEL // 4
RMS_EPS = 1e-6
L2_EPS = 1e-6
IN_SPLITS = (S5_WIDTH, GDN_WIDTH, GDN_WIDTH, GDN_WIDTH, GDN_WIDTH, GDN_HEADS, GDN_HEADS, GDN_HEADS, GDN_HEADS)
D_IN = S5_WIDTH + 4 * GDN_WIDTH + 4 * GDN_HEADS
F32 = jnp.float32

kernel_name = 'hybrid_s5_gdn_memxattn_hiermoe_encoder'


def _rmsnorm(x, gain):
    xf = x.astype(F32)
    y = xf * lax.rsqrt(jnp.mean(xf * xf, axis=-1, keepdims=True) + RMS_EPS)
    return (y * gain.astype(F32)).astype(x.dtype)


def _l2norm(x):
    return x * lax.rsqrt(jnp.sum(x * x, axis=-1, keepdims=True) + L2_EPS)


def _split_cols(h):
    parts, off = [], 0
    for w in IN_SPLITS:
        parts.append(h[..., off:off + w])
        off += w
    return parts


def _s5_scan(u, lam_re, lam_im, log_step, b_re, b_im, c_re, c_im, reverse):
    lam = lax.complex(lam_re.astype(F32), lam_im.astype(F32))
    step = jnp.exp(log_step.astype(F32))[:, None]
    lam_bar = jnp.exp(lam * step)
    b = lax.complex(b_re.astype(F32), b_im.astype(F32))
    b_bar = ((lam_bar - 1.0) / lam)[:, :, None] * b
    bu = jnp.einsum('gpc,bsgc->bsgp', b_bar, u.astype(jnp.complex64))
    a = jnp.broadcast_to(lam_bar[None, None], (1, u.shape[1]) + lam_bar.shape)

    def combine(e1, e2):
        a1, b1 = e1
        a2, b2 = e2
        return a1 * a2, a2 * b1 + b2

    _, h = lax.associative_scan(combine, (a, bu), reverse=reverse, axis=1)
    return (jnp.einsum('bsgp,gcp->bsgc', h.real, c_re.astype(F32))
            - jnp.einsum('bsgp,gcp->bsgc', h.imag, c_im.astype(F32)))


def _s5_mixer(u, lam_re_f, lam_im_f, log_step_f, b_re_f, b_im_f, c_re_f, c_im_f,
              lam_re_b, lam_im_b, log_step_b, b_re_b, b_im_b, c_re_b, c_im_b,
              d, w_glu, b_glu, norm_w):
    bsz, s, _ = u.shape
    uf = u.astype(F32)
    ug = uf.reshape(bsz, s, S5_GROUPS, S5_GROUP)
    y = (_s5_scan(ug, lam_re_f, lam_im_f, log_step_f, b_re_f, b_im_f, c_re_f, c_im_f, False)
         + _s5_scan(ug, lam_re_b, lam_im_b, log_step_b, b_re_b, b_im_b, c_re_b, c_im_b, True))
    y = y.reshape(bsz, s, S5_WIDTH) + d.astype(F32) * uf
    g = jax.nn.gelu(y, approximate=False)
    g = g * jax.nn.sigmoid(g @ w_glu.astype(F32) + b_glu.astype(F32))
    return _rmsnorm(g, norm_w).astype(u.dtype)


def _centred_depthwise_conv(x, w):
    c = x.shape[-1]
    pad = (GDN_CONV - 1) // 2
    return lax.conv_general_dilated(x, w[:, None, :].astype(x.dtype), window_strides=(1,),
                                    padding=[(pad, pad)], dimension_numbers=('NWC', 'WIO', 'NWC'),
                                    feature_group_count=c)


def _gated_delta_chunked(q, k, v, g, beta):
    bsz, s, nh, dk = q.shape
    dv = v.shape[-1]
    n = s // GDN_CHUNK
    q = q * (dk ** -0.5)

    def chunks(t):
        return jnp.transpose(t.reshape(bsz, n, GDN_CHUNK, nh, t.shape[-1]), (0, 3, 1, 2, 4))

    qc, kc, vc = chunks(q), chunks(k), chunks(v)
    bc = chunks(beta[..., None])
    gc = jnp.cumsum(chunks(g[..., None])[..., 0], axis=-1)
    idx = jnp.arange(GDN_CHUNK)
    lower = idx[:, None] >= idx[None, :]
    strict = idx[:, None] > idx[None, :]
    diff = gc[..., :, None] - gc[..., None, :]
    decay = jnp.where(lower, jnp.exp(jnp.where(lower, diff, 0.0)), 0.0)
    k_beta = kc * bc
    v_beta = vc * bc
    l_mat = jnp.where(strict, jnp.einsum('bhncd,bhnsd->bhncs', k_beta, kc) * decay, 0.0)
    u_c = lax.linalg.triangular_solve(l_mat, v_beta, left_side=True, lower=True, unit_diagonal=True)
    w_c = lax.linalg.triangular_solve(l_mat, k_beta * jnp.exp(gc)[..., None], left_side=True,
                                      lower=True, unit_diagonal=True)
    qk = jnp.where(lower, jnp.einsum('bhncd,bhnsd->bhncs', qc, kc) * decay, 0.0)

    def step(state, inp):
        q_i, k_i, u_i, w_i, g_i, qk_i = inp
        v_new = u_i - jnp.einsum('bhcd,bhdv->bhcv', w_i, state)
        o_i = (jnp.einsum('bhcd,bhdv->bhcv', q_i * jnp.exp(g_i)[..., None], state)
               + jnp.einsum('bhcs,bhsv->bhcv', qk_i, v_new))
        g_last = g_i[..., -1]
        state = (state * jnp.exp(g_last)[..., None, None]
                 + jnp.einsum('bhcd,bhcv->bhdv', k_i * jnp.exp(g_last[..., None] - g_i)[..., None], v_new))
        return state, o_i

    xs = tuple(jnp.moveaxis(t, 2, 0) for t in (qc, kc, u_c, w_c, gc, qk))
    state0 = jnp.zeros((bsz, nh, dk, dv), F32)
    _, o = lax.scan(step, state0, xs)
    return jnp.transpose(o, (1, 0, 3, 2, 4)).reshape(bsz, s, nh, dv)


def _gdn_mixer(q, k, v, z, beta_f, beta_b, a_f, a_b, conv_w, a_log_f, dt_bias_f, a_log_b, dt_bias_b, norm_w):
    bsz, s, _ = q.shape
    qkv = jax.nn.silu(_centred_depthwise_conv(jnp.concatenate([q, k, v], axis=-1), conv_w))
    qkv = qkv.astype(F32).reshape(bsz, s, 3, GDN_HEADS, GDN_HEAD_DIM)
    qh = _l2norm(qkv[:, :, 0])
    kh = _l2norm(qkv[:, :, 1])
    vh = qkv[:, :, 2]

    def log_decay(a, a_log, dt_bias):
        return -jnp.exp(a_log.astype(F32)) * jax.nn.softplus(a.astype(F32) + dt_bias.astype(F32))

    g_f = log_decay(a_f, a_log_f, dt_bias_f)
    g_b = log_decay(a_b, a_log_b, dt_bias_b)
    bt_f = jax.nn.sigmoid(beta_f.astype(F32))
    bt_b = jax.nn.sigmoid(beta_b.astype(F32))
    flip = lambda t: jnp.flip(t, axis=1)
    o = (_gated_delta_chunked(qh, kh, vh, g_f, bt_f)
         + flip(_gated_delta_chunked(flip(qh), flip(kh), flip(vh), flip(g_b), flip(bt_b))))
    o = o * lax.rsqrt(jnp.mean(o * o, axis=-1, keepdims=True) + RMS_EPS) * norm_w.astype(F32)
    o = o * jax.nn.silu(z.astype(F32).reshape(bsz, s, GDN_HEADS, GDN_HEAD_DIM))
    return o.reshape(bsz, s, GDN_WIDTH).astype(q.dtype)


def _mem_xattn(xn, memn, wq, wk, wv, wo):
    bsz, s, _ = xn.shape
    m = memn.shape[1]
    q = (xn @ wq).reshape(bsz, s, XA_HEADS, XA_HEAD_DIM)
    k = (memn @ wk).reshape(bsz, m, XA_HEADS, XA_HEAD_DIM)
    v = (memn @ wv).reshape(bsz, m, XA_HEADS, XA_HEAD_DIM)
    sc = jnp.einsum('bshd,bmhd->bhsm', q, k).astype(F32) * (XA_HEAD_DIM ** -0.5)
    p = jax.nn.softmax(sc, axis=-1).astype(v.dtype)
    o = jnp.einsum('bhsm,bmhd->bshd', p, v).reshape(bsz, s, XA_HEADS * XA_HEAD_DIM)
    return o @ wo


def _hier_moe(xn, wg, bg, we, be, w_gate, w_up, w_down):
    bsz, s, d = xn.shape
    t = xn.reshape(bsz * s, d)
    g_logits = (t @ wg).astype(F32) + bg.astype(F32)
    p_top, g_idx = lax.top_k(jax.nn.softmax(g_logits, axis=-1), 1)
    e_logits = ((t @ we).astype(F32) + be.astype(F32)).reshape(-1, MOE_GROUPS, MOE_PER_GROUP)
    e_sel = jnp.take_along_axis(e_logits, g_idx[:, :, None], axis=1)[:, 0]
    e_val, e_idx = lax.top_k(e_sel, MOE_TOPK)
    e_w = jax.nn.softmax(e_val, axis=-1) * p_top
    within = jnp.einsum('tk,tke->te', e_w, jax.nn.one_hot(e_idx, MOE_PER_GROUP, dtype=F32))
    combine = (jax.nn.one_hot(g_idx[:, 0], MOE_GROUPS, dtype=F32)[:, :, None]
               * within[:, None, :]).astype(xn.dtype)
    out = jnp.zeros_like(t)
    for grp in range(MOE_GROUPS):
        sl = slice(grp * MOE_PER_GROUP, (grp + 1) * MOE_PER_GROUP)
        h = (jax.nn.silu(jnp.einsum('td,edf->tef', t, w_gate[sl]))
             * jnp.einsum('td,edf->tef', t, w_up[sl]))
        h = h * combine[:, grp][..., None]
        out = out + jnp.einsum('tef,efd->td', h, w_down[sl])
    return out.reshape(bsz, s, d)


def setup_inputs(seed: int = 0) -> dict:
    key = jax.random.key(seed)
    k = jax.random.split(key, 48)
    L = DEPTH

    def nrm(i, shape, scale):
        return jax.random.normal(k[i], shape, F32) * scale

    def gain(i, shape):
        return 1.0 + nrm(i, shape, 0.02)

    def uni(i, shape, lo, hi):
        return jax.random.uniform(k[i], shape, F32, minval=lo, maxval=hi)

    n_idx = jnp.arange(S5_STATE, dtype=F32)
    dt_f = jnp.exp(uni(25, (L, GDN_HEADS), math.log(1e-3), math.log(1e-1)))
    dt_b = jnp.exp(uni(27, (L, GDN_HEADS), math.log(1e-3), math.log(1e-1)))
    return {
        'x': nrm(0, (BATCH, SEQ, D_MODEL), 1.0),
        'mem': nrm(1, (BATCH, MEM_LEN, D_MODEL), 1.0),
        'norm_mix': gain(2, (L, D_MODEL)),
        'w_in': nrm(3, (L, D_MODEL, D_IN), D_MODEL ** -0.5),
        'w_out': nrm(4, (L, D_MIX, D_MODEL), D_MIX ** -0.5),
        's5_lam_re_f': -0.5 + nrm(5, (L, S5_GROUPS, S5_STATE), 0.01),
        's5_lam_im_f': math.pi * n_idx + nrm(6, (L, S5_GROUPS, S5_STATE), 0.01),
        's5_log_step_f': uni(7, (L, S5_GROUPS), math.log(1e-3), math.log(1e-1)),
        's5_b_re_f': nrm(8, (L, S5_GROUPS, S5_STATE, S5_GROUP), (2 * S5_GROUP) ** -0.5),
        's5_b_im_f': nrm(9, (L, S5_GROUPS, S5_STATE, S5_GROUP), (2 * S5_GROUP) ** -0.5),
        's5_c_re_f': nrm(10, (L, S5_GROUPS, S5_GROUP, S5_STATE), S5_STATE ** -0.5),
        's5_c_im_f': nrm(11, (L, S5_GROUPS, S5_GROUP, S5_STATE), S5_STATE ** -0.5),
        's5_lam_re_b': -0.5 + nrm(12, (L, S5_GROUPS, S5_STATE), 0.01),
        's5_lam_im_b': math.pi * n_idx + nrm(13, (L, S5_GROUPS, S5_STATE), 0.01),
        's5_log_step_b': uni(14, (L, S5_GROUPS), math.log(1e-3), math.log(1e-1)),
        's5_b_re_b': nrm(15, (L, S5_GROUPS, S5_STATE, S5_GROUP), (2 * S5_GROUP) ** -0.5),
        's5_b_im_b': nrm(16, (L, S5_GROUPS, S5_STATE, S5_GROUP), (2 * S5_GROUP) ** -0.5),
        's5_c_re_b': nrm(17, (L, S5_GROUPS, S5_GROUP, S5_STATE), S5_STATE ** -0.5),
        's5_c_im_b': nrm(18, (L, S5_GROUPS, S5_GROUP, S5_STATE), S5_STATE ** -0.5),
        's5_d': nrm(19, (L, S5_WIDTH), 1.0),
        's5_w_glu': nrm(20, (L, S5_WIDTH, S5_WIDTH), S5_WIDTH ** -0.5),
        's5_b_glu': nrm(21, (L, S5_WIDTH), 0.02),
        's5_norm': gain(22, (L, S5_WIDTH)),
        'gdn_conv': nrm(23, (L, GDN_CONV, 3 * GDN_WIDTH), GDN_CONV ** -0.5),
        'gdn_a_log_f': jnp.log(uni(24, (L, GDN_HEADS), 1.0, 16.0)),
        'gdn_dt_bias_f': dt_f + jnp.log(-jnp.expm1(-dt_f)),
        'gdn_a_log_b': jnp.log(uni(26, (L, GDN_HEADS), 1.0, 16.0)),
        'gdn_dt_bias_b': dt_b + jnp.log(-jnp.expm1(-dt_b)),
        'gdn_norm': gain(28, (L, GDN_HEAD_DIM)),
        'norm_xattn': gain(29, (L, D_MODEL)),
        'norm_mem': gain(30, (L, D_MODEL)),
        'xa_wq': nrm(31, (L, D_MODEL, XA_HEADS * XA_HEAD_DIM), D_MODEL ** -0.5),
        'xa_wk': nrm(32, (L, D_MODEL, XA_HEADS * XA_HEAD_DIM), D_MODEL ** -0.5),
        'xa_wv': nrm(33, (L, D_MODEL, XA_HEADS * XA_HEAD_DIM), D_MODEL ** -0.5),
        'xa_wo': nrm(34, (L, XA_HEADS * XA_HEAD_DIM, D_MODEL), D_MODEL ** -0.5),
        'norm_moe': gain(35, (L, D_MODEL)),
        'router_group_w': nrm(36, (L, D_MODEL, MOE_GROUPS), D_MODEL ** -0.5),
        'router_group_b': nrm(37, (L, MOE_GROUPS), 0.01),
        'router_expert_w': nrm(38, (L, D_MODEL, MOE_EXPERTS), D_MODEL ** -0.5),
        'router_expert_b': nrm(39, (L, MOE_EXPERTS), 0.01),
        'moe_w_gate': nrm(40, (L, MOE_EXPERTS, D_MODEL, D_EXPERT), D_MODEL ** -0.5),
        'moe_w_up': nrm(41, (L, MOE_EXPERTS, D_MODEL, D_EXPERT), D_MODEL ** -0.5),
        'moe_w_down': nrm(42, (L, MOE_EXPERTS, D_EXPERT, D_MODEL), D_EXPERT ** -0.5),
        'norm_final': gain(43, (D_MODEL,)),
    }


def reference(x, mem, norm_mix, w_in, w_out,
              s5_lam_re_f, s5_lam_im_f, s5_log_step_f, s5_b_re_f, s5_b_im_f, s5_c_re_f, s5_c_im_f,
              s5_lam_re_b, s5_lam_im_b, s5_log_step_b, s5_b_re_b, s5_b_im_b, s5_c_re_b, s5_c_im_b,
              s5_d, s5_w_glu, s5_b_glu, s5_norm,
              gdn_conv, gdn_a_log_f, gdn_dt_bias_f, gdn_a_log_b, gdn_dt_bias_b, gdn_norm,
              norm_xattn, norm_mem, xa_wq, xa_wk, xa_wv, xa_wo,
              norm_moe, router_group_w, router_group_b, router_expert_w, router_expert_b,
              moe_w_gate, moe_w_up, moe_w_down, norm_final):
    for l in range(DEPTH):
        h = _rmsnorm(x, norm_mix[l])
        u, q, k, v, z, beta_f, beta_b, a_f, a_b = _split_cols(h @ w_in[l])
        y_s5 = _s5_mixer(u, s5_lam_re_f[l], s5_lam_im_f[l], s5_log_step_f[l], s5_b_re_f[l], s5_b_im_f[l],
                         s5_c_re_f[l], s5_c_im_f[l], s5_lam_re_b[l], s5_lam_im_b[l], s5_log_step_b[l],
                         s5_b_re_b[l], s5_b_im_b[l], s5_c_re_b[l], s5_c_im_b[l],
                         s5_d[l], s5_w_glu[l], s5_b_glu[l], s5_norm[l])
        y_gdn = _gdn_mixer(q, k, v, z, beta_f, beta_b, a_f, a_b, gdn_conv[l], gdn_a_log_f[l], gdn_dt_bias_f[l],
                           gdn_a_log_b[l], gdn_dt_bias_b[l], gdn_norm[l])
        x = x + jnp.concatenate([y_s5, y_gdn], axis=-1) @ w_out[l]
        x = x + _mem_xattn(_rmsnorm(x, norm_xattn[l]), _rmsnorm(mem, norm_mem[l]),
                           xa_wq[l], xa_wk[l], xa_wv[l], xa_wo[l])
        x = x + _hier_moe(_rmsnorm(x, norm_moe[l]), router_group_w[l], router_group_b[l],
                          router_expert_w[l], router_expert_b[l], moe_w_gate[l], moe_w_up[l], moe_w_down[l])
    return _rmsnorm(x, norm_final)
```

```cpp
#include <hip/hip_runtime.h>
#include <cstdio>
#include <cstdint>

typedef unsigned short bf16_t;
__device__ __forceinline__ float bf2f(bf16_t v) { return __uint_as_float(((unsigned)v) << 16); }
__device__ __forceinline__ bf16_t f2bf(float f) { unsigned u = __float_as_uint(f); return (bf16_t)((u + 0x7fffu + ((u >> 16) & 1u)) >> 16); }

constexpr int B_ = 8, S_ = 2048, T_ = B_ * S_, D_ = 1024, DIN = 2576;
constexpr int S5W = 512, NG = 32, NP = 64, GDW = 512, NH = 4, HD = 128, MEM = 256;
constexpr int XH = 4, XD = 256, NE = 32, DE = 256;
constexpr float RMS_EPS = 1e-6f, L2_EPS = 1e-6f;
constexpr int NT = 256;

struct Params {
    const float* in[48];
    float* out;
    unsigned char* ws;
};
enum { I_X = 0, I_MEM, I_NORM_MIX, I_W_IN, I_W_OUT,
       I_LAM_RE_F, I_LAM_IM_F, I_LOG_STEP_F, I_B_RE_F, I_B_IM_F, I_C_RE_F, I_C_IM_F,
       I_LAM_RE_B, I_LAM_IM_B, I_LOG_STEP_B, I_B_RE_B, I_B_IM_B, I_C_RE_B, I_C_IM_B,
       I_S5_D, I_W_GLU, I_B_GLU, I_S5_NORM,
       I_CONV, I_ALOG_F, I_DTB_F, I_ALOG_B, I_DTB_B, I_GDN_NORM,
       I_NORM_XA, I_NORM_MEM, I_WQ, I_WK, I_WV, I_WO,
       I_NORM_MOE, I_RG_W, I_RG_B, I_RE_W, I_RE_B, I_WGATE, I_WUP, I_WDOWN, I_NORM_FINAL, N_IN };

constexpr size_t MiB = 1u << 20;
constexpr size_t WS_HB   = 0;
constexpr size_t WS_PROJ = 32 * MiB;
constexpr size_t WS_QKVC = 112 * MiB;
constexpr size_t WS_YF   = 160 * MiB;
constexpr size_t WS_CAT  = 224 * MiB;
constexpr size_t OUT_BA = 0;
constexpr size_t OUT_GB = 1 * MiB;
constexpr size_t WS_KMEM = WS_YF;
constexpr size_t WS_VMEM = WS_YF + 8 * MiB;
constexpr size_t WS_MEMN = WS_YF + 16 * MiB;
constexpr size_t WS_ROUTE = WS_YF + 24 * MiB;
constexpr size_t WS_QB   = WS_PROJ;
constexpr size_t WS_OB   = WS_PROJ + 32 * MiB;
constexpr size_t WS_HMID = WS_QKVC;
constexpr int PROJ_LD = 2560;

__device__ __forceinline__ float wave_sum(float v) {
#pragma unroll
    for (int o = 32; o > 0; o >>= 1) v += __shfl_xor(v, o);
    return v;
}
__device__ __forceinline__ float sigmoidf_(float x) { return 1.f / (1.f + __expf(-x)); }
__device__ __forceinline__ float siluf_(float x) { return x * sigmoidf_(x); }
__device__ __forceinline__ float softplusf_(float x) { return x > 20.f ? x : log1pf(__expf(x)); }
__device__ __forceinline__ float geluf_(float x) { return 0.5f * x * (1.f + erff(x * 0.70710678118654752f)); }

template <class TA> __device__ __forceinline__ float ldA(const TA* p);
template <> __device__ __forceinline__ float ldA<float>(const float* p) { return *p; }
template <> __device__ __forceinline__ float ldA<bf16_t>(const bf16_t* p) { return bf2f(*p); }

template <class TA, class Epi>
__device__ void sgemm_phase(const TA* A, int lda, const float* W, int ldw, int M, int N, int K, float* smem, Epi epi) {
    float (*As)[68] = (float (*)[68])smem;
    float (*Ws)[68] = (float (*)[68])(smem + 16 * 68);
    const int tid = threadIdx.x, tx = tid & 15, ty = tid >> 4;
    const int tilesN = (N + 63) / 64, tilesM = M / 64, nt = tilesM * tilesN;
    for (int tile = blockIdx.x; tile < nt; tile += gridDim.x) {
        const int tm = tile / tilesN, tn = tile % tilesN, m0 = tm * 64, n0 = tn * 64;
        float acc[4][4];
#pragma unroll
        for (int i = 0; i < 4; ++i)
#pragma unroll
            for (int j = 0; j < 4; ++j) acc[i][j] = 0.f;
        for (int k0 = 0; k0 < K; k0 += 16) {
#pragma unroll
            for (int i = 0; i < 4; ++i) { const int e = tid + i * 256, r = e >> 4, kk = e & 15; As[kk][r] = ldA<TA>(A + (size_t)(m0 + r) * lda + k0 + kk); }
#pragma unroll
            for (int i = 0; i < 4; ++i) { const int e = tid + i * 256, kk = e >> 6, c = e & 63; Ws[kk][c] = (n0 + c < N) ? W[(size_t)(k0 + kk) * ldw + n0 + c] : 0.f; }
            __syncthreads();
#pragma unroll
            for (int kk = 0; kk < 16; ++kk) {
                float a[4], b[4];
#pragma unroll
                for (int i = 0; i < 4; ++i) a[i] = As[kk][ty * 4 + i];
#pragma unroll
                for (int j = 0; j < 4; ++j) b[j] = Ws[kk][tx * 4 + j];
#pragma unroll
                for (int i = 0; i < 4; ++i)
#pragma unroll
                    for (int j = 0; j < 4; ++j) acc[i][j] = fmaf(a[i], b[j], acc[i][j]);
            }
            __syncthreads();
        }
#pragma unroll
        for (int i = 0; i < 4; ++i)
#pragma unroll
            for (int j = 0; j < 4; ++j) { const int r = m0 + ty * 4 + i, c = n0 + tx * 4 + j; if (c < N) epi(r, c, acc[i][j]); }
    }
}

__device__ void rmsnorm_rows_bf16(const float* X, const float* gain, bf16_t* Y, int rows, int width) {
    const int lane = threadIdx.x & 63, gw = blockIdx.x * (NT / 64) + (threadIdx.x >> 6), nw = gridDim.x * (NT / 64);
    for (int r = gw; r < rows; r += nw) {
        const float* x = X + (size_t)r * width; float ss = 0.f;
        for (int c = lane; c < width; c += 64) { const float v = x[c]; ss += v * v; }
        const float rs = rsqrtf(wave_sum(ss) / (float)width + RMS_EPS);
        for (int c = lane; c < width; c += 64) Y[(size_t)r * width + c] = f2bf(x[c] * rs * gain[c]);
    }
}

__device__ void ph_norm1(const Params& p, float* smem) {
    rmsnorm_rows_bf16(p.in[I_X], p.in[I_NORM_MIX], (bf16_t*)(p.ws + WS_HB), T_, D_);
}
__device__ void ph_memnorm(const Params& p, float* smem) {
    rmsnorm_rows_bf16(p.in[I_MEM], p.in[I_NORM_MEM], (bf16_t*)(p.ws + WS_MEMN), B_ * MEM, D_);
}
__device__ void ph_inproj(const Params& p, float* smem) {
    bf16_t* proj = (bf16_t*)(p.ws + WS_PROJ); float* ba = (float*)((unsigned char*)p.out + OUT_BA);
    sgemm_phase<bf16_t>((const bf16_t*)(p.ws + WS_HB), D_, p.in[I_W_IN], DIN, T_, DIN, D_, smem,
        [=](int r, int c, float v) { if (c < 2560) proj[(size_t)r * PROJ_LD + c] = f2bf(v); else ba[(size_t)r * 16 + (c - 2560)] = v; });
}
__device__ void ph_kv(const Params& p, float* smem) {
    float* km = (float*)(p.ws + WS_KMEM); float* vm = (float*)(p.ws + WS_VMEM);
    sgemm_phase<bf16_t>((const bf16_t*)(p.ws + WS_MEMN), D_, p.in[I_WK], D_, B_ * MEM, D_, D_, smem, [=](int r, int c, float v) { km[(size_t)r * D_ + c] = v; });
    sgemm_phase<bf16_t>((const bf16_t*)(p.ws + WS_MEMN), D_, p.in[I_WV], D_, B_ * MEM, D_, D_, smem, [=](int r, int c, float v) { vm[(size_t)r * D_ + c] = v; });
}

__device__ void ph_s5scan(const Params& p, float* smem) {
    const int lane = threadIdx.x & 63, wv = threadIdx.x >> 6;
    float* red = smem + wv * (16 * 65);
    const bf16_t* proj = (const bf16_t*)(p.ws + WS_PROJ);
    float* Y = (float*)(p.ws + WS_YF);
    const int gw = blockIdx.x * 4 + wv, nw = gridDim.x * 4;
    for (int item = gw; item < B_ * NG * 2; item += nw) {
        const int dir = item & 1, g = (item >> 1) % NG, b = item / (2 * NG);
        const int o = dir ? (I_LAM_RE_B - I_LAM_RE_F) : 0;
        const float lre = p.in[I_LAM_RE_F + o][g * NP + lane], lim = p.in[I_LAM_IM_F + o][g * NP + lane];
        const float step = __expf(p.in[I_LOG_STEP_F + o][g]);
        const float er = expf(lre * step); float sn, cs; sincosf(lim * step, &sn, &cs);
        const float lbr = er * cs, lbi = er * sn;
        const float nr = lbr - 1.f, ni = lbi, den = lre * lre + lim * lim;
        const float cr = (nr * lre + ni * lim) / den, ci = (ni * lre - nr * lim) / den;
        float Br[16], Bi[16], Cr[16], Ci[16];
#pragma unroll
        for (int c = 0; c < 16; ++c) {
            const float br = p.in[I_B_RE_F + o][(g * NP + lane) * 16 + c], bi = p.in[I_B_IM_F + o][(g * NP + lane) * 16 + c];
            Br[c] = cr * br - ci * bi; Bi[c] = cr * bi + ci * br;
            Cr[c] = p.in[I_C_RE_F + o][(g * 16 + c) * NP + lane]; Ci[c] = p.in[I_C_IM_F + o][(g * 16 + c) * NP + lane];
        }
        float hr = 0.f, hi = 0.f;
        float* Yd = Y + (size_t)dir * T_ * S5W;
        for (int s = 0; s < S_; ++s) {
            const int t = b * S_ + (dir ? (S_ - 1 - s) : s);
            const bf16_t* up = proj + (size_t)t * PROJ_LD + g * 16;
            float bur = 0.f, bui = 0.f;
#pragma unroll
            for (int c = 0; c < 16; ++c) { const float u = bf2f(up[c]); bur = fmaf(Br[c], u, bur); bui = fmaf(Bi[c], u, bui); }
            const float nhr = lbr * hr - lbi * hi + bur, nhi = lbr * hi + lbi * hr + bui; hr = nhr; hi = nhi;
#pragma unroll
            for (int c = 0; c < 16; ++c) red[c * 65 + lane] = Cr[c] * hr - Ci[c] * hi;
            __builtin_amdgcn_s_waitcnt(0xc07f);
            {
                const int c = lane >> 2, q = lane & 3; float sacc = 0.f;
#pragma unroll
                for (int k = 0; k < 16; ++k) sacc += red[c * 65 + q * 16 + k];
                sacc += __shfl_xor(sacc, 1); sacc += __shfl_xor(sacc, 2);
                if (q == 0) Yd[(size_t)t * S5W + g * 16 + c] = sacc;
            }
            __builtin_amdgcn_s_waitcnt(0xc07f);
        }
    }
}
__device__ void ph_s5gelu(const Params& p, float* smem) {
    float* Y = (float*)(p.ws + WS_YF); const bf16_t* proj = (const bf16_t*)(p.ws + WS_PROJ); const float* d = p.in[I_S5_D];
    const size_t n = (size_t)T_ * S5W;
    for (size_t i = (size_t)blockIdx.x * NT + threadIdx.x; i < n; i += (size_t)gridDim.x * NT) {
        const int t = (int)(i / S5W), c = (int)(i % S5W);
        const float y = Y[i] + Y[n + i] + d[c] * bf2f(proj[(size_t)t * PROJ_LD + c]);
        Y[i] = geluf_(y);
    }
}
__device__ void ph_s5glu(const Params& p, float* smem) {
    const float* gl = (const float*)(p.ws + WS_YF); float* gg = (float*)(p.ws + WS_YF) + (size_t)T_ * S5W; const float* bg = p.in[I_B_GLU];
    sgemm_phase<float>(gl, S5W, p.in[I_W_GLU], S5W, T_, S5W, S5W, smem,
        [=](int r, int c, float v) { gg[(size_t)r * S5W + c] = gl[(size_t)r * S5W + c] * sigmoidf_(v + bg[c]); });
}
__device__ void ph_s5norm(const Params& p, float* smem) {
    const float* gg = (const float*)(p.ws + WS_YF) + (size_t)T_ * S5W; bf16_t* cat = (bf16_t*)(p.ws + WS_CAT); const float* gn = p.in[I_S5_NORM];
    const int lane = threadIdx.x & 63, gw = blockIdx.x * 4 + (threadIdx.x >> 6), nw = gridDim.x * 4;
    for (int r = gw; r < T_; r += nw) {
        const float* x = gg + (size_t)r * S5W; float v[8]; float ss = 0.f;
#pragma unroll
        for (int j = 0; j < 8; ++j) { v[j] = x[lane + 64 * j]; ss += v[j] * v[j]; }
        const float rs = rsqrtf(wave_sum(ss) / (float)S5W + RMS_EPS);
#pragma unroll
        for (int j = 0; j < 8; ++j) cat[(size_t)r * D_ + lane + 64 * j] = f2bf(v[j] * rs * gn[lane + 64 * j]);
    }
}

__device__ void ph_gdnprep(const Params& p, float* smem) {
    const bf16_t* proj = (const bf16_t*)(p.ws + WS_PROJ); bf16_t* qkvc = (bf16_t*)(p.ws + WS_QKVC);
    const float* cw = p.in[I_CONV]; const float* ba = (const float*)((unsigned char*)p.out + OUT_BA); float* gb = (float*)((unsigned char*)p.out + OUT_GB);
    const int tid = threadIdx.x, wv = tid >> 6;
    for (int t = blockIdx.x; t < T_; t += gridDim.x) {
        const int s = t % S_;
        float v[6];
#pragma unroll
        for (int j = 0; j < 6; ++j) {
            const int ch = tid + 256 * j; float a = 0.f;
#pragma unroll
            for (int k = 0; k < 5; ++k) { const int ss = s + k - 2; if (ss >= 0 && ss < S_) a = fmaf(cw[k * 1536 + ch], bf2f(proj[(size_t)(t + k - 2) * PROJ_LD + 512 + ch]), a); }
            v[j] = siluf_(a);
        }
#pragma unroll
        for (int j = 0; j < 4; ++j) { const float s2 = wave_sum(v[j] * v[j]); if ((tid & 63) == 0) smem[j * 4 + wv] = s2; }
        __syncthreads();
#pragma unroll
        for (int j = 0; j < 4; ++j) {
            const float tot = smem[j * 4 + (wv & 2)] + smem[j * 4 + (wv & 2) + 1];
            float sc = rsqrtf(tot + L2_EPS); if (j < 2) sc *= 0.08838834764831845f;
            v[j] *= sc;
        }
#pragma unroll
        for (int j = 0; j < 6; ++j) qkvc[(size_t)t * 1536 + tid + 256 * j] = f2bf(v[j]);
        if (tid < 16) {
            const float r = ba[(size_t)t * 16 + tid]; float o;
            if (tid < 8) o = sigmoidf_(r);
            else { const int h = tid & 3; const bool bw = tid >= 12; const float alog = p.in[bw ? I_ALOG_B : I_ALOG_F][h], dtb = p.in[bw ? I_DTB_B : I_DTB_F][h]; o = -__expf(alog) * softplusf_(r + dtb); }
            gb[(size_t)t * 16 + tid] = o;
        }
        __syncthreads();
    }
}
__device__ void ph_gdnrec(const Params& p, float* smem) {
    const bf16_t* qkvc = (const bf16_t*)(p.ws + WS_QKVC); const float* gb = (const float*)((unsigned char*)p.out + OUT_GB);
    float* O = (float*)(p.ws + WS_YF);
    const int half = threadIdx.x >> 7, j = threadIdx.x & 127;
    float* kq = smem + half * 256;
    for (int it0 = blockIdx.x * 2; it0 < B_ * NH * 2; it0 += gridDim.x * 2) {
        const int item = it0 + half; const int dir = item & 1, h = (item >> 1) % NH, b = item / (2 * NH);
        float Sc[128];
#pragma unroll
        for (int d = 0; d < 128; ++d) Sc[d] = 0.f;
        float* Od = O + (size_t)dir * T_ * GDW;
        for (int s = 0; s < S_; ++s) {
            const int t = b * S_ + (dir ? (S_ - 1 - s) : s);
            const bf16_t* row = qkvc + (size_t)t * 1536 + h * 128;
            kq[j] = bf2f(row[512 + j]); kq[128 + j] = bf2f(row[j]);
            const float vv = bf2f(row[1024 + j]);
            const float beta = gb[(size_t)t * 16 + dir * 4 + h], g = gb[(size_t)t * 16 + 8 + dir * 4 + h];
            __syncthreads();
            const float e = __expf(g);
            float dot = 0.f;
#pragma unroll
            for (int d = 0; d < 128; ++d) dot = fmaf(Sc[d], kq[d], dot);
            const float vn = beta * (vv - e * dot);
            float o = 0.f;
#pragma unroll
            for (int d = 0; d < 128; ++d) { Sc[d] = fmaf(kq[d], vn, e * Sc[d]); o = fmaf(Sc[d], kq[128 + d], o); }
            Od[(size_t)t * GDW + h * 128 + j] = o;
            __syncthreads();
        }
    }
}
__device__ void ph_gdncomb(const Params& p, float* smem) {
    const float* O = (const float*)(p.ws + WS_YF); const bf16_t* proj = (const bf16_t*)(p.ws + WS_PROJ); bf16_t* cat = (bf16_t*)(p.ws + WS_CAT); const float* gn = p.in[I_GDN_NORM];
    const int lane = threadIdx.x & 63, gw = blockIdx.x * 4 + (threadIdx.x >> 6), nw = gridDim.x * 4;
    for (int it = gw; it < T_ * NH; it += nw) {
        const int t = it / NH, h = it % NH; const size_t base = (size_t)t * GDW + h * 128;
        const float a0 = O[base + lane] + O[(size_t)T_ * GDW + base + lane], a1 = O[base + 64 + lane] + O[(size_t)T_ * GDW + base + 64 + lane];
        const float rs = rsqrtf(wave_sum(a0 * a0 + a1 * a1) / 128.f + RMS_EPS);
        const float z0 = bf2f(proj[(size_t)t * PROJ_LD + 2048 + h * 128 + lane]), z1 = bf2f(proj[(size_t)t * PROJ_LD + 2048 + h * 128 + 64 + lane]);
        cat[(size_t)t * D_ + 512 + h * 128 + lane] = f2bf(a0 * rs * gn[lane] * siluf_(z0));
        cat[(size_t)t * D_ + 512 + h * 128 + 64 + lane] = f2bf(a1 * rs * gn[64 + lane] * siluf_(z1));
    }
}
__device__ void ph_outproj(const Params& p, float* smem) {
    const float* x = p.in[I_X]; float* out = p.out;
    sgemm_phase<bf16_t>((const bf16_t*)(p.ws + WS_CAT), D_, p.in[I_W_OUT], D_, T_, D_, D_, smem,
        [=](int r, int c, float v) { out[(size_t)r * D_ + c] = x[(size_t)r * D_ + c] + v; });
}
__device__ void ph_norm2(const Params& p, float* smem) { rmsnorm_rows_bf16(p.out, p.in[I_NORM_XA], (bf16_t*)(p.ws + WS_HB), T_, D_); }
__device__ void ph_qproj(const Params& p, float* smem) {
    bf16_t* qb = (bf16_t*)(p.ws + WS_QB);
    sgemm_phase<bf16_t>((const bf16_t*)(p.ws + WS_HB), D_, p.in[I_WQ], D_, T_, D_, D_, smem, [=](int r, int c, float v) { qb[(size_t)r * D_ + c] = f2bf(v); });
}
__device__ void ph_attn(const Params& p, float* smem) {
    const bf16_t* qb = (const bf16_t*)(p.ws + WS_QB); const float* km = (const float*)(p.ws + WS_KMEM); const float* vm = (const float*)(p.ws + WS_VMEM); bf16_t* ob = (bf16_t*)(p.ws + WS_OB);
    const int lane = threadIdx.x & 63, wv = threadIdx.x >> 6;
    float* qs = smem + wv * 512;
    const int gw = blockIdx.x * 4 + wv, nw = gridDim.x * 4;
    for (int it = gw; it < T_ * XH; it += nw) {
        const int t = it / XH, h = it % XH, b = t / S_;
#pragma unroll
        for (int j = 0; j < 4; ++j) qs[lane + 64 * j] = bf2f(qb[(size_t)t * D_ + h * XD + lane + 64 * j]);
        __builtin_amdgcn_s_waitcnt(0xc07f);
        float sc[4]; float mx = -1e30f;
#pragma unroll
        for (int j = 0; j < 4; ++j) {
            const float* kr = km + (size_t)(b * MEM + lane + 64 * j) * D_ + h * XD; float a = 0.f;
            for (int d = 0; d < XD; ++d) a = fmaf(qs[d], kr[d], a);
            sc[j] = a * 0.0625f; mx = fmaxf(mx, sc[j]);
        }
#pragma unroll
        for (int o = 32; o > 0; o >>= 1) mx = fmaxf(mx, __shfl_xor(mx, o));
        float sum = 0.f;
#pragma unroll
        for (int j = 0; j < 4; ++j) { sc[j] = __expf(sc[j] - mx); sum += sc[j]; }
        sum = wave_sum(sum); const float inv = 1.f / sum;
#pragma unroll
        for (int j = 0; j < 4; ++j) qs[256 + lane + 64 * j] = sc[j] * inv;
        __builtin_amdgcn_s_waitcnt(0xc07f);
        float o[4] = {0.f, 0.f, 0.f, 0.f};
        for (int m = 0; m < MEM; ++m) {
            const float pm = qs[256 + m]; const float* vr = vm + (size_t)(b * MEM + m) * D_ + h * XD;
#pragma unroll
            for (int j = 0; j < 4; ++j) o[j] = fmaf(pm, vr[lane + 64 * j], o[j]);
        }
#pragma unroll
        for (int j = 0; j < 4; ++j) ob[(size_t)t * D_ + h * XD + lane + 64 * j] = f2bf(o[j]);
        __builtin_amdgcn_s_waitcnt(0xc07f);
    }
}
__device__ void ph_woproj(const Params& p, float* smem) {
    float* out = p.out;
    sgemm_phase<bf16_t>((const bf16_t*)(p.ws + WS_OB), D_, p.in[I_WO], D_, T_, D_, D_, smem, [=](int r, int c, float v) { out[(size_t)r * D_ + c] += v; });
}
__device__ void ph_router(const Params& p, float* smem) {
    const float* x2 = p.out; bf16_t* hb = (bf16_t*)(p.ws + WS_HB); int* route = (int*)(p.ws + WS_ROUTE);
    const float* gn = p.in[I_NORM_MOE]; const float* wg = p.in[I_RG_W]; const float* bg = p.in[I_RG_B]; const float* we = p.in[I_RE_W]; const float* be = p.in[I_RE_B];
    const int lane = threadIdx.x & 63, gw = blockIdx.x * 4 + (threadIdx.x >> 6), nw = gridDim.x * 4;
    for (int t = gw; t < T_; t += nw) {
        float xv[16]; float ss = 0.f;
#pragma unroll
        for (int j = 0; j < 16; ++j) { xv[j] = x2[(size_t)t * D_ + lane + 64 * j]; ss += xv[j] * xv[j]; }
        const float rs = rsqrtf(wave_sum(ss) / (float)D_ + RMS_EPS);
#pragma unroll
        for (int j = 0; j < 16; ++j) { xv[j] = xv[j] * rs * gn[lane + 64 * j]; hb[(size_t)t * D_ + lane + 64 * j] = f2bf(xv[j]); }
        float gl[4];
#pragma unroll
        for (int g = 0; g < 4; ++g) { float a = 0.f;
#pragma unroll
            for (int j = 0; j < 16; ++j) a = fmaf(xv[j], wg[(size_t)(lane + 64 * j) * 4 + g], a);
            gl[g] = wave_sum(a) + bg[g]; }
        int gi = 0; float gm = gl[0];
#pragma unroll
        for (int g = 1; g < 4; ++g) if (gl[g] > gm) { gm = gl[g]; gi = g; }
        float gs = 0.f;
#pragma unroll
        for (int g = 0; g < 4; ++g) gs += __expf(gl[g] - gm);
        const float ptop = 1.f / gs;
        float el[8];
#pragma unroll
        for (int e = 0; e < 8; ++e) { float a = 0.f;
#pragma unroll
            for (int j = 0; j < 16; ++j) a = fmaf(xv[j], we[(size_t)(lane + 64 * j) * NE + gi * 8 + e], a);
            el[e] = wave_sum(a) + be[gi * 8 + e]; }
        int i0 = 0; float v0 = el[0];
#pragma unroll
        for (int e = 1; e < 8; ++e) if (el[e] > v0) { v0 = el[e]; i0 = e; }
        int i1 = -1; float v1 = -1e30f;
#pragma unroll
        for (int e = 0; e < 8; ++e) if (e != i0 && el[e] > v1) { v1 = el[e]; i1 = e; }
        const float e1 = __expf(v1 - v0), w0 = ptop / (1.f + e1), w1 = ptop * e1 / (1.f + e1);
        if (lane == 0) { route[(size_t)t * 4 + 0] = gi * 8 + i0; route[(size_t)t * 4 + 1] = gi * 8 + i1; ((float*)route)[(size_t)t * 4 + 2] = w0; ((float*)route)[(size_t)t * 4 + 3] = w1; }
    }
}
__device__ void ph_moeup(const Params& p, float* smem) {
    const bf16_t* hb = (const bf16_t*)(p.ws + WS_HB); const int* route = (const int*)(p.ws + WS_ROUTE); float* hmid = (float*)(p.ws + WS_HMID);
    const int lane = threadIdx.x & 63, wv = threadIdx.x >> 6; float* xs = smem + wv * 1024;
    const int gw = blockIdx.x * 4 + wv, nw = gridDim.x * 4;
    for (int it = gw; it < T_ * 2; it += nw) {
        const int t = it >> 1, sl = it & 1; const int e = route[(size_t)t * 4 + sl]; const float w = ((const float*)route)[(size_t)t * 4 + 2 + sl];
#pragma unroll
        for (int j = 0; j < 16; ++j) xs[lane + 64 * j] = bf2f(hb[(size_t)t * D_ + lane + 64 * j]);
        __builtin_amdgcn_s_waitcnt(0xc07f);
        const float4* Wg = (const float4*)(p.in[I_WGATE] + (size_t)e * D_ * DE) + lane; const float4* Wu = (const float4*)(p.in[I_WUP] + (size_t)e * D_ * DE) + lane;
        float4 ag = {0.f, 0.f, 0.f, 0.f}, au = {0.f, 0.f, 0.f, 0.f};
        for (int k = 0; k < D_; ++k) { const float xk = xs[k]; const float4 a = Wg[(size_t)k * 64], b = Wu[(size_t)k * 64];
            ag.x = fmaf(xk, a.x, ag.x); ag.y = fmaf(xk, a.y, ag.y); ag.z = fmaf(xk, a.z, ag.z); ag.w = fmaf(xk, a.w, ag.w);
            au.x = fmaf(xk, b.x, au.x); au.y = fmaf(xk, b.y, au.y); au.z = fmaf(xk, b.z, au.z); au.w = fmaf(xk, b.w, au.w); }
        float4 r; r.x = siluf_(ag.x) * au.x * w; r.y = siluf_(ag.y) * au.y * w; r.z = siluf_(ag.z) * au.z * w; r.w = siluf_(ag.w) * au.w * w;
        ((float4*)(hmid + (size_t)it * DE))[lane] = r;
        __builtin_amdgcn_s_waitcnt(0xc07f);
    }
}
__device__ void ph_moedown(const Params& p, float* smem) {
    const int* route = (const int*)(p.ws + WS_ROUTE); const float* hmid = (const float*)(p.ws + WS_HMID); float* out = p.out;
    const int lane = threadIdx.x & 63, wv = threadIdx.x >> 6; float* hs = smem + wv * 512;
    const int gw = blockIdx.x * 4 + wv, nw = gridDim.x * 4;
    for (int t = gw; t < T_; t += nw) {
#pragma unroll
        for (int j = 0; j < 8; ++j) hs[lane + 64 * j] = hmid[(size_t)t * 512 + lane + 64 * j];
        __builtin_amdgcn_s_waitcnt(0xc07f);
        float4 acc[4];
#pragma unroll
        for (int j = 0; j < 4; ++j) acc[j] = ((const float4*)(out + (size_t)t * D_))[lane + 64 * j];
        for (int sl = 0; sl < 2; ++sl) {
            const int e = route[(size_t)t * 4 + sl]; const float4* Wd = (const float4*)(p.in[I_WDOWN] + (size_t)e * DE * D_) + lane;
            for (int f = 0; f < DE; ++f) { const float hf = hs[sl * 256 + f];
#pragma unroll
                for (int j = 0; j < 4; ++j) { const float4 w = Wd[(size_t)f * 256 + 64 * j]; acc[j].x = fmaf(hf, w.x, acc[j].x); acc[j].y = fmaf(hf, w.y, acc[j].y); acc[j].z = fmaf(hf, w.z, acc[j].z); acc[j].w = fmaf(hf, w.w, acc[j].w); } }
        }
#pragma unroll
        for (int j = 0; j < 4; ++j) ((float4*)(out + (size_t)t * D_))[lane + 64 * j] = acc[j];
        __builtin_amdgcn_s_waitcnt(0xc07f);
    }
}
__device__ void ph_final(const Params& p, float* smem) {
    float* out = p.out; const float* gn = p.in[I_NORM_FINAL];
    const int lane = threadIdx.x & 63, gw = blockIdx.x * 4 + (threadIdx.x >> 6), nw = gridDim.x * 4;
    for (int t = gw; t < T_; t += nw) {
        float xv[16]; float ss = 0.f;
#pragma unroll
        for (int j = 0; j < 16; ++j) { xv[j] = out[(size_t)t * D_ + lane + 64 * j]; ss += xv[j] * xv[j]; }
        const float rs = rsqrtf(wave_sum(ss) / (float)D_ + RMS_EPS);
#pragma unroll
        for (int j = 0; j < 16; ++j) out[(size_t)t * D_ + lane + 64 * j] = xv[j] * rs * gn[lane + 64 * j];
    }
}

enum { P_NORM1 = 0, P_INPROJ, P_MEMNORM, P_KV, P_S5SCAN, P_S5GELU, P_S5GLU, P_S5NORM, P_GDNPREP, P_GDNREC, P_GDNCOMB, P_OUTPROJ, P_NORM2, P_QPROJ, P_ATTN, P_WOPROJ, P_ROUTER, P_MOEUP, P_MOEDOWN, P_FINAL, P_COUNT };

template <int PH> __global__ void __launch_bounds__(NT) k_phase(Params p) {
    __shared__ __attribute__((aligned(16))) float smem[4608];
    if (PH == P_NORM1) ph_norm1(p, smem);
    else if (PH == P_INPROJ) ph_inproj(p, smem);
    else if (PH == P_MEMNORM) ph_memnorm(p, smem);
    else if (PH == P_KV) ph_kv(p, smem);
    else if (PH == P_S5SCAN) ph_s5scan(p, smem);
    else if (PH == P_S5GELU) ph_s5gelu(p, smem);
    else if (PH == P_S5GLU) ph_s5glu(p, smem);
    else if (PH == P_S5NORM) ph_s5norm(p, smem);
    else if (PH == P_GDNPREP) ph_gdnprep(p, smem);
    else if (PH == P_GDNREC) ph_gdnrec(p, smem);
    else if (PH == P_GDNCOMB) ph_gdncomb(p, smem);
    else if (PH == P_OUTPROJ) ph_outproj(p, smem);
    else if (PH == P_NORM2) ph_norm2(p, smem);
    else if (PH == P_QPROJ) ph_qproj(p, smem);
    else if (PH == P_ATTN) ph_attn(p, smem);
    else if (PH == P_WOPROJ) ph_woproj(p, smem);
    else if (PH == P_ROUTER) ph_router(p, smem);
    else if (PH == P_MOEUP) ph_moeup(p, smem);
    else if (PH == P_MOEDOWN) ph_moedown(p, smem);
    else if (PH == P_FINAL) ph_final(p, smem);
}

extern "C" void kernel_launch(void* const* d_in, const int* in_sizes, int n_in, void* d_out, int out_size, void* d_ws, size_t ws_size, hipStream_t stream) {
    if (n_in != N_IN || out_size != T_ * D_ || ws_size < 256 * MiB) { fprintf(stderr, "kernel_launch: unexpected shapes n_in=%d out=%d ws=%zu\n", n_in, out_size, ws_size); return; }
    Params p{};
    for (int i = 0; i < N_IN; ++i) p.in[i] = (const float*)d_in[i];
    p.out = (float*)d_out; p.ws = (unsigned char*)d_ws;
    const int G = 2048;
#define LAUNCH(PH, grid) hipLaunchKernelGGL(k_phase<PH>, dim3(grid), dim3(NT), 0, stream, p)
    LAUNCH(P_NORM1, G);
    LAUNCH(P_INPROJ, G);
    LAUNCH(P_S5SCAN, 128);
    LAUNCH(P_S5GELU, G);
    LAUNCH(P_S5GLU, G);
    LAUNCH(P_S5NORM, G);
    LAUNCH(P_GDNPREP, G);
    LAUNCH(P_GDNREC, 32);
    LAUNCH(P_GDNCOMB, G);
    LAUNCH(P_OUTPROJ, G);
    LAUNCH(P_MEMNORM, G);
    LAUNCH(P_KV, G);
    LAUNCH(P_NORM2, G);
    LAUNCH(P_QPROJ, G);
    LAUNCH(P_ATTN, G);
    LAUNCH(P_WOPROJ, G);
    LAUNCH(P_ROUTER, G);
    LAUNCH(P_MOEUP, G);
    LAUNCH(P_MOEDOWN, G);
    LAUNCH(P_FINAL, G);
}
```

```cpp
#include <hip/hip_runtime.h>
#include <hip/hip_cooperative_groups.h>
namespace cg = cooperative_groups;
#include <cstdio>
#include <cstdint>
#include <type_traits>

typedef unsigned short bf16_t;
__device__ __forceinline__ float bf2f(bf16_t v) { return __uint_as_float(((unsigned)v) << 16); }
typedef __bf16 bf16v2e_t __attribute__((ext_vector_type(2)));
typedef float f32v2e_t __attribute__((ext_vector_type(2)));
__device__ __forceinline__ bf16_t f2bf(float f) { const f32v2e_t v = {f, 0.f}; const bf16v2e_t h = __builtin_convertvector(v, bf16v2e_t); return (bf16_t)(__builtin_bit_cast(unsigned, h) & 0xffffu); }

constexpr int B_ = 8, S_ = 2048, T_ = B_ * S_, D_ = 1024, DIN = 2576;
constexpr int S5W = 512, NG = 32, NP = 64, GDW = 512, NH = 4, HD = 128, MEM = 256;
constexpr int XH = 4, XD = 256, NE = 32, DE = 256;
constexpr float RMS_EPS = 1e-6f, L2_EPS = 1e-6f;
constexpr int NT = 512, NW = NT / 64;

struct Params {
    const float* in[48];
    float* out;
    unsigned char* ws;
};
enum { I_X = 0, I_MEM, I_NORM_MIX, I_W_IN, I_W_OUT,
       I_LAM_RE_F, I_LAM_IM_F, I_LOG_STEP_F, I_B_RE_F, I_B_IM_F, I_C_RE_F, I_C_IM_F,
       I_LAM_RE_B, I_LAM_IM_B, I_LOG_STEP_B, I_B_RE_B, I_B_IM_B, I_C_RE_B, I_C_IM_B,
       I_S5_D, I_W_GLU, I_B_GLU, I_S5_NORM,
       I_CONV, I_ALOG_F, I_DTB_F, I_ALOG_B, I_DTB_B, I_GDN_NORM,
       I_NORM_XA, I_NORM_MEM, I_WQ, I_WK, I_WV, I_WO,
       I_NORM_MOE, I_RG_W, I_RG_B, I_RE_W, I_RE_B, I_WGATE, I_WUP, I_WDOWN, I_NORM_FINAL, N_IN };

constexpr size_t MiB = 1u << 20;
constexpr size_t WS_HB   = 16 * MiB;
constexpr size_t WS_GL   = 0;
constexpr size_t WS_QKVR = 192 * MiB;
constexpr size_t WS_ZB   = 48 * MiB;
constexpr size_t WS_QKVC = 112 * MiB;
constexpr size_t WS_YF   = 160 * MiB;
constexpr size_t WS_CAT  = 224 * MiB;
constexpr size_t OUT_BA = 0;
constexpr size_t OUT_GB = 1 * MiB;
constexpr size_t OUT_WINT = 4 * MiB;
constexpr size_t OUT_WGLUT = 10 * MiB;
constexpr int QKV_LD = 1536, NINP = 2816;
constexpr size_t WS_BAR  = 111 * MiB + 768 * 1024;
constexpr size_t WS_AEXT = 160 * MiB;
constexpr size_t WS_HLOC = 192 * MiB;
constexpr size_t OUT_MMAT = 12 * MiB;
constexpr size_t OUT_EMAT = 20 * MiB;
constexpr int S5L = 16, S5NC = S_ / S5L;
constexpr size_t WS_XB   = 0;
constexpr size_t WS_QB   = 32 * MiB;
constexpr size_t WS_PB   = 64 * MiB;
constexpr size_t WS_OB   = 112 * MiB;
constexpr size_t WS_ROUTE = 154 * MiB;
constexpr size_t WS_WRT  = 156 * MiB;
constexpr size_t WS_CNT  = 155 * MiB;
constexpr size_t WS_WOUTT = 144 * MiB;
constexpr size_t WS_WQB  = 104 * MiB;
constexpr size_t WS_WOT  = 106 * MiB;
constexpr size_t WS_MQ   = 160 * MiB;
constexpr size_t WS_VWT  = 128 * MiB;
constexpr size_t WS_KMEM = 96 * MiB;
constexpr size_t WS_VMEM = 100 * MiB;
constexpr size_t WS_MEMN = 104 * MiB;
constexpr size_t WS_SSQ  = 108 * MiB;
constexpr size_t OUT_WKT = 58 * MiB, OUT_WVT = 60 * MiB;
constexpr size_t WS_WGUT = 176 * MiB;
constexpr size_t WS_WDT  = 208 * MiB;
constexpr size_t WS_XS   = 32 * MiB;
constexpr size_t WS_HM   = 112 * MiB;
constexpr int MC_NT = 32, MC_REV = 64, MC_MAP = 256, MC_WORDS = 256 + 32 * 128;
constexpr int MAXRT = 159;

__device__ __forceinline__ int ltid() { int t = threadIdx.x; asm volatile("" : "+v"(t)); return t; }
__device__ __forceinline__ float dpp_max16(float v) {
    v = fmaxf(v, __int_as_float(__builtin_amdgcn_update_dpp(0, __float_as_int(v), 0xB1, 0xF, 0xF, true)));
    v = fmaxf(v, __int_as_float(__builtin_amdgcn_update_dpp(0, __float_as_int(v), 0x4E, 0xF, 0xF, true)));
    v = fmaxf(v, __int_as_float(__builtin_amdgcn_update_dpp(0, __float_as_int(v), 0x141, 0xF, 0xF, true)));
    v = fmaxf(v, __int_as_float(__builtin_amdgcn_update_dpp(0, __float_as_int(v), 0x140, 0xF, 0xF, true)));
    return v;
}
__device__ __forceinline__ float dpp_sum16(float v) {
    v += __int_as_float(__builtin_amdgcn_update_dpp(0, __float_as_int(v), 0xB1, 0xF, 0xF, true));
    v += __int_as_float(__builtin_amdgcn_update_dpp(0, __float_as_int(v), 0x4E, 0xF, 0xF, true));
    v += __int_as_float(__builtin_amdgcn_update_dpp(0, __float_as_int(v), 0x141, 0xF, 0xF, true));
    v += __int_as_float(__builtin_amdgcn_update_dpp(0, __float_as_int(v), 0x140, 0xF, 0xF, true));
    return v;
}
__device__ __forceinline__ float wave_sum(float v) {
    v += __int_as_float(__builtin_amdgcn_update_dpp(0, __float_as_int(v), 0xB1, 0xF, 0xF, true));
    v += __int_as_float(__builtin_amdgcn_update_dpp(0, __float_as_int(v), 0x4E, 0xF, 0xF, true));
    v += __int_as_float(__builtin_amdgcn_update_dpp(0, __float_as_int(v), 0x141, 0xF, 0xF, true));
    v += __int_as_float(__builtin_amdgcn_update_dpp(0, __float_as_int(v), 0x140, 0xF, 0xF, true));
    v += __int_as_float(__builtin_amdgcn_update_dpp(0, __float_as_int(v), 0x142, 0xA, 0xF, false));
    v += __int_as_float(__builtin_amdgcn_update_dpp(0, __float_as_int(v), 0x143, 0xC, 0xF, false));
    return __int_as_float(__builtin_amdgcn_readlane(__float_as_int(v), 63));
}
__device__ __forceinline__ float sigmoidf_(float x) { return __builtin_amdgcn_rcpf(1.f + __expf(-x)); }
__device__ __forceinline__ float siluf_(float x) { return x * sigmoidf_(x); }
__device__ __forceinline__ float softplusf_(float x) { return x > 20.f ? x : log1pf(__expf(x)); }
__device__ __forceinline__ float geluf_(float x) { return 0.5f * x * (1.f + erff(x * 0.70710678118654752f)); }

template <class TA> __device__ __forceinline__ float ldA(const TA* p);
template <> __device__ __forceinline__ float ldA<float>(const float* p) { return *p; }
template <> __device__ __forceinline__ float ldA<bf16_t>(const bf16_t* p) { return bf2f(*p); }

typedef float f4_t __attribute__((ext_vector_type(4)));
typedef unsigned u2_t __attribute__((ext_vector_type(2)));
typedef unsigned u4_t __attribute__((ext_vector_type(4)));
__device__ __forceinline__ unsigned pkbf(float lo, float hi);
__device__ __forceinline__ float bflo(unsigned u) { return __uint_as_float(u << 16); }
__device__ __forceinline__ float bfhi(unsigned u) { return __uint_as_float(u & 0xffff0000u); }
__device__ __forceinline__ void rmsnorm_rows_bf16(const float* X, const float* gain, bf16_t* Y, int rows, int width) {
    const int THR = ltid();
    const int lane = THR & 63, gw = blockIdx.x * NW + (THR >> 6), nw = gridDim.x * NW;
    f4_t g[4];
#pragma unroll
    for (int j = 0; j < 4; ++j) g[j] = ((const f4_t*)gain)[lane + 64 * j];
    for (int r0 = gw * 4; r0 < rows; r0 += nw * 4) {
        f4_t v[4][4];
#pragma unroll
        for (int r = 0; r < 4; ++r)
#pragma unroll
            for (int j = 0; j < 4; ++j) v[r][j] = ((const f4_t*)(X + (size_t)(r0 + r) * 1024))[lane + 64 * j];
#pragma unroll
        for (int r = 0; r < 4; ++r) { float ss = 0.f;
#pragma unroll
            for (int j = 0; j < 4; ++j) ss += v[r][j].x * v[r][j].x + v[r][j].y * v[r][j].y + v[r][j].z * v[r][j].z + v[r][j].w * v[r][j].w;
            const float rs = rsqrtf(wave_sum(ss) * (1.f / 1024.f) + RMS_EPS);
#pragma unroll
            for (int j = 0; j < 4; ++j) { const f4_t o = v[r][j] * rs * g[j]; u2_t w; w.x = pkbf(o.x, o.y); w.y = pkbf(o.z, o.w); ((u2_t*)(Y + (size_t)(r0 + r) * 1024))[lane + 64 * j] = w; } }
    }
}

namespace pg8 {
#define PG8_LAS __attribute__((address_space(3)))
typedef short bf16x8 __attribute__((ext_vector_type(8)));
typedef float f32x4 __attribute__((ext_vector_type(4)));
typedef unsigned u32x4 __attribute__((ext_vector_type(4)));
typedef unsigned u32x2 __attribute__((ext_vector_type(2)));
constexpr int BM = 256, BK = 64, HALF = 128, HTB = HALF * BK * 2, STAGE_BYTES = 8 * HTB;
__device__ __forceinline__ int lds_byte(int r, int c) { const int st = (r >> 4) * 2 + (c >> 5), rr = r & 15, cc = c & 31, ob = rr * 64 + cc * 2; return st * 1024 + (ob ^ (((ob >> 9) & 1) << 5)); }
__device__ __forceinline__ void stage_rc(int b, int& R, int& C) { const int st = b / 1024, sb = b % 1024, swz = sb ^ (((sb >> 9) & 1) << 5); R = (st >> 1) * 16 + swz / 64; C = (st & 1) * 32 + (swz % 64) / 2; }
__device__ __forceinline__ int perm32(int rho) { const int n = rho >> 4, i = rho & 15; return 8 * (i >> 2) + 4 * n + (i & 3); }
typedef __bf16 bf16v2_t __attribute__((ext_vector_type(2)));
typedef float f32v2_t __attribute__((ext_vector_type(2)));
__device__ __forceinline__ unsigned cvt_pk_bf16(float lo, float hi) { const f32v2_t f = {lo, hi}; const bf16v2_t h = __builtin_convertvector(f, bf16v2_t); return __builtin_bit_cast(unsigned, h); }
}
__device__ __forceinline__ unsigned pkbf(float lo, float hi) { return pg8::cvt_pk_bf16(lo, hi); }
namespace pg8 {

struct Unit { const char* a; const char* b; int orow, ocol, aux; };
struct DenseOrder {
    const char* A; const char* Bt; int lda, ldb, nM, nN, nwg, G, c;
    __device__ void init(const bf16_t* A_, int lda_, const bf16_t* Bt_, int ldb_, int M, int N, int G_, int c_) { A = (const char*)A_; Bt = (const char*)Bt_; lda = lda_; ldb = ldb_; nM = M / BM; nN = N / BM; nwg = nM * nN; G = G_; c = c_; }
    __device__ bool next(int i, Unit& u) const {
        const long L = (long)i * G + c; if (L >= nwg) return false;
        int wgid = (int)L; { const int q = nwg / 8, r = nwg % 8, xcd = wgid % 8, off = wgid / 8; wgid = (xcd < r ? xcd * (q + 1) : r * (q + 1) + (xcd - r) * q) + off; }
        const int nig = 8 * nN, gid = wgid / nig, fm = gid * 8, gsz = (nM - fm) < 8 ? (nM - fm) : 8;
        const int pm = fm + ((wgid % nig) % gsz), pn = (wgid % nig) / gsz;
        u.a = A + (size_t)pm * BM * lda * 2; u.b = Bt + (size_t)pn * BM * ldb * 2; u.orow = pm * BM; u.ocol = pn * BM; u.aux = pn; return true;
    }
};

template <class Epi, class Sched>
__device__ __forceinline__ void gemm_phase(PG8_LAS unsigned char* lds, const int K, const int lda, const int ldb, const Sched& S, const Epi& E) {
    int tid_ = threadIdx.x; asm volatile("" : "+v"(tid_));
    const int tid = tid_, wid = __builtin_amdgcn_readfirstlane(tid >> 6), lane = tid & 63, wr = wid >> 2, wc = wid & 3, fr = lane & 15, fq = lane >> 4;
    const int nt = K / BK;
    unsigned voffA[2], voffB[2];
#pragma unroll
    for (int i = 0; i < 2; ++i) { int R, C; stage_rc(tid * 16 + i * 8192, R, C); const int Rb = Epi::PERM ? ((R & ~31) + perm32(R & 31)) : R;
        voffA[i] = (unsigned)(R * lda + C) * 2u; voffB[i] = (unsigned)(Rb * ldb + C) * 2u; }
    const size_t kstep = (size_t)(BK * 2);
    const size_t hstepA = (size_t)HALF * lda * 2, hstepB = (size_t)HALF * ldb * 2;
    const unsigned ldsw = (unsigned)wid * 1024u;
    const int aoff = lds_byte(wr * 64 + fr, fq * 8), boff = lds_byte(wc * 32 + fr, fq * 8);
#define PG8_SA(b, h) (((b) * 2 + (h)) * HTB)
#define PG8_SB(b, h) ((4 + (b) * 2 + (h)) * HTB)
#define PG8_STAGE(bufoff, gbase, voff) do { _Pragma("unroll") for (int _i = 0; _i < 2; ++_i) \
        __builtin_amdgcn_global_load_lds((const unsigned*)((const char*)(gbase) + (voff)[_i]), (PG8_LAS unsigned*)(lds + (bufoff) + ldsw + _i * 8192), 16, 0, 0); } while (0)
#define PG8_LDA(dst, b, h) do { _Pragma("unroll") for (int m = 0; m < 4; ++m) _Pragma("unroll") for (int k = 0; k < 2; ++k) dst[m][k] = *(const PG8_LAS bf16x8*)(lds + PG8_SA(b, h) + aoff + m * 2048 + k * 1024); } while (0)
#define PG8_LDB(dst, b, h) do { _Pragma("unroll") for (int n = 0; n < 2; ++n) _Pragma("unroll") for (int k = 0; k < 2; ++k) dst[n][k] = *(const PG8_LAS bf16x8*)(lds + PG8_SB(b, h) + boff + n * 2048 + k * 1024); } while (0)
#define PG8_MMA(ai, bj, At, Bt) do { __builtin_amdgcn_s_setprio(1); _Pragma("unroll") for (int m = 0; m < 4; ++m) _Pragma("unroll") for (int n = 0; n < 2; ++n) _Pragma("unroll") for (int k = 0; k < 2; ++k) \
        acc[ai][bj][m][n] = __builtin_amdgcn_mfma_f32_16x16x32_bf16(Bt[n][k], At[m][k], acc[ai][bj][m][n], 0, 0, 0); __builtin_amdgcn_s_setprio(0); } while (0)
#define PG8_WAIT_V(n) asm volatile("s_waitcnt vmcnt(" #n ")" ::: "memory")
#define PG8_WAIT_L(n) asm volatile("s_waitcnt lgkmcnt(" #n ")" ::: "memory")
#define PG8_BAR __builtin_amdgcn_s_barrier()
#define PG8_SCHED __builtin_amdgcn_sched_barrier(0)
    Unit cur, nxt; int ui = 0;
    if (!S.next(0, cur)) return;
    f32x4 acc[2][2][4][2];
#pragma unroll
    for (int a = 0; a < 2; ++a)
#pragma unroll
        for (int b = 0; b < 2; ++b)
#pragma unroll
            for (int m = 0; m < 4; ++m)
#pragma unroll
                for (int n = 0; n < 2; ++n) acc[a][b][m][n] = (f32x4){0.f, 0.f, 0.f, 0.f};
    bf16x8 At[4][2], B0[2][2], B1[2][2];
    const char* cA = cur.a; const char* cB = cur.b;
    PG8_STAGE(PG8_SB(0, 0), cB, voffB); PG8_STAGE(PG8_SA(0, 0), cA, voffA); PG8_STAGE(PG8_SB(0, 1), cB + hstepB, voffB); PG8_STAGE(PG8_SA(0, 1), cA + hstepA, voffA);
    if (wr == 1) PG8_BAR;
    PG8_WAIT_V(4); PG8_BAR;
    PG8_STAGE(PG8_SB(1, 0), cB + kstep, voffB); PG8_STAGE(PG8_SA(1, 0), cA + kstep, voffA); PG8_STAGE(PG8_SB(1, 1), cB + hstepB + kstep, voffB);
    PG8_WAIT_V(6); PG8_BAR;
    for (;;) {
        const bool has_next = S.next(ui + 1, nxt);
        const char* nA = has_next ? nxt.a : cA; const char* nB = has_next ? nxt.b : cB;
        for (int t = 0; t < nt; t += 2) {
            const bool last = (t == nt - 2);
            const char* a1 = cA + (size_t)(t + 1) * kstep;
            const char* a2 = last ? nA : cA + (size_t)(t + 2) * kstep; const char* b2 = last ? nB : cB + (size_t)(t + 2) * kstep;
            const char* a3 = a2 + kstep; const char* b3 = b2 + kstep;
            PG8_LDB(B0, 0, 0); PG8_SCHED; PG8_LDA(At, 0, 0); PG8_STAGE(PG8_SA(1, 1), a1 + hstepA, voffA);
            PG8_WAIT_L(8); PG8_BAR; PG8_WAIT_L(0); PG8_MMA(0, 0, At, B0); PG8_BAR; PG8_SCHED;
            PG8_LDB(B1, 0, 1); PG8_STAGE(PG8_SB(0, 0), b2, voffB);
            PG8_BAR; PG8_WAIT_L(0); PG8_MMA(0, 1, At, B1); PG8_BAR;
            PG8_LDA(At, 0, 1); PG8_STAGE(PG8_SA(0, 0), a2, voffA);
            PG8_BAR; PG8_WAIT_L(0); PG8_MMA(1, 0, At, B0); PG8_BAR; PG8_SCHED;
            PG8_STAGE(PG8_SB(0, 1), b2 + hstepB, voffB);
            PG8_WAIT_V(6); PG8_BAR; PG8_MMA(1, 1, At, B1); PG8_BAR;
            PG8_LDB(B0, 1, 0); PG8_SCHED; PG8_LDA(At, 1, 0); PG8_STAGE(PG8_SA(0, 1), a2 + hstepA, voffA);
            PG8_WAIT_L(8); PG8_BAR; PG8_WAIT_L(0); PG8_MMA(0, 0, At, B0); PG8_BAR; PG8_SCHED;
            PG8_LDB(B1, 1, 1); PG8_STAGE(PG8_SB(1, 0), b3, voffB);
            PG8_BAR; PG8_WAIT_L(0); PG8_MMA(0, 1, At, B1); PG8_BAR;
            PG8_LDA(At, 1, 1); PG8_STAGE(PG8_SA(1, 0), a3, voffA);
            PG8_BAR; PG8_WAIT_L(0); PG8_MMA(1, 0, At, B0); PG8_BAR; PG8_SCHED;
            PG8_STAGE(PG8_SB(1, 1), b3 + hstepB, voffB);
            PG8_WAIT_V(6); PG8_BAR; PG8_MMA(1, 1, At, B1); PG8_BAR;
        }
        E(acc, cur, wr, wc, fr, fq);
        if (!has_next) break;
#pragma unroll
        for (int a = 0; a < 2; ++a)
#pragma unroll
            for (int b = 0; b < 2; ++b)
#pragma unroll
                for (int m = 0; m < 4; ++m)
#pragma unroll
                    for (int n = 0; n < 2; ++n) acc[a][b][m][n] = (f32x4){0.f, 0.f, 0.f, 0.f};
        cur = nxt; cA = nA; cB = nB; ++ui;
    }
    PG8_WAIT_V(0);
    if (wr == 0) PG8_BAR;
    PG8_BAR;
#undef PG8_SA
#undef PG8_SB
#undef PG8_STAGE
#undef PG8_LDA
#undef PG8_LDB
#undef PG8_MMA
#undef PG8_WAIT_V
#undef PG8_WAIT_L
#undef PG8_BAR
#undef PG8_SCHED
}
}
typedef pg8::f32x4 f32x4; typedef pg8::u32x4 u32x4;
#define LAS __attribute__((address_space(3)))

#define LAS __attribute__((address_space(3)))

__device__ __forceinline__ void ph_norm1(const Params& p, float* smem) {
    rmsnorm_rows_bf16(p.in[I_X], p.in[I_NORM_MIX], (bf16_t*)(p.ws + WS_HB), T_, D_);
}
__device__ __forceinline__ void ph_memnorm(const Params& p, float* smem) {
    rmsnorm_rows_bf16(p.in[I_MEM], p.in[I_NORM_MEM], (bf16_t*)(p.ws + WS_MEMN), B_ * MEM, D_);
}
__device__ __forceinline__ void ph_s5mat(const Params& p, float* smem) {
    const int THR = ltid();
    bf16_t* Mm = (bf16_t*)((unsigned char*)p.out + OUT_MMAT); bf16_t* Em = (bf16_t*)((unsigned char*)p.out + OUT_EMAT);
    float* lp = smem;
    float* cf = smem + 640;
    float* Bb = smem + 896;
    float* kk = smem + 896 + 4096;
    __syncthreads();
    for (int item = blockIdx.x; item < NG * S5L; item += gridDim.x) {
        const int g = item >> 4, j = item & 15;
        if (THR < 320) {
            const int which = THR >> 6, pp = THR & 63; const int dir = (which == 1 || which == 4) ? 1 : 0;
            const int o = dir ? (I_LAM_RE_B - I_LAM_RE_F) : 0;
            const float lre = p.in[I_LAM_RE_F + o][g * NP + pp], lim = p.in[I_LAM_IM_F + o][g * NP + pp], step = __expf(p.in[I_LOG_STEP_F + o][g]);
            const float pw = (float)(which == 0 ? j : which == 1 ? j : which == 2 ? (15 - j) : which == 3 ? (j + 1) : (16 - j));
            const float er = expf(lre * step * pw); float sn, cs; sincosf(lim * step * pw, &sn, &cs);
            lp[(which * 64 + pp) * 2] = er * cs; lp[(which * 64 + pp) * 2 + 1] = er * sn;
            if (which < 2) {
                const float e1 = expf(lre * step); float s1, c1; sincosf(lim * step, &s1, &c1);
                const float nr = e1 * c1 - 1.f, ni = e1 * s1, den = lre * lre + lim * lim;
                cf[(dir * 64 + pp) * 2] = (nr * lre + ni * lim) / den; cf[(dir * 64 + pp) * 2 + 1] = (ni * lre - nr * lim) / den;
            }
        }
        __syncthreads();
        for (int e = THR; e < 2048; e += NT) {
            const int dir = e >> 10, pp = (e >> 4) & 63, ci = e & 15; const int o = dir ? (I_LAM_RE_B - I_LAM_RE_F) : 0;
            const float br = p.in[I_B_RE_F + o][(g * NP + pp) * 16 + ci], bi = p.in[I_B_IM_F + o][(g * NP + pp) * 16 + ci];
            const float cr = cf[(dir * 64 + pp) * 2], ci_ = cf[(dir * 64 + pp) * 2 + 1];
            Bb[e * 2] = cr * br - ci_ * bi; Bb[e * 2 + 1] = cr * bi + ci_ * br;
        }
        __syncthreads();
        {
            const int dir = THR >> 8, co = (THR >> 4) & 15, ci = THR & 15; const int o = dir ? (I_LAM_RE_B - I_LAM_RE_F) : 0;
            const float* cre = p.in[I_C_RE_F + o] + (g * 16 + co) * NP; const float* cim = p.in[I_C_IM_F + o] + (g * 16 + co) * NP;
            float acc = 0.f;
            for (int pp = 0; pp < 64; ++pp) {
                const float lr = lp[(dir * 64 + pp) * 2], li = lp[(dir * 64 + pp) * 2 + 1], c_r = cre[pp], c_i = cim[pp];
                const float clr = c_r * lr - c_i * li, cli = c_r * li + c_i * lr;
                acc += clr * Bb[((dir * 64 + pp) * 16 + ci) * 2] - cli * Bb[((dir * 64 + pp) * 16 + ci) * 2 + 1];
            }
            kk[THR] = acc;
        }
        __syncthreads();
        {
            const int dir = THR >> 8, co = (THR >> 4) & 15, ci = THR & 15; bf16_t* Mg = Mm + (size_t)g * 256 * 512;
            if (j == 0) { if (dir == 0) { const bf16_t v = f2bf(kk[THR] + kk[256 + THR] + (co == ci ? p.in[I_S5_D][g * 16 + co] : 0.f));
                    for (int jj = 0; jj < 16; ++jj) Mg[(size_t)(jj * 16 + co) * 512 + jj * 16 + ci] = v; } }
            else { const bf16_t v = f2bf(kk[THR]);
                if (dir == 0) { for (int jj = j; jj < 16; ++jj) Mg[(size_t)(jj * 16 + co) * 512 + (jj - j) * 16 + ci] = v; }
                else { for (int jj = 0; jj + j < 16; ++jj) Mg[(size_t)(jj * 16 + co) * 512 + (jj + j) * 16 + ci] = v; } }
        }
        for (int e = THR; e < 2048; e += NT) {
            const int dir = e >> 10, co = (e >> 6) & 15, pp = e & 63; const int o = dir ? (I_LAM_RE_B - I_LAM_RE_F) : 0;
            const float c_r = p.in[I_C_RE_F + o][(g * 16 + co) * NP + pp], c_i = p.in[I_C_IM_F + o][(g * 16 + co) * NP + pp];
            const int w = dir ? 4 : 3; const float lr = lp[(w * 64 + pp) * 2], li = lp[(w * 64 + pp) * 2 + 1];
            bf16_t* row = Mm + ((size_t)g * 256 + j * 16 + co) * 512 + 256 + dir * 128;
            row[pp] = f2bf(c_r * lr - c_i * li); row[64 + pp] = f2bf(-(c_r * li + c_i * lr));
        }
        for (int e = THR; e < 2048; e += NT) {
            const int dir = e >> 10, pp = (e >> 4) & 63, ci = e & 15;
            const int w = dir ? 1 : 2; const float lr = lp[(w * 64 + pp) * 2], li = lp[(w * 64 + pp) * 2 + 1];
            const float br = Bb[e * 2], bi = Bb[e * 2 + 1];
            bf16_t* Eg = Em + (size_t)g * 256 * 256;
            Eg[(size_t)(dir * 128 + pp) * 256 + j * 16 + ci] = f2bf(lr * br - li * bi);
            Eg[(size_t)(dir * 128 + 64 + pp) * 256 + j * 16 + ci] = f2bf(lr * bi + li * br);
        }
        __syncthreads();
    }
}
__device__ __forceinline__ void s5carry_unit(const Params& p, int g, int pm) {
    const int THR = ltid();
    if (THR < 256) {
        const float* Hl = (const float*)(p.ws + WS_HLOC); bf16_t* Ax = (bf16_t*)(p.ws + WS_AEXT);
        const int pp = THR & 63, dir = (THR >> 6) & 1, b = 2 * pm + (THR >> 7); const int o = dir ? (I_LAM_RE_B - I_LAM_RE_F) : 0;
        const float lre = p.in[I_LAM_RE_F + o][g * NP + pp], lim = p.in[I_LAM_IM_F + o][g * NP + pp], step = __expf(p.in[I_LOG_STEP_F + o][g]);
        const float er = expf(lre * step * (float)S5L); float sn, cs; sincosf(lim * step * (float)S5L, &sn, &cs);
        const float lr = er * cs, li = er * sn;
        float hr = 0.f, hi = 0.f;
        const size_t rowbase = (size_t)g * 1024 + (size_t)b * S5NC;
        for (int s0 = 0; s0 < S5NC; s0 += 16) {
            float lr_[16], li_[16];
#pragma unroll
            for (int k = 0; k < 16; ++k) { const int c = dir ? (S5NC - 1 - (s0 + k)) : (s0 + k); const float* hl = Hl + (rowbase + c) * 256 + dir * 128; lr_[k] = hl[pp]; li_[k] = hl[64 + pp]; }
#pragma unroll
            for (int k = 0; k < 16; ++k) { const int c = dir ? (S5NC - 1 - (s0 + k)) : (s0 + k);
                bf16_t* ar = Ax + (rowbase + c) * 512 + 256 + dir * 128; ar[pp] = f2bf(hr); ar[64 + pp] = f2bf(hi);
                const float nr = lr * hr - li * hi + lr_[k], ni = lr * hi + li * hr + li_[k]; hr = nr; hi = ni; }
        }
    }
    asm volatile("s_waitcnt vmcnt(0)" ::: "memory");
    __syncthreads();
}
constexpr size_t WS_GW   = 16 * MiB;
constexpr size_t WS_GUT  = 64 * MiB;
constexpr size_t WS_GQK  = 128 * MiB;
constexpr size_t WS_GKT  = 144 * MiB;
constexpr size_t WS_GQN  = 112 * MiB;
constexpr size_t OUT_GSC = 24 * MiB;
constexpr size_t OUT_GO  = 26 * MiB;
typedef short bf16x4 __attribute__((ext_vector_type(4)));
typedef pg8::bf16x8 bf16x8;
__device__ __forceinline__ bf16x8 cat44(bf16x4 lo, bf16x4 hi) { return __builtin_shufflevector(lo, hi, 0, 1, 2, 3, 4, 5, 6, 7); }
__device__ __forceinline__ bf16x4 pack4(float a, float b, float c, float d) { union { unsigned u[2]; bf16x4 v; } x; x.u[0] = pg8::cvt_pk_bf16(a, b); x.u[1] = pg8::cvt_pk_bf16(c, d); return x.v; }

__host__ __device__ constexpr int gdna_pieces_before(int i) { return i <= 16 ? i - 1 : i <= 32 ? 16 + 2 * (i - 17) : i <= 48 ? 48 + 3 * (i - 33) : 96 + 4 * (i - 49); }
__device__ __forceinline__ void ph_gdna(const Params& p, float* smem) {
    LAS unsigned char* L = (LAS unsigned char*)smem;
    constexpr int KS = 0, QS = 17408, VS = 34816, KT = 52224, VT = 70656, KK = 89088, QKR = 105728, SC = 122368, TB = 124416;
    constexpr int AF = KS, AB = QS, TF = KK;
    LAS float* sc = (LAS float*)(L + SC);
    const bf16_t* proj = (const bf16_t*)(p.ws + WS_QKVR); const float* ba = (const float*)((unsigned char*)p.out + OUT_BA); const float* cw = p.in[I_CONV]; bf16_t* GQN = (bf16_t*)(p.ws + WS_GQN);
    bf16_t* GW = (bf16_t*)(p.ws + WS_GW); bf16_t* GUT = (bf16_t*)(p.ws + WS_GUT); bf16_t* GQK = (bf16_t*)(p.ws + WS_GQK); bf16_t* GKT = (bf16_t*)(p.ws + WS_GKT);
    float* GSC = (float*)((unsigned char*)p.out + OUT_GSC);
    auto loadraw = [&](unsigned (&rw)[3][12], float& bav, int it) {
        const int THR = ltid(); const int lane = THR & 63, wid = THR >> 6;
        const int n = it & 31, h = (it >> 5) & 3, b = it >> 7, t0 = b * S_ + n * 64, s0 = n * 64 + wid * 8;
#pragma unroll
        for (int mat = 0; mat < 3; ++mat)
#pragma unroll
            for (int r = 0; r < 12; ++r) { const int sq = s0 - 2 + r; unsigned raw = 0u;
                if (sq >= 0 && sq < S_) raw = *(const unsigned*)(proj + (size_t)(b * S_ + sq) * QKV_LD + mat * 512 + h * 128 + lane * 2);
                rw[mat][r] = raw; }
        bav = 0.f;
        if (THR < 256) { const int i = THR & 63, w = THR >> 6; bav = ba[(size_t)(t0 + i) * 16 + (w == 0 ? 8 + h : w == 1 ? 12 + h : w == 2 ? h : 4 + h)]; }
    };
    const bool fixed_h = (gridDim.x % 128u) == 0u;
    float cwa[3][5], cwb[3][5];
    auto loadtaps = [&](int h) {
        const int lane = ltid() & 63;
#pragma unroll
        for (int mat = 0; mat < 3; ++mat)
#pragma unroll
            for (int k = 0; k < 5; ++k) { const int col = mat * 512 + h * 128 + lane * 2; cwa[mat][k] = cw[k * 1536 + col]; cwb[mat][k] = cw[k * 1536 + col + 1]; }
    };
    loadtaps((blockIdx.x >> 5) & 3);
    unsigned rawc[3][12]; float bac = 0.f;
    if ((int)blockIdx.x < B_ * NH * 32) loadraw(rawc, bac, blockIdx.x);
    for (int item = blockIdx.x; item < B_ * NH * 32; item += gridDim.x) {
        const int THR = ltid();
        const int lane = THR & 63, wid = THR >> 6, l15 = lane & 15, q4 = lane >> 4;
        const int n = item & 31, h = (item >> 5) & 3, b = item >> 7, t0 = b * S_ + n * 64;
        if (!fixed_h) loadtaps(h);
        if (THR < 256) { const int i = THR & 63, w = THR >> 6; const float r = bac;
            sc[w * 64 + i] = (w < 2) ? -__expf(p.in[w ? I_ALOG_B : I_ALOG_F][h]) * softplusf_(r + p.in[w ? I_DTB_B : I_DTB_F][h]) : sigmoidf_(r); }
        {
#pragma unroll
            for (int mat = 0; mat < 3; ++mat) {
                float w0[5], w1[5], x0[12], x1[12];
#pragma unroll
                for (int k = 0; k < 5; ++k) { w0[k] = cwa[mat][k]; w1[k] = cwb[mat][k]; }
#pragma unroll
                for (int r = 0; r < 12; ++r) { const unsigned raw = rawc[mat][r]; x0[r] = __uint_as_float(raw << 16); x1[r] = __uint_as_float(raw & 0xffff0000u); }
#pragma unroll
                for (int tk = 0; tk < 8; ++tk) { float a0 = 0.f, a1 = 0.f;
#pragma unroll
                    for (int k = 0; k < 5; ++k) { a0 = fmaf(w0[k], x0[tk + k], a0); a1 = fmaf(w1[k], x1[tk + k], a1); }
                    float y0 = siluf_(a0), y1 = siluf_(a1);
                    if (mat < 2) { float scl = rsqrtf(wave_sum(y0 * y0 + y1 * y1) + L2_EPS); if (mat == 0) scl *= 0.08838834764831845f; y0 *= scl; y1 *= scl; }
                    *(LAS unsigned*)(L + (mat == 0 ? QS : mat == 1 ? KS : VS) + (wid * 8 + tk) * 272 + lane * 4) = pg8::cvt_pk_bf16(y0, y1); }
            }
        }
        unsigned rawn[3][12]; float ban = 0.f;
        if (item + (int)gridDim.x < B_ * NH * 32) loadraw(rawn, ban, item + gridDim.x);
        __syncthreads();
        if (wid < 2) { float v = sc[wid * 64 + (wid ? 63 - lane : lane)];
#pragma unroll
            for (int o = 1; o < 64; o <<= 1) { const float t = __shfl_up(v, o); if (lane >= o) v += t; }
            sc[256 + wid * 64 + (wid ? 63 - lane : lane)] = v; }
        {
#pragma unroll
            for (int i = 0; i < 2; ++i) { const int e = THR + i * NT, row = e >> 4, ch = e & 15; *(u32x4*)(GQN + (size_t)item * 8192 + row * 128 + ch * 8) = *(const LAS u32x4*)(L + QS + row * 272 + ch * 16); }
            const int tok0 = 4 * (THR & 15), c0 = 4 * (THR >> 4);
#pragma unroll
            for (int mat = 0; mat < 2; ++mat) { const int src = mat ? VS : KS, dst = mat ? VT : KT; bf16x4 r[4];
#pragma unroll
                for (int i = 0; i < 4; ++i) r[i] = *(const LAS bf16x4*)(L + src + (tok0 + i) * 272 + c0 * 2);
#pragma unroll
                for (int c = 0; c < 4; ++c) { bf16x4 o; o[0] = r[0][c]; o[1] = r[1][c]; o[2] = r[2][c]; o[3] = r[3][c]; *(LAS bf16x4*)(L + dst + (c0 + c) * 144 + tok0 * 2) = o; } }
        }
#pragma unroll
        for (int ti = 0; ti < 4; ++ti) { const int id = wid * 4 + ti, mat = id >> 4, it = (id >> 2) & 3, jt = id & 3; f32x4 acc = {0.f, 0.f, 0.f, 0.f};
#pragma unroll
            for (int s4 = 0; s4 < 4; ++s4) { const bf16x8 a = *(const LAS bf16x8*)(L + (mat ? QS : KS) + (16 * it + l15) * 272 + (32 * s4 + 8 * q4) * 2);
                const bf16x8 bb = *(const LAS bf16x8*)(L + KS + (16 * jt + l15) * 272 + (32 * s4 + 8 * q4) * 2);
                acc = __builtin_amdgcn_mfma_f32_16x16x32_bf16(a, bb, acc, 0, 0, 0); }
            LAS float* dst = (LAS float*)(L + (mat ? QKR : KK));
#pragma unroll
            for (int r = 0; r < 4; ++r) dst[(16 * it + 4 * q4 + r) * 65 + 16 * jt + l15] = acc[r]; }
        __syncthreads();
        {
            LAS float* kk = (LAS float*)(L + KK); LAS float* qr = (LAS float*)(L + QKR); LAS float* af = (LAS float*)(L + AF); LAS float* ab = (LAS float*)(L + AB);
            bf16_t* qkf = GQK + (size_t)(item * 2) * 4096; bf16_t* qkb = qkf + 4096;
            const int i = THR >> 3, j0 = (THR & 7) * 8;
            const float gfi = sc[256 + i], gbi = sc[320 + i], bfi = sc[128 + i], bbi = sc[192 + i];
            float vf[8], vb[8], qf[8], qb[8];
#pragma unroll
            for (int e = 0; e < 8; ++e) { const int j = j0 + e; const float kv = kk[i * 65 + j], qv = qr[i * 65 + j];
                const float df = __expf(fminf(gfi - sc[256 + j], 0.f)), db = __expf(fminf(gbi - sc[320 + j], 0.f));
                vf[e] = (j < i) ? bfi * kv * df : 0.f; vb[e] = (j > i) ? bbi * kv * db : 0.f; qf[e] = (j <= i) ? qv * df : 0.f; qb[e] = (j >= i) ? qv * db : 0.f; }
            *(LAS f32x4*)(af + i * 64 + j0) = (f32x4){vf[0], vf[1], vf[2], vf[3]}; *(LAS f32x4*)(af + i * 64 + j0 + 4) = (f32x4){vf[4], vf[5], vf[6], vf[7]};
            *(LAS f32x4*)(ab + (63 - i) * 64 + 56 - j0) = (f32x4){vb[7], vb[6], vb[5], vb[4]}; *(LAS f32x4*)(ab + (63 - i) * 64 + 60 - j0) = (f32x4){vb[3], vb[2], vb[1], vb[0]};
            u32x4 w1, w2; w1.x = pkbf(qf[0], qf[1]); w1.y = pkbf(qf[2], qf[3]); w1.z = pkbf(qf[4], qf[5]); w1.w = pkbf(qf[6], qf[7]);
            w2.x = pkbf(qb[0], qb[1]); w2.y = pkbf(qb[2], qb[3]); w2.z = pkbf(qb[4], qb[5]); w2.w = pkbf(qb[6], qb[7]);
            *(u32x4*)(qkf + i * 64 + j0) = w1; *(u32x4*)(qkb + i * 64 + j0) = w2;
        }
        __syncthreads();
        {
            const int sd = wid >> 2, r4 = lane & 3, c = 16 * (wid & 3) + (lane >> 2);
            const LAS float* A = (const LAS float*)(L + (sd ? AB : AF)) + r4;
            float to[16];
#pragma unroll
            for (int m = 0; m < 16; ++m) to[m] = 0.f;
            float ar3[3][16];
            ar3[1][0] = A[1 * 64];
            ar3[2][0] = A[2 * 64];
            if (r4 == 0) to[0] = (c == 0) ? 1.f : 0.f;
#define GDNA_ROW(i) { constexpr int NM = ((i) + 3) / 4, NP2 = ((i) + 5) / 4; \
                if ((i) + 2 < 64) { _Pragma("unroll") for (int m = 0; m < NP2; ++m) ar3[((i) + 2) % 3][m] = A[((i) + 2) * 64 + 4 * m]; } \
                float p0 = 0.f, p1 = 0.f; \
                _Pragma("unroll") for (int m = 0; m < NM; ++m) { if (m & 1) p1 = fmaf(ar3[(i) % 3][m], to[m], p1); else p0 = fmaf(ar3[(i) % 3][m], to[m], p0); } \
                float ps = p0 + p1; \
                ps += __int_as_float(__builtin_amdgcn_update_dpp(0, __float_as_int(ps), 0xB1, 0xF, 0xF, true));     \
                ps += __int_as_float(__builtin_amdgcn_update_dpp(0, __float_as_int(ps), 0x4E, 0xF, 0xF, true));     \
                const float val = ((c == (i)) ? 1.f : 0.f) - ps; \
                to[(i) >> 2] = (r4 == ((i) & 3)) ? val : to[(i) >> 2]; asm volatile("" ::: "memory"); }
#define GDNA_ROWS8(b) GDNA_ROW(b) GDNA_ROW(b + 1) GDNA_ROW(b + 2) GDNA_ROW(b + 3) GDNA_ROW(b + 4) GDNA_ROW(b + 5) GDNA_ROW(b + 6) GDNA_ROW(b + 7)
            GDNA_ROW(1) GDNA_ROW(2) GDNA_ROW(3) GDNA_ROW(4) GDNA_ROW(5) GDNA_ROW(6) GDNA_ROW(7)
            GDNA_ROWS8(8) GDNA_ROWS8(16) GDNA_ROWS8(24) GDNA_ROWS8(32) GDNA_ROWS8(40) GDNA_ROWS8(48) GDNA_ROWS8(56)
#undef GDNA_ROWS8
#undef GDNA_ROW
            const int cc = sd ? 63 - c : c; const float be = sc[128 + sd * 64 + cc], s1 = be * __expf(sc[256 + sd * 64 + cc]);
            LAS bf16_t* T1 = (LAS bf16_t*)(L + (sd ? TB : TF)); LAS bf16_t* T2 = T1 + 64 * 72;
#pragma unroll
            for (int m = 0; m < 16; ++m) { const int j = 4 * m + r4, ii = sd ? 63 - j : j; T1[ii * 72 + cc] = f2bf(to[m] * s1); T2[ii * 72 + cc] = f2bf(to[m] * be); }
        }
        {
            bf16_t* kt = GKT + (size_t)item * 8192;
#pragma unroll
            for (int i = 0; i < 2; ++i) { const int e = THR + i * NT, row = e >> 3, ch = e & 7; *(u32x4*)(kt + row * 64 + ch * 8) = *(const LAS u32x4*)(L + KT + row * 144 + ch * 16); }
            if (THR < 128) { const int dir = THR >> 6, i = THR & 63; const float gc = sc[256 + dir * 64 + i], gl = sc[256 + dir * 64 + (dir ? 0 : 63)];
                float* o = GSC + (size_t)(item * 2 + dir) * 132; o[i] = __expf(gc); o[64 + i] = __expf(gl - gc); if (i == 0) o[128] = __expf(gl); }
        }
        __syncthreads();
#pragma unroll 4
        for (int ti = 0; ti < 16; ++ti) { const int id = wid * 16 + ti, dir = id >> 6, isU = (id >> 5) & 1, x = (id >> 2) & 7, y = id & 3;
            const int t1 = dir ? TB : TF; f32x4 acc = {0.f, 0.f, 0.f, 0.f};
#pragma unroll
            for (int s2 = 0; s2 < 2; ++s2) {
                bf16x8 a, bb;
                if (!isU) { a = *(const LAS bf16x8*)(L + KT + (16 * x + l15) * 144 + (32 * s2 + 8 * q4) * 2); bb = *(const LAS bf16x8*)(L + t1 + (16 * y + l15) * 144 + (32 * s2 + 8 * q4) * 2); }
                else { a = *(const LAS bf16x8*)(L + t1 + 64 * 144 + (16 * y + l15) * 144 + (32 * s2 + 8 * q4) * 2); bb = *(const LAS bf16x8*)(L + VT + (16 * x + l15) * 144 + (32 * s2 + 8 * q4) * 2); }
                acc = __builtin_amdgcn_mfma_f32_16x16x32_bf16(a, bb, acc, 0, 0, 0); }
            const bf16x4 o = pack4(acc[0], acc[1], acc[2], acc[3]);
            if (!isU) *(bf16x4*)(GW + (size_t)(item * 2 + dir) * 8192 + (16 * y + l15) * 128 + 16 * x + 4 * q4) = o;
            else *(bf16x4*)(GUT + (size_t)(item * 2 + dir) * 8192 + (16 * x + l15) * 64 + 16 * y + 4 * q4) = o; }
#pragma unroll
        for (int mat = 0; mat < 3; ++mat)
#pragma unroll
            for (int r = 0; r < 12; ++r) rawc[mat][r] = rawn[mat][r];
        bac = ban;
        __syncthreads();
    }
}

__device__ __forceinline__ void ph_gdnb(const Params& p, float* smem) {
    if (blockIdx.x >= B_ * NH * 2 * 2) return;
    LAS unsigned char* L = (LAS unsigned char*)smem;
    constexpr int BUF = 62464 + 1024, OW = 0, OQ = 17408, OK_ = 34816, OQK = 53248, OSC = 62464;
    const int half = (blockIdx.x >> 3) & 1, seq = (blockIdx.x & 7) | ((blockIdx.x >> 4) << 3), dir = seq & 1, h = (seq >> 1) & 3, b = seq >> 3;
    const bf16_t* GQN = (const bf16_t*)(p.ws + WS_GQN);
    const bf16_t* GW = (const bf16_t*)(p.ws + WS_GW); const bf16_t* GUT = (const bf16_t*)(p.ws + WS_GUT); const bf16_t* GQK = (const bf16_t*)(p.ws + WS_GQK); const bf16_t* GKT = (const bf16_t*)(p.ws + WS_GKT);
    const float* GSC = (const float*)((unsigned char*)p.out + OUT_GSC);
    bf16_t* GO = (bf16_t*)((unsigned char*)p.out + OUT_GO) + (size_t)dir * T_ * GDW;
    auto stage = [&](int n, int buf, int tt, auto nth_tag) {
        constexpr int NTH = decltype(nth_tag)::value, NCH = 3584 / NTH;
        const int item = (b * 4 + h) * 32 + n;
        u32x4 d[NCH];
#pragma unroll
        for (int i = 0; i < NCH; ++i) { const int e = tt + i * NTH; const u32x4* src;
            if (e < 1024) src = (const u32x4*)(GW + (size_t)(item * 2 + dir) * 8192) + e;
            else if (e < 2048) src = (const u32x4*)(GQN + (size_t)item * 8192) + (e - 1024);
            else if (e < 3072) src = (const u32x4*)(GKT + (size_t)item * 8192) + (e - 2048);
            else src = (const u32x4*)(GQK + (size_t)(item * 2 + dir) * 4096) + (e - 3072);
            d[i] = *src; }
        const float scv = (tt < 132) ? GSC[(size_t)(item * 2 + dir) * 132 + tt] : 0.f;
#pragma unroll
        for (int i = 0; i < NCH; ++i) { const int e = tt + i * NTH; int off;
            if (e < 1024) off = OW + (e >> 4) * 272 + (e & 15) * 16;
            else if (e < 2048) off = OQ + ((e - 1024) >> 4) * 272 + (e & 15) * 16;
            else if (e < 3072) off = OK_ + ((e - 2048) >> 3) * 144 + (e & 7) * 16;
            else off = OQK + ((e - 3072) >> 3) * 144 + (e & 7) * 16;
            *(LAS u32x4*)(L + buf * BUF + off) = d[i]; }
        if (tt < 132) *(LAS float*)(L + buf * BUF + OSC + tt * 4) = scv;
    };
    auto loadu = [&](bf16x4 (&u)[4], int n) {
        const int THR = ltid(); const int lane = THR & 63, wid = THR >> 6, l15 = lane & 15, q4 = lane >> 4, dv0 = half * 64 + (wid & 3) * 16;
        const bf16_t* ut = GUT + (size_t)(((b * 4 + h) * 32 + n) * 2 + dir) * 8192 + (size_t)(dv0 + l15) * 64 + 4 * q4;
#pragma unroll
        for (int mt = 0; mt < 4; ++mt) u[mt] = *(const bf16x4*)(ut + 16 * mt);
    };
    f32x4 S[8]; bf16x8 Sb[4];
#pragma unroll
    for (int i = 0; i < 8; ++i) S[i] = (f32x4){0.f, 0.f, 0.f, 0.f};
#pragma unroll
    for (int i = 0; i < 4; ++i) Sb[i] = (bf16x8){0, 0, 0, 0, 0, 0, 0, 0};
    auto compute = [&](int n, int buf, const bf16x4 (&uraw)[4]) {
        const int THR = ltid(); const int lane = THR & 63, wid = THR >> 6, l15 = lane & 15, q4 = lane >> 4, dv0 = half * 64 + (wid & 3) * 16;
        const LAS unsigned char* Bf = L + buf * BUF; const LAS float* scl = (const LAS float*)(Bf + OSC);
        f32x4 ws[4], qs[4];
        {
            bf16x8 fa[4][4];
#pragma unroll
            for (int mt = 0; mt < 4; ++mt)
#pragma unroll
                for (int s4 = 0; s4 < 4; ++s4) { const LAS unsigned char* r = Bf + OW + (16 * mt + l15) * 272 + (32 * s4 + 4 * q4) * 2; fa[mt][s4] = cat44(*(const LAS bf16x4*)r, *(const LAS bf16x4*)(r + 32)); }
#pragma unroll
            for (int mt = 0; mt < 4; ++mt) { ws[mt] = (f32x4){0.f, 0.f, 0.f, 0.f};
#pragma unroll
                for (int s4 = 0; s4 < 4; ++s4) ws[mt] = __builtin_amdgcn_mfma_f32_16x16x32_bf16(fa[mt][s4], Sb[s4], ws[mt], 0, 0, 0); }
        }
        {
            bf16x8 fa[4][4];
#pragma unroll
            for (int mt = 0; mt < 4; ++mt)
#pragma unroll
                for (int s4 = 0; s4 < 4; ++s4) { const LAS unsigned char* r = Bf + OQ + (16 * mt + l15) * 272 + (32 * s4 + 4 * q4) * 2; fa[mt][s4] = cat44(*(const LAS bf16x4*)r, *(const LAS bf16x4*)(r + 32)); }
#pragma unroll
            for (int mt = 0; mt < 4; ++mt) { qs[mt] = (f32x4){0.f, 0.f, 0.f, 0.f};
#pragma unroll
                for (int s4 = 0; s4 < 4; ++s4) qs[mt] = __builtin_amdgcn_mfma_f32_16x16x32_bf16(fa[mt][s4], Sb[s4], qs[mt], 0, 0, 0); }
        }
        f32x4 vn[4], vs[4];
#pragma unroll
        for (int mt = 0; mt < 4; ++mt) { const f32x4 es = *(const LAS f32x4*)(scl + 64 + 16 * mt + 4 * q4);
#pragma unroll
            for (int r = 0; r < 4; ++r) { const float u = __uint_as_float(((unsigned)(unsigned short)uraw[mt][r]) << 16); vn[mt][r] = u - ws[mt][r]; vs[mt][r] = vn[mt][r] * es[r]; } }
        bf16x8 vb[2], vsb[2];
#pragma unroll
        for (int s2 = 0; s2 < 2; ++s2) { vb[s2] = cat44(pack4(vn[2 * s2][0], vn[2 * s2][1], vn[2 * s2][2], vn[2 * s2][3]), pack4(vn[2 * s2 + 1][0], vn[2 * s2 + 1][1], vn[2 * s2 + 1][2], vn[2 * s2 + 1][3]));
            vsb[s2] = cat44(pack4(vs[2 * s2][0], vs[2 * s2][1], vs[2 * s2][2], vs[2 * s2][3]), pack4(vs[2 * s2 + 1][0], vs[2 * s2 + 1][1], vs[2 * s2 + 1][2], vs[2 * s2 + 1][3])); }
        bf16x8 fk[8][2];
        {
            bf16x8 fq[4][2];
#pragma unroll
            for (int it = 0; it < 4; ++it)
#pragma unroll
                for (int s2 = 0; s2 < 2; ++s2) { const LAS unsigned char* r = Bf + OQK + (16 * it + l15) * 144 + (32 * s2 + 4 * q4) * 2; fq[it][s2] = cat44(*(const LAS bf16x4*)r, *(const LAS bf16x4*)(r + 32)); }
#pragma unroll
            for (int t8 = 0; t8 < 8; ++t8)
#pragma unroll
                for (int s2 = 0; s2 < 2; ++s2) { const LAS unsigned char* r = Bf + OK_ + (16 * t8 + l15) * 144 + (32 * s2 + 4 * q4) * 2; fk[t8][s2] = cat44(*(const LAS bf16x4*)r, *(const LAS bf16x4*)(r + 32)); }
#pragma unroll
            for (int it = 0; it < 4; ++it) { f32x4 o2 = {0.f, 0.f, 0.f, 0.f};
#pragma unroll
                for (int s2 = 0; s2 < 2; ++s2) o2 = __builtin_amdgcn_mfma_f32_16x16x32_bf16(fq[it][s2], vb[s2], o2, 0, 0, 0);
                const f32x4 eg4 = *(const LAS f32x4*)(scl + 16 * it + 4 * q4);
#pragma unroll
                for (int r = 0; r < 4; ++r) { const int tok = 16 * it + 4 * q4 + r; const float o = eg4[r] * qs[it][r] + o2[r];
                    GO[((size_t)b * S_ + n * 64 + tok) * GDW + h * 128 + dv0 + l15] = f2bf(o); } }
        }
        const float eg = scl[128];
#pragma unroll
        for (int t8 = 0; t8 < 8; ++t8) { f32x4 c = S[t8] * eg;
#pragma unroll
            for (int s2 = 0; s2 < 2; ++s2) c = __builtin_amdgcn_mfma_f32_16x16x32_bf16(fk[t8][s2], vsb[s2], c, 0, 0, 0);
            S[t8] = c; }
#pragma unroll
        for (int s4 = 0; s4 < 4; ++s4) Sb[s4] = cat44(pack4(S[2 * s4][0], S[2 * s4][1], S[2 * s4][2], S[2 * s4][3]), pack4(S[2 * s4 + 1][0], S[2 * s4 + 1][1], S[2 * s4 + 1][2], S[2 * s4 + 1][3]));
    };
    const int n0 = dir ? 31 : 0, dn = dir ? -1 : 1;
    const int wid0 = __builtin_amdgcn_readfirstlane(ltid() >> 6);
    { const int THR = ltid(); stage(n0, 0, THR, std::integral_constant<int, 512>()); }
    __syncthreads();
    if (wid0 >= 4) {
        const int tt = ltid() - 256;
        constexpr int NCH = 14;
        auto ld = [&](u32x4 (&d)[NCH], float& scv, int n) {
            const int item = (b * 4 + h) * 32 + n;
#pragma unroll
            for (int i = 0; i < NCH; ++i) { const int e = tt + i * 256; const u32x4* src;
                if (e < 1024) src = (const u32x4*)(GW + (size_t)(item * 2 + dir) * 8192) + e;
                else if (e < 2048) src = (const u32x4*)(GQN + (size_t)item * 8192) + (e - 1024);
                else if (e < 3072) src = (const u32x4*)(GKT + (size_t)item * 8192) + (e - 2048);
                else src = (const u32x4*)(GQK + (size_t)(item * 2 + dir) * 4096) + (e - 3072);
                d[i] = *src; }
            scv = (tt < 132) ? GSC[(size_t)(item * 2 + dir) * 132 + tt] : 0.f;
        };
        auto st_ = [&](const u32x4 (&d)[NCH], float scv, int buf) {
#pragma unroll
            for (int i = 0; i < NCH; ++i) { const int e = tt + i * 256; int off;
                if (e < 1024) off = OW + (e >> 4) * 272 + (e & 15) * 16;
                else if (e < 2048) off = OQ + ((e - 1024) >> 4) * 272 + (e & 15) * 16;
                else if (e < 3072) off = OK_ + ((e - 2048) >> 3) * 144 + (e & 7) * 16;
                else off = OQK + ((e - 3072) >> 3) * 144 + (e & 7) * 16;
                *(LAS u32x4*)(L + buf * BUF + off) = d[i]; }
            if (tt < 132) *(LAS float*)(L + buf * BUF + OSC + tt * 4) = scv;
        };
        u32x4 r0[NCH], r1[NCH]; float c0 = 0.f, c1 = 0.f;
        ld(r0, c0, n0 + dn);
        for (int st = 0; st < 32; st += 2) {
            if (st + 2 < 32) ld(r1, c1, n0 + dn * (st + 2));
            st_(r0, c0, 1);
            __syncthreads();
            if (st + 3 < 32) ld(r0, c0, n0 + dn * (st + 3));
            if (st + 2 < 32) st_(r1, c1, 0);
            __syncthreads();
        }
    } else {
        bf16x4 uA[4], uB[4];
        loadu(uA, n0); loadu(uB, n0 + dn);
        for (int st = 0; st < 32; st += 2) {
            { bf16x4 uc[4];
#pragma unroll
              for (int mt = 0; mt < 4; ++mt) uc[mt] = uA[mt];
              if (st + 2 < 32) loadu(uA, n0 + dn * (st + 2));
              compute(n0 + dn * st, 0, uc);
              __syncthreads(); }
            { bf16x4 uc[4];
#pragma unroll
              for (int mt = 0; mt < 4; ++mt) uc[mt] = uB[mt];
              if (st + 3 < 32) loadu(uB, n0 + dn * (st + 3));
              compute(n0 + dn * (st + 1), 1, uc);
              __syncthreads(); }
        }
    }
}
__device__ __forceinline__ void ph_gdncomb(const Params& p, float* smem) {
    const int THR = ltid();
    const bf16_t* O = (const bf16_t*)((unsigned char*)p.out + OUT_GO); const bf16_t* zb = (const bf16_t*)(p.ws + WS_ZB); bf16_t* cat = (bf16_t*)(p.ws + WS_CAT); const float* gn = p.in[I_GDN_NORM];
    const int lane = THR & 63, gw = blockIdx.x * NW + (THR >> 6), nw = gridDim.x * NW;
    const f4_t g0 = ((const f4_t*)gn)[(lane & 15) * 2], g1 = ((const f4_t*)gn)[(lane & 15) * 2 + 1];
    const float gg[8] = {g0.x, g0.y, g0.z, g0.w, g1.x, g1.y, g1.z, g1.w};
    const float* ssq5 = (const float*)(p.ws + WS_SSQ); const f4_t n0 = ((const f4_t*)p.in[I_S5_NORM])[lane * 2], n1 = ((const f4_t*)p.in[I_S5_NORM])[lane * 2 + 1];
    const float nn[8] = {n0.x, n0.y, n0.z, n0.w, n1.x, n1.y, n1.z, n1.w};
    for (int t0 = gw * 4; t0 < T_; t0 += nw * 4) {
        u4_t of[4], ob[4], zz[4], s5[4]; float r5[4];
#pragma unroll
        for (int r = 0; r < 4; ++r) { const size_t t = t0 + r; s5[r] = ((const u4_t*)(cat + t * D_))[lane]; r5[r] = rsqrtf(ssq5[t] * (1.f / (float)S5W) + RMS_EPS); of[r] = ((const u4_t*)(O + t * GDW))[lane]; ob[r] = ((const u4_t*)(O + (size_t)T_ * GDW + t * GDW))[lane]; zz[r] = ((const u4_t*)(zb + t * GDW))[lane]; }
#pragma unroll
        for (int r = 0; r < 4; ++r) {
            float a[8]; float ss = 0.f;
#pragma unroll
            for (int k = 0; k < 4; ++k) { a[2 * k] = bflo(of[r][k]) + bflo(ob[r][k]); a[2 * k + 1] = bfhi(of[r][k]) + bfhi(ob[r][k]); ss += a[2 * k] * a[2 * k] + a[2 * k + 1] * a[2 * k + 1]; }
            ss = dpp_sum16(ss);
            const float rs = rsqrtf(ss * (1.f / 128.f) + RMS_EPS);
            float o[8];
#pragma unroll
            for (int k = 0; k < 4; ++k) { o[2 * k] = a[2 * k] * rs * gg[2 * k] * siluf_(bflo(zz[r][k])); o[2 * k + 1] = a[2 * k + 1] * rs * gg[2 * k + 1] * siluf_(bfhi(zz[r][k])); }
            u4_t w; w.x = pkbf(o[0], o[1]); w.y = pkbf(o[2], o[3]); w.z = pkbf(o[4], o[5]); w.w = pkbf(o[6], o[7]);
            ((u4_t*)(cat + (size_t)(t0 + r) * D_ + 512))[lane] = w;
            u4_t v5;
#pragma unroll
            for (int k = 0; k < 4; ++k) v5[k] = pkbf(bflo(s5[r][k]) * r5[r] * nn[2 * k], bfhi(s5[r][k]) * r5[r] * nn[2 * k + 1]);
            ((u4_t*)(cat + (size_t)(t0 + r) * D_))[lane] = v5; }
    }
}
__device__ __forceinline__ void ph_router(const Params& p, float* smem) {
    const int THR = ltid();
    const bf16_t* x2 = (const bf16_t*)(p.ws + WS_XB); bf16_t* xs = (bf16_t*)(p.ws + WS_XS); int* route = (int*)(p.ws + WS_ROUTE); int* mc = (int*)(p.ws + WS_CNT);
    const float* gn = p.in[I_NORM_MOE]; const float* bg = p.in[I_RG_B]; const float* be = p.in[I_RE_B]; const float* WrT = (const float*)(p.ws + WS_WRT);
    const int lane = THR & 63, gw = blockIdx.x * NW + (THR >> 6), nw = gridDim.x * NW;
    { LAS f4_t* lw = (LAS f4_t*)smem; const f4_t* src = (const f4_t*)(WrT + 4 * D_);
#pragma unroll 4
      for (int i = THR; i < 32 * D_ / 4; i += NT) lw[i] = src[i]; }
    __syncthreads();
    for (int t0 = gw * 4; t0 < T_; t0 += nw * 4) {
        f4_t xv[4][4]; float rs[4];
        { u2_t raw[4][4];
#pragma unroll
          for (int r = 0; r < 4; ++r)
#pragma unroll
            for (int j = 0; j < 4; ++j) raw[r][j] = ((const u2_t*)(x2 + (size_t)(t0 + r) * D_))[lane + 64 * j];
#pragma unroll
          for (int r = 0; r < 4; ++r)
#pragma unroll
            for (int j = 0; j < 4; ++j) xv[r][j] = (f4_t){bflo(raw[r][j].x), bfhi(raw[r][j].x), bflo(raw[r][j].y), bfhi(raw[r][j].y)}; }
#pragma unroll
        for (int r = 0; r < 4; ++r) { float ss = 0.f;
#pragma unroll
            for (int j = 0; j < 4; ++j) ss += xv[r][j].x * xv[r][j].x + xv[r][j].y * xv[r][j].y + xv[r][j].z * xv[r][j].z + xv[r][j].w * xv[r][j].w;
            rs[r] = rsqrtf(wave_sum(ss) * (1.f / (float)D_) + RMS_EPS); }
        LAS float* lgs = (LAS float*)smem + 32768 + (THR >> 6) * 160;
        const float* Wl = WrT + lane * 4; const LAS float* Ll = (const LAS float*)smem + lane * 4;
#pragma unroll 2
        for (int o = 0; o < 4; ++o) {
            f4_t w[4];
#pragma unroll
            for (int j = 0; j < 4; ++j) w[j] = *(const f4_t*)(Wl + (size_t)o * D_ + 256 * j);
            const float bias = bg[o];
#pragma unroll
            for (int r = 0; r < 4; ++r) { float a = 0.f;
#pragma unroll
                for (int j = 0; j < 4; ++j) a += xv[r][j].x * w[j].x + xv[r][j].y * w[j].y + xv[r][j].z * w[j].z + xv[r][j].w * w[j].w;
                const float tot = wave_sum(a) * rs[r] + bias; if (lane == 0) lgs[r * 40 + o] = tot; }
        }
#pragma unroll 2
        for (int o = 0; o < 32; ++o) {
            f4_t w[4];
#pragma unroll
            for (int j = 0; j < 4; ++j) w[j] = *(const LAS f4_t*)(Ll + o * D_ + 256 * j);
            const float bias = be[o];
#pragma unroll
            for (int r = 0; r < 4; ++r) { float a = 0.f;
#pragma unroll
                for (int j = 0; j < 4; ++j) a += xv[r][j].x * w[j].x + xv[r][j].y * w[j].y + xv[r][j].z * w[j].z + xv[r][j].w * w[j].w;
                const float tot = wave_sum(a) * rs[r] + bias; if (lane == 0) lgs[r * 40 + 4 + o] = tot; }
        }
        asm volatile("s_waitcnt lgkmcnt(0)" ::: "memory");
        float mine[36];
        if (lane < 4) {
#pragma unroll
            for (int o = 0; o < 36; ++o) mine[o] = lgs[lane * 40 + o];
        }
        int r0v = 0, r1v = 0;
        if (lane < 4) {
            int gi = 0; float gm = mine[0];
#pragma unroll
            for (int g = 1; g < 4; ++g) if (mine[g] > gm) { gm = mine[g]; gi = g; }
            float gs = 0.f;
#pragma unroll
            for (int g = 0; g < 4; ++g) gs += __expf(mine[g] - gm);
            const float ptop = 1.f / gs;
            float el[8];
#pragma unroll
            for (int e = 0; e < 8; ++e) { float v = mine[4 + e];
#pragma unroll
                for (int g = 1; g < 4; ++g) v = (gi == g) ? mine[4 + g * 8 + e] : v;
                el[e] = v; }
            int i0 = 0; float v0 = el[0];
#pragma unroll
            for (int e = 1; e < 8; ++e) if (el[e] > v0) { v0 = el[e]; i0 = e; }
            int i1 = -1; float v1 = -1e30f;
#pragma unroll
            for (int e = 0; e < 8; ++e) if (e != i0 && el[e] > v1) { v1 = el[e]; i1 = e; }
            const float e1 = __expf(v1 - v0), w0 = ptop / (1.f + e1), w1 = ptop * e1 / (1.f + e1);
            const int ea = gi * 8 + i0, eb = gi * 8 + i1;
            const int pa = atomicAdd(mc + ea, 1), pbb = atomicAdd(mc + eb, 1);
            unsigned* ma = (unsigned*)mc + MC_MAP + ea * 128 + (pa >> 8); unsigned* mb = (unsigned*)mc + MC_MAP + eb * 128 + (pbb >> 8);
            if ((pa & 255) == 0)  { const int tid = atomicAdd(mc + MC_NT, 1); mc[MC_REV + tid] = ea; __hip_atomic_store(ma, (unsigned)tid + 1u, __ATOMIC_RELAXED, __HIP_MEMORY_SCOPE_AGENT); }
            if ((pbb & 255) == 0) { const int tid = atomicAdd(mc + MC_NT, 1); mc[MC_REV + tid] = eb; __hip_atomic_store(mb, (unsigned)tid + 1u, __ATOMIC_RELAXED, __HIP_MEMORY_SCOPE_AGENT); }
            asm volatile("" ::: "memory");
            unsigned ta, tb, sp = 0u;
            while ((ta = __hip_atomic_load(ma, __ATOMIC_RELAXED, __HIP_MEMORY_SCOPE_AGENT)) == 0u) { __builtin_amdgcn_s_sleep(1); if (++sp > (1u << 22)) break; }
            while ((tb = __hip_atomic_load(mb, __ATOMIC_RELAXED, __HIP_MEMORY_SCOPE_AGENT)) == 0u) { __builtin_amdgcn_s_sleep(1); if (++sp > (1u << 22)) break; }
            r0v = (int)(ta - 1u) * 256 + (pa & 255); r1v = (int)(tb - 1u) * 256 + (pbb & 255);
            int* rr = route + (size_t)(t0 + lane) * 8; rr[0] = ea; rr[1] = eb; ((float*)rr)[2] = w0; ((float*)rr)[3] = w1; rr[6] = r0v; rr[7] = r1v;
        }
#pragma unroll
        for (int r = 0; r < 4; ++r) {
            const int d0 = __builtin_amdgcn_readlane(r0v, r), d1 = __builtin_amdgcn_readlane(r1v, r);
            u2_t* q0 = (u2_t*)(xs + (size_t)d0 * D_); u2_t* q1 = (u2_t*)(xs + (size_t)d1 * D_);
#pragma unroll
            for (int j = 0; j < 4; ++j) { const f4_t g = ((const f4_t*)gn)[lane + 64 * j]; const f4_t o = xv[r][j] * rs[r] * g; u2_t w; w.x = pkbf(o.x, o.y); w.y = pkbf(o.z, o.w); q0[lane + 64 * j] = w; q1[lane + 64 * j] = w; } }
    }
}
__device__ __forceinline__ void moe_build_table(const Params& p, int* tab) {
    const int THR = ltid();
    const int* mc = (const int*)(p.ws + WS_CNT);
    if (THR == 0) tab[0] = mc[MC_NT];
    if (THR < 160) tab[40 + THR] = mc[MC_REV + THR];
    __syncthreads();
}
__device__ __forceinline__ void ph_final(const Params& p, float* smem) {
    const int THR = ltid();
    float* out = p.out; const bf16_t* x2 = (const bf16_t*)(p.ws + WS_XB); const float* gn = p.in[I_NORM_FINAL]; const bf16_t* Y = (const bf16_t*)(p.ws + WS_XS); const int* route = (const int*)(p.ws + WS_ROUTE);
    const int lane = THR & 63, gw = blockIdx.x * NW + (THR >> 6), nw = gridDim.x * NW;
    f4_t g[4];
#pragma unroll
    for (int j = 0; j < 4; ++j) g[j] = ((const f4_t*)gn)[lane + 64 * j];
    for (int t0 = gw * 2; t0 < T_; t0 += nw * 2) {
        f4_t xv[2][4]; u2_t xr[2][4], ya[2][4], yb[2][4]; float w0[2], w1[2];
#pragma unroll
        for (int r = 0; r < 2; ++r) { const int* rr = route + (size_t)(t0 + r) * 8; w0[r] = ((const float*)rr)[2]; w1[r] = ((const float*)rr)[3];
            const u2_t* y0 = (const u2_t*)(Y + (size_t)rr[6] * D_); const u2_t* y1 = (const u2_t*)(Y + (size_t)rr[7] * D_);
#pragma unroll
            for (int j = 0; j < 4; ++j) { xr[r][j] = ((const u2_t*)(x2 + (size_t)(t0 + r) * D_))[lane + 64 * j]; ya[r][j] = y0[lane + 64 * j]; yb[r][j] = y1[lane + 64 * j]; } }
#pragma unroll
        for (int r = 0; r < 2; ++r) { float ss = 0.f;
#pragma unroll
            for (int j = 0; j < 4; ++j) { f4_t v = (f4_t){bflo(xr[r][j].x), bfhi(xr[r][j].x), bflo(xr[r][j].y), bfhi(xr[r][j].y)};
                v.x += w0[r] * bflo(ya[r][j].x) + w1[r] * bflo(yb[r][j].x); v.y += w0[r] * bfhi(ya[r][j].x) + w1[r] * bfhi(yb[r][j].x);
                v.z += w0[r] * bflo(ya[r][j].y) + w1[r] * bflo(yb[r][j].y); v.w += w0[r] * bfhi(ya[r][j].y) + w1[r] * bfhi(yb[r][j].y);
                xv[r][j] = v; ss += v.x * v.x + v.y * v.y + v.z * v.z + v.w * v.w; }
            const float rs = rsqrtf(wave_sum(ss) * (1.f / (float)D_) + RMS_EPS);
#pragma unroll
            for (int j = 0; j < 4; ++j) ((f4_t*)(out + (size_t)(t0 + r) * D_))[lane + 64 * j] = xv[r][j] * rs * g[j]; }
    }
}


typedef pg8::f32x4 f32x4; typedef pg8::u32x4 u32x4;

__device__ __forceinline__ void transpose_item(const float* W, int K, int N, bf16_t* WT, int ldt, int dst_row0, int k0, int n0, const float* rowscale, LAS float* scr, int lane) {
    f4_t v[8];
#pragma unroll
    for (int i = 0; i < 8; ++i) v[i] = *(const f4_t*)(W + (size_t)(k0 + (lane >> 3) + 8 * i) * N + n0 + 4 * (lane & 7));
#pragma unroll
    for (int i = 0; i < 8; ++i) { const int kk = (lane >> 3) + 8 * i; f4_t x = v[i]; if (rowscale) x = x * rowscale[k0 + kk];
        LAS float* d = scr + kk * 33 + 4 * (lane & 7); d[0] = x.x; d[1] = x.y; d[2] = x.z; d[3] = x.w; }
    asm volatile("s_waitcnt lgkmcnt(0)" ::: "memory");
    const int c = lane & 7;
#pragma unroll
    for (int j = 0; j < 4; ++j) { const int n = (lane >> 3) + 8 * j; const LAS float* sp = scr + (8 * c) * 33 + n;
        u32x4 o; o.x = pg8::cvt_pk_bf16(sp[0 * 33], sp[1 * 33]); o.y = pg8::cvt_pk_bf16(sp[2 * 33], sp[3 * 33]); o.z = pg8::cvt_pk_bf16(sp[4 * 33], sp[5 * 33]); o.w = pg8::cvt_pk_bf16(sp[6 * 33], sp[7 * 33]);
        *(u32x4*)(WT + (size_t)(dst_row0 + n) * ldt + k0 + 8 * c) = o; }
    asm volatile("s_waitcnt lgkmcnt(0)" ::: "memory");
}
__device__ __forceinline__ void transpose_matrix(const float* W, int K, int N, bf16_t* WT, const float* rowscale, float* smem) {
    const int THR = ltid();
    const int lane = THR & 63, wv = THR >> 6; LAS float* scr = (LAS float*)smem + wv * (64 * 33);
    const int gw = blockIdx.x * NW + wv, nw = gridDim.x * NW, nblk = N / 32, items = (K / 64) * nblk;
    for (int it = gw; it < items; it += nw) { const int kb = it / nblk, nb = it % nblk; transpose_item(W, K, N, WT, K, nb * 32, kb * 64, nb * 32, rowscale, scr, lane); }
}
__device__ __forceinline__ void ph_prep0(const Params& p, float* smem) {
    const int THR = ltid();
    bf16_t* WinT = (bf16_t*)((unsigned char*)p.out + OUT_WINT);
    {
        const int lane = THR & 63, wv = THR >> 6; LAS float* scr = (LAS float*)smem + wv * (64 * 33);
        const int gw = blockIdx.x * NW + wv, nw = gridDim.x * NW, nblk = 2560 / 32, items = 16 * nblk;
        for (int it = gw; it < items; it += nw) { const int kb = it / nblk, nb = it % nblk; transpose_item(p.in[I_W_IN], D_, DIN, WinT, D_, nb * 32, kb * 64, nb * 32, nullptr, scr, lane); }
        for (size_t i = (size_t)blockIdx.x * NT + THR; i < (size_t)256 * D_; i += (size_t)gridDim.x * NT) {
            const int n = (int)(i / D_), k = (int)(i % D_);
            WinT[(size_t)(2560 + n) * D_ + k] = n < 16 ? f2bf(p.in[I_W_IN][(size_t)k * DIN + 2560 + n]) : (bf16_t)0;
        }
    }
    transpose_matrix(p.in[I_W_GLU], S5W, S5W, (bf16_t*)((unsigned char*)p.out + OUT_WGLUT), nullptr, smem);
    transpose_matrix(p.in[I_WK], D_, D_, (bf16_t*)((unsigned char*)p.out + OUT_WKT), nullptr, smem);
    transpose_matrix(p.in[I_WV], D_, D_, (bf16_t*)((unsigned char*)p.out + OUT_WVT), nullptr, smem);
    { float* ssq = (float*)(p.ws + WS_SSQ); for (int i = blockIdx.x * NT + THR; i < 2 * T_; i += gridDim.x * NT) ssq[i] = 0.f; }
}
__device__ __forceinline__ void ph_prep1(const Params& p, float* smem) {
    transpose_matrix(p.in[I_W_OUT], D_, D_, (bf16_t*)(p.ws + WS_WOUTT), nullptr, smem);
}
__device__ __forceinline__ void ph_prepa(const Params& p, float* smem) {
    const int THR = ltid();
    bf16_t* WqB = (bf16_t*)(p.ws + WS_WQB); const float* wq = p.in[I_WQ]; const float* gx = p.in[I_NORM_XA];
    for (int i = blockIdx.x * NT + THR; i < D_ * D_ / 4; i += gridDim.x * NT) { const f4_t v = ((const f4_t*)wq)[i] * gx[i >> 8]; u2_t w; w.x = pkbf(v.x, v.y); w.y = pkbf(v.z, v.w); ((u2_t*)WqB)[i] = w; }
    transpose_matrix(p.in[I_WO], D_, D_, (bf16_t*)(p.ws + WS_WOT), nullptr, smem);
}
__device__ __forceinline__ void ph_prep2(const Params& p, float* smem) {
    const int THR = ltid();
    const int lane = THR & 63, wv = THR >> 6; LAS float* scr = (LAS float*)smem + wv * (64 * 33);
    const int gw = blockIdx.x * NW + wv, nw = gridDim.x * NW;
    bf16_t* WguT = (bf16_t*)(p.ws + WS_WGUT);
    if (blockIdx.x == 0) for (int i = THR; i < MC_WORDS; i += NT) ((int*)(p.ws + WS_CNT))[i] = 0;
    { float* WrT = (float*)(p.ws + WS_WRT); const float* gnm = p.in[I_NORM_MOE];
      for (int i = blockIdx.x * NT + THR; i < 36 * D_; i += gridDim.x * NT) { const int o = i >> 10, k = i & 1023; WrT[i] = gnm[k] * (o < 4 ? p.in[I_RG_W][k * 4 + o] : p.in[I_RE_W][k * NE + (o - 4)]); } }
    for (int it = gw; it < NE * 2 * 128; it += nw) {
        const int e = it >> 8, which = (it >> 7) & 1, r = it & 127, kb = r >> 3, nb = r & 7, f0 = nb * 32;
        const float* W = p.in[which ? I_WUP : I_WGATE] + (size_t)e * D_ * DE;
        transpose_item(W, D_, DE, WguT, D_, e * 512 + (f0 >> 7) * 256 + which * 128 + (f0 & 127), kb * 64, f0, nullptr, scr, lane);
    }
}
__device__ __forceinline__ void prep_wdown_idle(const Params& p, float* smem, int first) {
    const int THR = ltid();
    const int lane = THR & 63, wv = THR >> 6; LAS float* scr = (LAS float*)smem + wv * (64 * 33);
    bf16_t* WdT = (bf16_t*)(p.ws + WS_WDT);
    const int c = (int)blockIdx.x - first; if (c < 0) return;
    const int gw = c * NW + wv, nw = ((int)gridDim.x - first) * NW;
    for (int it = gw; it < NE * 128; it += nw) {
        const int e = it >> 7, r = it & 127, kb = r >> 5, nb = r & 31;
        transpose_item(p.in[I_WDOWN] + (size_t)e * DE * D_, DE, D_, WdT, DE, e * D_ + nb * 32, kb * 64, nb * 32, nullptr, scr, lane);
    }
}

struct EpiInproj {
    static constexpr bool PERM = true;
    bf16_t* qkvr; bf16_t* zb; float* ba; bf16_t* aext;
    __device__ __forceinline__ void operator()(const f32x4 (&acc)[2][2][4][2], const pg8::Unit& u, int wr, int wc, int fr, int fq) const {
        const int row0 = u.orow + wr * 64 + fr;
        if (u.aux < 2) {
            const int col0 = u.ocol + wc * 32 + 8 * fq;
#pragma unroll
            for (int ai = 0; ai < 2; ++ai)
#pragma unroll
                for (int m = 0; m < 4; ++m) { const int t = row0 + ai * 128 + m * 16, n = t >> 4, j = t & 15;
#pragma unroll
                    for (int bj = 0; bj < 2; ++bj) { const int c = col0 + bj * 128, g = c >> 4, ci = c & 15; const f32x4 v0 = acc[ai][bj][m][0], v1 = acc[ai][bj][m][1];
                        u32x4 w; w.x = pg8::cvt_pk_bf16(v0[0], v0[1]); w.y = pg8::cvt_pk_bf16(v0[2], v0[3]); w.z = pg8::cvt_pk_bf16(v1[0], v1[1]); w.w = pg8::cvt_pk_bf16(v1[2], v1[3]);
                        *(u32x4*)(aext + ((size_t)g * 1024 + n) * 512 + j * 16 + ci) = w; } }
        } else if (u.aux < 10) {
            const int col0 = u.ocol + wc * 32 + 8 * fq;
#pragma unroll
            for (int ai = 0; ai < 2; ++ai)
#pragma unroll
                for (int m = 0; m < 4; ++m) { const int rr = row0 + ai * 128 + m * 16; bf16_t* rowp = (u.aux < 8) ? qkvr + (size_t)rr * QKV_LD + col0 - 512 : zb + (size_t)rr * GDW + col0 - 2048;
#pragma unroll
                    for (int bj = 0; bj < 2; ++bj) { const f32x4 v0 = acc[ai][bj][m][0], v1 = acc[ai][bj][m][1];
                        u32x4 w; w.x = pg8::cvt_pk_bf16(v0[0], v0[1]); w.y = pg8::cvt_pk_bf16(v0[2], v0[3]); w.z = pg8::cvt_pk_bf16(v1[0], v1[1]); w.w = pg8::cvt_pk_bf16(v1[2], v1[3]);
                        *(u32x4*)(rowp + bj * 128) = w; } }
        } else if (wc == 0 && fq < 2) {
#pragma unroll
            for (int ai = 0; ai < 2; ++ai)
#pragma unroll
                for (int m = 0; m < 4; ++m) { float* rowp = ba + (size_t)(row0 + ai * 128 + m * 16) * 16 + 8 * fq;
                    *(f32x4*)(rowp) = acc[ai][0][m][0]; *(f32x4*)(rowp + 4) = acc[ai][0][m][1]; }
        }
    }
};
struct EpiBf16Out {
    static constexpr bool PERM = true;
    bf16_t* O; int ldc; float scale; size_t aux_stride;
    __device__ __forceinline__ void operator()(const f32x4 (&acc)[2][2][4][2], const pg8::Unit& u, int wr, int wc, int fr, int fq) const {
        const int row0 = u.orow + wr * 64 + fr, col0 = u.ocol + wc * 32 + 8 * fq; bf16_t* base = O + (size_t)u.aux * aux_stride;
#pragma unroll
        for (int ai = 0; ai < 2; ++ai)
#pragma unroll
            for (int m = 0; m < 4; ++m) { bf16_t* rowp = base + (size_t)(row0 + ai * 128 + m * 16) * ldc + col0;
#pragma unroll
                for (int bj = 0; bj < 2; ++bj) { const f32x4 v0 = acc[ai][bj][m][0] * scale, v1 = acc[ai][bj][m][1] * scale;
                    u32x4 w; w.x = pg8::cvt_pk_bf16(v0[0], v0[1]); w.y = pg8::cvt_pk_bf16(v0[2], v0[3]); w.z = pg8::cvt_pk_bf16(v1[0], v1[1]); w.w = pg8::cvt_pk_bf16(v1[2], v1[3]);
                    *(u32x4*)(rowp + bj * 128) = w; } }
    }
};
struct EpiResid {
    static constexpr bool PERM = false;
    const float* base; const bf16_t* baseb; float* out; int ldc; bf16_t* xb; float* ssq;
    __device__ __forceinline__ void operator()(const f32x4 (&acc)[2][2][4][2], const pg8::Unit& u, int wr, int wc, int fr, int fq) const {
        const int row0 = u.orow + wr * 64 + fr, col0 = u.ocol + wc * 32 + 4 * fq;
#pragma unroll
        for (int ai = 0; ai < 2; ++ai)
#pragma unroll
            for (int m = 0; m < 4; ++m) { const size_t off = (size_t)(row0 + ai * 128 + m * 16) * ldc + col0; float ss = 0.f;
#pragma unroll
                for (int bj = 0; bj < 2; ++bj)
#pragma unroll
                    for (int n = 0; n < 2; ++n) { f32x4 b;
                        if (base) b = *(const f32x4*)(base + off + bj * 128 + n * 16);
                        else { const u2_t rb = *(const u2_t*)(baseb + off + bj * 128 + n * 16); b = (f32x4){bflo(rb.x), bfhi(rb.x), bflo(rb.y), bfhi(rb.y)}; }
                        const f32x4 o = b + acc[ai][bj][m][n]; if (out) *(f32x4*)(out + off + bj * 128 + n * 16) = o;
                        if (xb) { u2_t w; w.x = pkbf(o[0], o[1]); w.y = pkbf(o[2], o[3]); *(u2_t*)(xb + off + bj * 128 + n * 16) = w; ss += o[0] * o[0] + o[1] * o[1] + o[2] * o[2] + o[3] * o[3]; } }
                if (ssq) { ss += __shfl_xor(ss, 16); ss += __shfl_xor(ss, 32); if (fq == 0) atomicAdd(ssq + row0 + ai * 128 + m * 16, ss); }
                asm volatile("" ::: "memory"); }
    }
};
struct EpiGlu {
    static constexpr bool PERM = true;
    const bf16_t* gl; const float* bias; bf16_t* cat; float* ssq;
    __device__ __forceinline__ void operator()(const f32x4 (&acc)[2][2][4][2], const pg8::Unit& u, int wr, int wc, int fr, int fq) const {
        const int row0 = u.orow + wr * 64 + fr, col0 = u.ocol + wc * 32 + 8 * fq;
#pragma unroll
        for (int ai = 0; ai < 2; ++ai)
#pragma unroll
            for (int m = 0; m < 4; ++m) { const int r = row0 + ai * 128 + m * 16; float ss = 0.f;
#pragma unroll
                for (int bj = 0; bj < 2; ++bj) { const int c = col0 + bj * 128; const u4_t graw = *(const u4_t*)(gl + (size_t)r * S5W + c);
                    const f32x4 b0 = *(const f32x4*)(bias + c), b1 = *(const f32x4*)(bias + c + 4); const f32x4 a0 = acc[ai][bj][m][0] + b0, a1 = acc[ai][bj][m][1] + b1;
                    float o[8];
                    o[0] = bflo(graw.x) * sigmoidf_(a0[0]); o[1] = bfhi(graw.x) * sigmoidf_(a0[1]); o[2] = bflo(graw.y) * sigmoidf_(a0[2]); o[3] = bfhi(graw.y) * sigmoidf_(a0[3]);
                    o[4] = bflo(graw.z) * sigmoidf_(a1[0]); o[5] = bfhi(graw.z) * sigmoidf_(a1[1]); o[6] = bflo(graw.w) * sigmoidf_(a1[2]); o[7] = bfhi(graw.w) * sigmoidf_(a1[3]);
#pragma unroll
                    for (int e = 0; e < 8; ++e) ss += o[e] * o[e];
                    u4_t w; w.x = pkbf(o[0], o[1]); w.y = pkbf(o[2], o[3]); w.z = pkbf(o[4], o[5]); w.w = pkbf(o[6], o[7]);
                    *(u4_t*)(cat + (size_t)r * D_ + c) = w; }
                ss += __shfl_xor(ss, 16); ss += __shfl_xor(ss, 32); if (fq == 0) atomicAdd(ssq + r, ss);
                asm volatile("" ::: "memory"); }
    }
};
struct EpiBf16RowScale {
    static constexpr bool PERM = true;
    bf16_t* O; int ldc; float scale; const float* ssq;
    __device__ __forceinline__ void operator()(const f32x4 (&acc)[2][2][4][2], const pg8::Unit& u, int wr, int wc, int fr, int fq) const {
        const int row0 = u.orow + wr * 64 + fr, col0 = u.ocol + wc * 32 + 8 * fq;
#pragma unroll
        for (int ai = 0; ai < 2; ++ai)
#pragma unroll
            for (int m = 0; m < 4; ++m) { const int r = row0 + ai * 128 + m * 16; const float sc = rsqrtf(ssq[r] * (1.f / (float)D_) + RMS_EPS) * scale; bf16_t* rowp = O + (size_t)r * ldc + col0;
#pragma unroll
                for (int bj = 0; bj < 2; ++bj) { const f32x4 v0 = acc[ai][bj][m][0] * sc, v1 = acc[ai][bj][m][1] * sc;
                    u32x4 w; w.x = pg8::cvt_pk_bf16(v0[0], v0[1]); w.y = pg8::cvt_pk_bf16(v0[2], v0[3]); w.z = pg8::cvt_pk_bf16(v1[0], v1[1]); w.w = pg8::cvt_pk_bf16(v1[2], v1[3]);
                    *(u32x4*)(rowp + bj * 128) = w; } }
    }
};
struct EpiMoeUp {
    static constexpr bool PERM = true;
    bf16_t* hm;
    __device__ __forceinline__ void operator()(const f32x4 (&acc)[2][2][4][2], const pg8::Unit& u, int wr, int wc, int fr, int fq) const {
        const int row0 = u.orow + wr * 64 + fr, col0 = u.ocol + wc * 32 + 8 * fq;
#pragma unroll
        for (int ai = 0; ai < 2; ++ai)
#pragma unroll
            for (int m = 0; m < 4; ++m) { bf16_t* rowp = hm + (size_t)(row0 + ai * 128 + m * 16) * DE + col0;
                float h[8];
#pragma unroll
                for (int n = 0; n < 2; ++n)
#pragma unroll
                    for (int e = 0; e < 4; ++e) h[n * 4 + e] = siluf_(acc[ai][0][m][n][e]) * acc[ai][1][m][n][e];
                u32x4 w; w.x = pg8::cvt_pk_bf16(h[0], h[1]); w.y = pg8::cvt_pk_bf16(h[2], h[3]); w.z = pg8::cvt_pk_bf16(h[4], h[5]); w.w = pg8::cvt_pk_bf16(h[6], h[7]);
                *(u32x4*)rowp = w; }
    }
};

template <int NCOL> struct MoeOrder {
    const char* A; const char* W; const int* tab; int lda, wrows_per_expert, ldb, ocol_step, G, c;
    __device__ bool next(int i, pg8::Unit& u) const {
        const int L = i * G + c; if (L >= tab[0] * NCOL) return false;
        const int rt = L / NCOL, j = L % NCOL, e = tab[40 + rt];
        u.a = A + (size_t)rt * 256 * lda * 2; u.b = W + ((size_t)e * wrows_per_expert + j * 256) * ldb * 2; u.orow = rt * 256; u.ocol = j * ocol_step; u.aux = 0; return true;
    }
};

struct EpiF32Out {
    static constexpr bool PERM = false;
    float* O; int ldc; size_t aux_stride;
    __device__ __forceinline__ void operator()(const f32x4 (&acc)[2][2][4][2], const pg8::Unit& u, int wr, int wc, int fr, int fq) const {
        const int row0 = u.orow + wr * 64 + fr, col0 = u.ocol + wc * 32 + 4 * fq; float* base = O + (size_t)u.aux * aux_stride;
#pragma unroll
        for (int ai = 0; ai < 2; ++ai)
#pragma unroll
            for (int m = 0; m < 4; ++m) { float* rowp = base + (size_t)(row0 + ai * 128 + m * 16) * ldc + col0;
#pragma unroll
                for (int bj = 0; bj < 2; ++bj)
#pragma unroll
                    for (int n = 0; n < 2; ++n) *(f32x4*)(rowp + bj * 128 + n * 16) = acc[ai][bj][m][n]; }
    }
};
typedef float f32x2 __attribute__((ext_vector_type(2)));
__device__ __forceinline__ f32x2 gelu_pk(f32x2 v) {
    const f32x2 av = __builtin_elementwise_abs(v), d = av * 0.2316418882f + 1.0f;
    f32x2 t; t.x = __builtin_amdgcn_rcpf(d.x); t.y = __builtin_amdgcn_rcpf(d.y);
    f32x2 q = t * 0.5307027145f + (-0.7265760135f); q = q * t + 0.7107068705f; q = q * t + (-0.142248368f); q = q * t + 0.127414796f; q = q * t;
    const f32x2 s = (v * v) * (-0.72134752044f);
    f32x2 e; e.x = __builtin_amdgcn_exp2f(s.x); e.y = __builtin_amdgcn_exp2f(s.y);
    const f32x2 m = v * (q * e), r = v - m;
    f32x2 o; o.x = v.x < 0.f ? m.x : r.x; o.y = v.y < 0.f ? m.y : r.y; return o;
}
struct EpiS5Main {
    static constexpr bool PERM = true;
    bf16_t* gl;
    __device__ __forceinline__ void operator()(const f32x4 (&acc)[2][2][4][2], const pg8::Unit& u, int wr, int wc, int fr, int fq) const {
        const int row0 = u.orow + wr * 64 + fr, col0 = wc * 32 + 8 * fq, g = u.aux;
#pragma unroll
        for (int ai = 0; ai < 2; ++ai)
#pragma unroll
            for (int m = 0; m < 4; ++m) { const int n = row0 + ai * 128 + m * 16;
#pragma unroll
                for (int bj = 0; bj < 2; ++bj) { const int c = col0 + bj * 128, j = c >> 4, co = c & 15; const f32x4 v0 = acc[ai][bj][m][0], v1 = acc[ai][bj][m][1];
                    const f32x2 a = gelu_pk((f32x2){v0[0], v0[1]}), b = gelu_pk((f32x2){v0[2], v0[3]}), c2 = gelu_pk((f32x2){v1[0], v1[1]}), d2 = gelu_pk((f32x2){v1[2], v1[3]});
                    u32x4 w; w.x = pg8::cvt_pk_bf16(a.x, a.y); w.y = pg8::cvt_pk_bf16(b.x, b.y); w.z = pg8::cvt_pk_bf16(c2.x, c2.y); w.w = pg8::cvt_pk_bf16(d2.x, d2.y);
                    *(u32x4*)(gl + ((size_t)n * 16 + j) * S5W + g * 16 + co) = w; } }
    }
};
struct S5Order {
    const char* A; const char* Bm; int ldb, G, c;
    __device__ bool next(int i, pg8::Unit& u) const {
        const int L = i * G + c; if (L >= NG * 4) return false;
        const int g = L >> 2, pm = L & 3;
        u.a = A + ((size_t)g * 1024 + pm * 256) * 512 * 2; u.b = Bm + (size_t)g * 256 * ldb * 2; u.orow = pm * 256; u.ocol = 0; u.aux = g; return true;
    }
};
__device__ __forceinline__ void fp_s5estep(const Params& p, LAS unsigned char* lds, int G, int c) {
    S5Order S{(const char*)(p.ws + WS_AEXT), (const char*)p.out + OUT_EMAT, 256, G, c};
    EpiF32Out E{(float*)(p.ws + WS_HLOC), 256, (size_t)1024 * 256};
    pg8::gemm_phase(lds, 256, 512, 256, S, E);
}
__device__ __forceinline__ void fp_s5main(const Params& p, LAS unsigned char* lds, int G, int c) {
    S5Order S{(const char*)(p.ws + WS_AEXT), (const char*)p.out + OUT_MMAT, 512, G, c};
    EpiS5Main E{(bf16_t*)(p.ws + WS_GL)};
    pg8::gemm_phase(lds, 512, 512, 512, S, E);
}

__device__ __forceinline__ void fp_inproj(const Params& p, LAS unsigned char* lds) {
    pg8::DenseOrder S; S.init((const bf16_t*)(p.ws + WS_HB), D_, (const bf16_t*)((unsigned char*)p.out + OUT_WINT), D_, T_, NINP, gridDim.x, blockIdx.x);
    EpiInproj E{(bf16_t*)(p.ws + WS_QKVR), (bf16_t*)(p.ws + WS_ZB), (float*)((unsigned char*)p.out + OUT_BA), (bf16_t*)(p.ws + WS_AEXT)};
    pg8::gemm_phase(lds, D_, D_, D_, S, E);
}
__device__ __forceinline__ void fp_glu(const Params& p, LAS unsigned char* lds, int G, int c) {
    pg8::DenseOrder S; S.init((const bf16_t*)(p.ws + WS_GL), S5W, (const bf16_t*)((unsigned char*)p.out + OUT_WGLUT), S5W, T_, S5W, G, c);
    EpiGlu E{(const bf16_t*)(p.ws + WS_GL), p.in[I_B_GLU], (bf16_t*)(p.ws + WS_CAT), (float*)(p.ws + WS_SSQ)};
    pg8::gemm_phase(lds, S5W, S5W, S5W, S, E);
}
__device__ __forceinline__ void fp_outproj(const Params& p, LAS unsigned char* lds) {
    pg8::DenseOrder S; S.init((const bf16_t*)(p.ws + WS_CAT), D_, (const bf16_t*)(p.ws + WS_WOUTT), D_, T_, D_, gridDim.x, blockIdx.x);
    EpiResid E{p.in[I_X], nullptr, nullptr, D_, (bf16_t*)(p.ws + WS_XB), (float*)(p.ws + WS_SSQ) + T_};
    pg8::gemm_phase(lds, D_, D_, D_, S, E);
}
__device__ __forceinline__ void fp_kv(const Params& p, LAS unsigned char* lds) {
    {
        pg8::DenseOrder S; S.init((const bf16_t*)(p.ws + WS_MEMN), D_, (const bf16_t*)((unsigned char*)p.out + OUT_WKT), D_, B_ * MEM, D_, gridDim.x, (blockIdx.x + gridDim.x - 192) % gridDim.x);
        EpiBf16Out E{(bf16_t*)(p.ws + WS_KMEM), D_, 1.f, 0};
        pg8::gemm_phase(lds, D_, D_, D_, S, E);
    }
    {
        pg8::DenseOrder S; S.init((const bf16_t*)(p.ws + WS_MEMN), D_, (const bf16_t*)((unsigned char*)p.out + OUT_WVT), D_, B_ * MEM, D_, gridDim.x, (blockIdx.x + gridDim.x - 224) % gridDim.x);
        EpiBf16Out E{(bf16_t*)(p.ws + WS_VMEM), D_, 1.f, 0};
        pg8::gemm_phase(lds, D_, D_, D_, S, E);
    }
}
struct AttnPreOrder {
    const char* Kmem; const char* Vmem; const char* WqB; const char* WoT; int G, c;
    __device__ bool next(int i, pg8::Unit& u) const {
        const int L = i * G + c; if (L >= 256) return false;
        const int x = L & 3, h = (L >> 2) & 3, b = (L >> 4) & 7;
        if (L < 128) { u.a = Kmem + ((size_t)(b * MEM) * D_ + h * XD) * 2; u.b = WqB + ((size_t)(x * 256) * D_ + h * XD) * 2; u.orow = 0; u.ocol = x * 256; u.aux = b * 4 + h; }
        else { u.a = WoT + ((size_t)(x * 256) * D_ + h * XD) * 2; u.b = Vmem + ((size_t)(b * MEM) * D_ + h * XD) * 2; u.orow = x * 256; u.ocol = h * XD; u.aux = 64 + b; }
        return true;
    }
};
struct EpiAttnPre {
    static constexpr bool PERM = true;
    bf16_t* Mq; bf16_t* VWT;
    __device__ __forceinline__ void operator()(const f32x4 (&acc)[2][2][4][2], const pg8::Unit& u, int wr, int wc, int fr, int fq) const {
        bf16_t* base = (u.aux < 64) ? Mq + (size_t)u.aux * MEM * D_ : VWT + (size_t)(u.aux - 64) * D_ * D_;
        const int row0 = u.orow + wr * 64 + fr, col0 = u.ocol + wc * 32 + 8 * fq;
#pragma unroll
        for (int ai = 0; ai < 2; ++ai)
#pragma unroll
            for (int m = 0; m < 4; ++m) { bf16_t* rowp = base + (size_t)(row0 + ai * 128 + m * 16) * D_ + col0;
#pragma unroll
                for (int bj = 0; bj < 2; ++bj) { const f32x4 v0 = acc[ai][bj][m][0], v1 = acc[ai][bj][m][1];
                    u32x4 w; w.x = pg8::cvt_pk_bf16(v0[0], v0[1]); w.y = pg8::cvt_pk_bf16(v0[2], v0[3]); w.z = pg8::cvt_pk_bf16(v1[0], v1[1]); w.w = pg8::cvt_pk_bf16(v1[2], v1[3]);
                    *(u32x4*)(rowp + bj * 128) = w; } }
    }
};
__device__ __forceinline__ void fp_attn_pre(const Params& p, LAS unsigned char* lds) {
    AttnPreOrder S{(const char*)(p.ws + WS_KMEM), (const char*)(p.ws + WS_VMEM), (const char*)(p.ws + WS_WQB), (const char*)(p.ws + WS_WOT), (int)gridDim.x, (int)blockIdx.x};
    EpiAttnPre E{(bf16_t*)(p.ws + WS_MQ), (bf16_t*)(p.ws + WS_VWT)};
    pg8::gemm_phase(lds, XD, D_, D_, S, E);
}
struct AttnSOrder {
    const char* Xb; const char* Mq; int G, c;
    __device__ bool next(int i, pg8::Unit& u) const {
        const int L = i * G + c; if (L >= B_ * XH * 8) return false;
        const int pm = L & 7, h = (L >> 3) & 3, b = L >> 5;
        u.a = Xb + (size_t)(b * S_ + pm * 256) * D_ * 2; u.b = Mq + (size_t)((b * 4 + h) * MEM) * D_ * 2; u.orow = b * S_ + pm * 256; u.ocol = h * XD; u.aux = 0; return true;
    }
};
struct AttnWoOrder {
    const char* Pm; const char* VWT; int G, c;
    __device__ bool next(int i, pg8::Unit& u) const {
        const int L = i * G + c; if (L >= 256) return false;
        const int pn = L & 3, pm = (L >> 2) & 7, b = L >> 5;
        u.a = Pm + (size_t)(b * S_ + pm * 256) * D_ * 2; u.b = VWT + ((size_t)b * D_ + pn * 256) * D_ * 2; u.orow = b * S_ + pm * 256; u.ocol = pn * 256; u.aux = 0; return true;
    }
};
__device__ __forceinline__ void fp_attn_fused(const Params& p, LAS unsigned char* lds) {
    const int L = blockIdx.x; if (L >= B_ * XH * 8) return;
    {
        AttnSOrder S{(const char*)(p.ws + WS_XB), (const char*)(p.ws + WS_MQ), (int)gridDim.x, L};
        EpiBf16RowScale E{(bf16_t*)(p.ws + WS_PB), D_, 0.0625f, (const float*)(p.ws + WS_SSQ) + T_};
        pg8::gemm_phase(lds, D_, D_, D_, S, E);
    }
    {
        const int THR = ltid(); const int lane = THR & 63, wid = THR >> 6;
        const int pm = L & 7, h = (L >> 3) & 3, b = L >> 5;
        bf16_t* base = (bf16_t*)(p.ws + WS_PB) + (size_t)(b * S_ + pm * 256 + wid * 32 + (lane >> 4)) * D_ + h * XD + (lane & 15) * 16;
        u4_t ra[8], rb[8];
#pragma unroll
        for (int i = 0; i < 8; ++i) { ra[i] = *(const u4_t*)(base + (size_t)(4 * i) * D_); rb[i] = *(const u4_t*)(base + (size_t)(4 * i) * D_ + 8); }
#pragma unroll
        for (int i = 0; i < 8; ++i) {
            float v[16];
#pragma unroll
            for (int k = 0; k < 4; ++k) { v[2 * k] = bflo(ra[i][k]); v[2 * k + 1] = bfhi(ra[i][k]); v[8 + 2 * k] = bflo(rb[i][k]); v[9 + 2 * k] = bfhi(rb[i][k]); }
            float mx = v[0];
#pragma unroll
            for (int k = 1; k < 16; ++k) mx = fmaxf(mx, v[k]);
            mx = dpp_max16(mx);
            float sum = 0.f;
#pragma unroll
            for (int k = 0; k < 16; ++k) { v[k] = __expf(v[k] - mx); sum += v[k]; }
            const float inv = 1.f / dpp_sum16(sum);
            u4_t wa, wb;
#pragma unroll
            for (int k = 0; k < 4; ++k) { wa[k] = pkbf(v[2 * k] * inv, v[2 * k + 1] * inv); wb[k] = pkbf(v[8 + 2 * k] * inv, v[9 + 2 * k] * inv); }
            *(u4_t*)(base + (size_t)(4 * i) * D_) = wa; *(u4_t*)(base + (size_t)(4 * i) * D_ + 8) = wb; }
    }
}
__device__ __forceinline__ void fp_woproj(const Params& p, LAS unsigned char* lds) {
    AttnWoOrder S{(const char*)(p.ws + WS_PB), (const char*)(p.ws + WS_VWT), (int)gridDim.x, (int)blockIdx.x};
    EpiResid E{nullptr, (const bf16_t*)(p.ws + WS_XB), nullptr, D_, (bf16_t*)(p.ws + WS_XB), nullptr};
    pg8::gemm_phase(lds, D_, D_, D_, S, E);
}
constexpr int LDS_TAB_OFF = pg8::STAGE_BYTES;
__device__ __forceinline__ void fp_moeup(const Params& p, LAS unsigned char* lds, float* smem) {
    int* tab = (int*)((unsigned char*)smem + LDS_TAB_OFF); moe_build_table(p, tab);
    MoeOrder<2> S{(const char*)(p.ws + WS_XS), (const char*)(p.ws + WS_WGUT), tab, D_, 512, D_, 128, (int)gridDim.x, (int)blockIdx.x};
    EpiMoeUp E{(bf16_t*)(p.ws + WS_HM)};
    pg8::gemm_phase(lds, D_, D_, D_, S, E);
    prep_wdown_idle(p, smem, (tab[0] * 2) % (int)gridDim.x);
}
__device__ __forceinline__ void fp_moedown(const Params& p, LAS unsigned char* lds, float* smem) {
    int* tab = (int*)((unsigned char*)smem + LDS_TAB_OFF); moe_build_table(p, tab);
    MoeOrder<4> S{(const char*)(p.ws + WS_HM), (const char*)(p.ws + WS_WDT), tab, DE, D_, DE, 256, (int)gridDim.x, (int)blockIdx.x};
    EpiBf16Out E{(bf16_t*)(p.ws + WS_XS), D_, 1.f, 0};
    pg8::gemm_phase(lds, DE, DE, DE, S, E);
}


#define XB_TMO      128
#define XB_XCNT(j)  (256  + 64 * (j))
#define XB_XSUB(j)  (1280 + 64 * (j))
#define XB_XGEN(j)  (2304 + 64 * (j))
#define XB_TOP      3328
#define XB_TOPGEN   3392
#define XCD_BAR_WORDS 3456
#define XB_SPIN_CAP (1u << 18)
__device__ __forceinline__ unsigned xb_ld(unsigned* p)              { return __hip_atomic_load(p, __ATOMIC_RELAXED, __HIP_MEMORY_SCOPE_AGENT); }
__device__ __forceinline__ unsigned xb_add(unsigned* p, unsigned v) { return __hip_atomic_fetch_add(p, v, __ATOMIC_RELAXED, __HIP_MEMORY_SCOPE_AGENT); }
__device__ __forceinline__ unsigned xb_xcc_id() { return (unsigned)__builtin_amdgcn_s_getreg((3 << 11) | 20) & 0xFu; }
#define XB_SPIN(cond, bar) do { unsigned _sp = 0; while (cond) { __builtin_amdgcn_s_sleep(1); \
    if ((++_sp & 255u) == 0u) { if (xb_ld(&(bar)[XB_TMO])) break; if (_sp > XB_SPIN_CAP) { atomicAdd(&(bar)[XB_TMO], 1u); break; } } } } while (0)
struct XcdBarrier { unsigned* bar; unsigned x; volatile LAS unsigned* st; unsigned G; };
__device__ __forceinline__ XcdBarrier xcd_barrier_post(unsigned* bar, volatile LAS unsigned* st, unsigned G) {
    XcdBarrier b; b.bar = bar; b.x = xb_xcc_id(); b.st = st; b.G = G;
    if (threadIdx.x == 0) (void)xb_add(&bar[XB_XCNT(b.x)], 1u);
    return b;
}
__device__ __forceinline__ void xcd_barrier_complete(unsigned* bar, unsigned x, const unsigned G, unsigned& nloc, unsigned& nx) {
    unsigned sum, cnt, mine, sp = 0u;
    for (;;) {
        sum = 0u; cnt = 0u; mine = 0u;
#pragma unroll
        for (unsigned j = 0; j < 16; ++j) { const unsigned c = xb_ld(&bar[XB_XCNT(j)]); sum += c; cnt += (c > 0u) ? 1u : 0u; mine = (j == x) ? c : mine; }
        if (sum == G) break;
        __builtin_amdgcn_s_sleep(1);
        if ((++sp & 255u) == 0u) { if (xb_ld(&bar[XB_TMO])) break; if (sp > XB_SPIN_CAP) { atomicAdd(&bar[XB_TMO], 1u); break; } }
    }
    nloc = mine > 0u ? mine : 1u; nx = cnt > 0u ? cnt : 1u;
}
__device__ __forceinline__ void xcd_barrier(const XcdBarrier& b) {
    asm volatile("s_waitcnt vmcnt(0)" ::: "memory");
    __syncthreads();
    if (threadIdx.x == 0) {
        unsigned* bar = b.bar;
        __builtin_amdgcn_s_waitcnt(0);
        unsigned nloc = b.st[0], nx = b.st[1];
        if (nloc == 0u) { xcd_barrier_complete(bar, b.x, b.G, nloc, nx); b.st[0] = nloc; b.st[1] = nx; }
        const unsigned old = xb_add(&bar[XB_XSUB(b.x)], 1u);
        const unsigned gen = old / nloc;
        if (old + 1u == (gen + 1u) * nloc) {
            __builtin_amdgcn_fence(__ATOMIC_RELEASE, "agent");
            asm volatile("s_waitcnt vmcnt(0)" ::: "memory");
            const unsigned og = xb_add(&bar[XB_TOP], 1u);
            const unsigned tg = og / nx;
            if (og + 1u == (tg + 1u) * nx) xb_add(&bar[XB_TOPGEN], 1u);
            else XB_SPIN(xb_ld(&bar[XB_TOPGEN]) == tg, bar);
            __builtin_amdgcn_fence(__ATOMIC_ACQUIRE, "agent");
            xb_add(&bar[XB_XGEN(b.x)], 1u);
            asm volatile("s_waitcnt vmcnt(0)" ::: "memory");
        } else {
            XB_SPIN(xb_ld(&bar[XB_XGEN(b.x)]) == gen, bar);
            __builtin_amdgcn_fence(__ATOMIC_ACQUIRE, "agent");
            asm volatile("s_waitcnt vmcnt(0)" ::: "memory");
        }
    }
    __syncthreads();
}

constexpr int LDS_BYTES = 147456;
constexpr int LDS_BARST_OFF = LDS_BYTES - 16;

__global__ void __launch_bounds__(NT, 2) mega_fwd(Params p) {
    __shared__ __attribute__((aligned(16))) unsigned char lds_raw[LDS_BYTES];
    float* smem = (float*)lds_raw; LAS unsigned char* lds = (LAS unsigned char*)lds_raw;
    cg::grid_group grid = cg::this_grid();
    if (threadIdx.x < 4) ((LAS unsigned*)(lds + LDS_BARST_OFF))[threadIdx.x] = 0u;
    __syncthreads();
    const XcdBarrier bar = xcd_barrier_post((unsigned*)(p.ws + WS_BAR), (volatile LAS unsigned*)(lds + LDS_BARST_OFF), gridDim.x);
#define GSYNC() xcd_barrier(bar)
    constexpr int GDNB_BLOCKS = B_ * NH * 2 * 2; const int s5G = (int)gridDim.x - GDNB_BLOCKS, s5c = (int)blockIdx.x - GDNB_BLOCKS;
    XcdBarrier bar2 = bar;
    if (s5c >= 0) bar2 = xcd_barrier_post((unsigned*)(p.ws + WS_BAR) + 4096, (volatile LAS unsigned*)(lds + LDS_BARST_OFF) + 2, (unsigned)s5G);
    if (p.ws == nullptr) grid.sync();
    ph_norm1(p, smem); ph_memnorm(p, smem); ph_prep0(p, smem); ph_s5mat(p, smem);  GSYNC();
    fp_inproj(p, lds); fp_kv(p, lds);  GSYNC();
    ph_prepa(p, smem); __syncthreads(); ph_gdna(p, smem);    GSYNC();
    if (s5c < 0) ph_gdnb(p, smem);
    else {
        for (int L = s5c; L < NG * 4; L += s5G) { fp_s5estep(p, lds, NG * 4, L); s5carry_unit(p, L >> 2, L & 3); fp_s5main(p, lds, NG * 4, L); }
        xcd_barrier(bar2); fp_glu(p, lds, s5G, s5c); }
    GSYNC();
    ph_gdncomb(p, smem); ph_prep1(p, smem); __syncthreads(); fp_attn_pre(p, lds); GSYNC();
    fp_outproj(p, lds); ph_prep2(p, smem); GSYNC();
    fp_attn_fused(p, lds); GSYNC();
    fp_woproj(p, lds);   GSYNC();
    ph_router(p, smem);  GSYNC();
    fp_moeup(p, lds, smem);   GSYNC();
    fp_moedown(p, lds, smem); GSYNC();
    ph_final(p, smem);
}

extern "C" void kernel_launch(void* const* d_in, const int* in_sizes, int n_in, void* d_out, int out_size, void* d_ws, size_t ws_size, hipStream_t stream) {
    if (n_in != N_IN || out_size != T_ * D_ || ws_size < 256 * MiB) { fprintf(stderr, "kernel_launch: unexpected shapes n_in=%d out=%d ws=%zu\n", n_in, out_size, ws_size); return; }
    static int grid_blocks = 0;
    if (!grid_blocks) {
        int dev = 0, cus = 0, per_cu = 0;
        (void)hipGetDevice(&dev);
        (void)hipDeviceGetAttribute(&cus, hipDeviceAttributeMultiprocessorCount, dev);
        (void)hipOccupancyMaxActiveBlocksPerMultiprocessor(&per_cu, mega_fwd, NT, 0);
        if (per_cu < 1) { fprintf(stderr, "kernel_launch: occupancy query says %d blocks/CU\n", per_cu); per_cu = 1; }
        grid_blocks = cus;
    }
    Params p{};
    for (int i = 0; i < N_IN; ++i) p.in[i] = (const float*)d_in[i];
    p.out = (float*)d_out; p.ws = (unsigned char*)d_ws;
    (void)hipMemsetAsync((unsigned char*)d_ws + WS_BAR, 0, (4096 + XCD_BAR_WORDS) * 4, stream);
    void* args[] = {&p};
    hipError_t e = hipLaunchCooperativeKernel((void*)mega_fwd, dim3(grid_blocks), dim3(NT), args, 0, stream);
    if (e != hipSuccess) fprintf(stderr, "cooperative launch failed: %s (grid %d)\n", hipGetErrorString(e), grid_blocks);
}
```

```cpp
#include <hip/hip_runtime.h>
#include <hip/hip_cooperative_groups.h>
namespace cg = cooperative_groups;
#include <cstdio>
#include <cstdint>
#include <type_traits>

typedef unsigned short bf16_t;
__device__ __forceinline__ float bf2f(bf16_t v) { return __uint_as_float(((unsigned)v) << 16); }
typedef __bf16 bf16v2e_t __attribute__((ext_vector_type(2)));
typedef float f32v2e_t __attribute__((ext_vector_type(2)));
__device__ __forceinline__ bf16_t f2bf(float f) { const f32v2e_t v = {f, 0.f}; const bf16v2e_t h = __builtin_convertvector(v, bf16v2e_t); return (bf16_t)(__builtin_bit_cast(unsigned, h) & 0xffffu); }

constexpr int B_ = 8, S_ = 2048, T_ = B_ * S_, D_ = 1024, DIN = 2576;
constexpr int S5W = 512, NG = 32, NP = 64, GDW = 512, NH = 4, HD = 128, MEM = 256;
constexpr int XH = 4, XD = 256, NE = 32, DE = 256;
constexpr float RMS_EPS = 1e-6f, L2_EPS = 1e-6f;
constexpr int NT = 512, NW = NT / 64;

struct Params {
    const float* in[48];
    float* out;
    unsigned char* ws;
};
enum { I_X = 0, I_MEM, I_NORM_MIX, I_W_IN, I_W_OUT,
       I_LAM_RE_F, I_LAM_IM_F, I_LOG_STEP_F, I_B_RE_F, I_B_IM_F, I_C_RE_F, I_C_IM_F,
       I_LAM_RE_B, I_LAM_IM_B, I_LOG_STEP_B, I_B_RE_B, I_B_IM_B, I_C_RE_B, I_C_IM_B,
       I_S5_D, I_W_GLU, I_B_GLU, I_S5_NORM,
       I_CONV, I_ALOG_F, I_DTB_F, I_ALOG_B, I_DTB_B, I_GDN_NORM,
       I_NORM_XA, I_NORM_MEM, I_WQ, I_WK, I_WV, I_WO,
       I_NORM_MOE, I_RG_W, I_RG_B, I_RE_W, I_RE_B, I_WGATE, I_WUP, I_WDOWN, I_NORM_FINAL, N_IN };

constexpr size_t MiB = 1u << 20;
constexpr size_t WS_HB   = 16 * MiB;
constexpr size_t WS_GL   = 0;
constexpr size_t WS_QKVR = 192 * MiB;
constexpr size_t WS_ZB   = 48 * MiB;
constexpr size_t WS_QKVC = 112 * MiB;
constexpr size_t WS_YF   = 160 * MiB;
constexpr size_t WS_CAT  = 224 * MiB;
constexpr size_t OUT_BA = 0;
constexpr size_t OUT_GB = 1 * MiB;
constexpr size_t OUT_WINT = 4 * MiB;
constexpr size_t OUT_WGLUT = 10 * MiB;
constexpr int QKV_LD = 1536, NINP = 2816;
constexpr size_t WS_BAR  = 111 * MiB + 768 * 1024;
constexpr size_t WS_AEXT = 160 * MiB;
constexpr size_t WS_HLOC = 192 * MiB;
constexpr size_t OUT_MMAT = 12 * MiB;
constexpr size_t OUT_EMAT = 20 * MiB;
constexpr int S5L = 16, S5NC = S_ / S5L;
constexpr size_t WS_XB   = 0;
constexpr size_t WS_QB   = 32 * MiB;
constexpr size_t WS_PB   = 64 * MiB;
constexpr size_t WS_OB   = 112 * MiB;
constexpr size_t WS_ROUTE = 154 * MiB;
constexpr size_t WS_WRT  = 156 * MiB;
constexpr size_t WS_CNT  = 155 * MiB;
constexpr size_t WS_WOUTT = 144 * MiB;
constexpr size_t WS_WQB  = 104 * MiB;
constexpr size_t WS_WOT  = 106 * MiB;
constexpr size_t WS_MQ   = 160 * MiB;
constexpr size_t WS_VWT  = 128 * MiB;
constexpr size_t WS_KMEM = 96 * MiB;
constexpr size_t WS_VMEM = 100 * MiB;
constexpr size_t WS_MEMN = 104 * MiB;
constexpr size_t WS_SSQ  = 108 * MiB;
constexpr size_t OUT_WKT = 58 * MiB, OUT_WVT = 60 * MiB;
constexpr size_t WS_WGUT = 176 * MiB;
constexpr size_t WS_WDT  = 208 * MiB;
constexpr size_t WS_XS   = 32 * MiB;
constexpr size_t WS_HM   = 112 * MiB;
constexpr int MC_CS = 64, MC_NT = 2048, MC_REV = 2112, MC_MAP = 2304, MC_WORDS = 2304 + 32 * 128;
constexpr int MAXRT = 159;

__device__ __forceinline__ int ltid() { int t = threadIdx.x; asm volatile("" : "+v"(t)); return t; }
__device__ __forceinline__ float dpp_max16(float v) {
    v = fmaxf(v, __int_as_float(__builtin_amdgcn_update_dpp(0, __float_as_int(v), 0xB1, 0xF, 0xF, true)));
    v = fmaxf(v, __int_as_float(__builtin_amdgcn_update_dpp(0, __float_as_int(v), 0x4E, 0xF, 0xF, true)));
    v = fmaxf(v, __int_as_float(__builtin_amdgcn_update_dpp(0, __float_as_int(v), 0x141, 0xF, 0xF, true)));
    v = fmaxf(v, __int_as_float(__builtin_amdgcn_update_dpp(0, __float_as_int(v), 0x140, 0xF, 0xF, true)));
    return v;
}
__device__ __forceinline__ float dpp_sum16(float v) {
    v += __int_as_float(__builtin_amdgcn_update_dpp(0, __float_as_int(v), 0xB1, 0xF, 0xF, true));
    v += __int_as_float(__builtin_amdgcn_update_dpp(0, __float_as_int(v), 0x4E, 0xF, 0xF, true));
    v += __int_as_float(__builtin_amdgcn_update_dpp(0, __float_as_int(v), 0x141, 0xF, 0xF, true));
    v += __int_as_float(__builtin_amdgcn_update_dpp(0, __float_as_int(v), 0x140, 0xF, 0xF, true));
    return v;
}
__device__ __forceinline__ float wave_sum(float v) {
    v += __int_as_float(__builtin_amdgcn_update_dpp(0, __float_as_int(v), 0xB1, 0xF, 0xF, true));
    v += __int_as_float(__builtin_amdgcn_update_dpp(0, __float_as_int(v), 0x4E, 0xF, 0xF, true));
    v += __int_as_float(__builtin_amdgcn_update_dpp(0, __float_as_int(v), 0x141, 0xF, 0xF, true));
    v += __int_as_float(__builtin_amdgcn_update_dpp(0, __float_as_int(v), 0x140, 0xF, 0xF, true));
    v += __int_as_float(__builtin_amdgcn_update_dpp(0, __float_as_int(v), 0x142, 0xA, 0xF, false));
    v += __int_as_float(__builtin_amdgcn_update_dpp(0, __float_as_int(v), 0x143, 0xC, 0xF, false));
    return __int_as_float(__builtin_amdgcn_readlane(__float_as_int(v), 63));
}
__device__ __forceinline__ float sigmoidf_(float x) { return __builtin_amdgcn_rcpf(1.f + __expf(-x)); }
__device__ __forceinline__ float siluf_(float x) { return x * sigmoidf_(x); }
__device__ __forceinline__ float softplusf_(float x) { return x > 20.f ? x : log1pf(__expf(x)); }
__device__ __forceinline__ float geluf_(float x) { return 0.5f * x * (1.f + erff(x * 0.70710678118654752f)); }

template <class TA> __device__ __forceinline__ float ldA(const TA* p);
template <> __device__ __forceinline__ float ldA<float>(const float* p) { return *p; }
template <> __device__ __forceinline__ float ldA<bf16_t>(const bf16_t* p) { return bf2f(*p); }

typedef float f4_t __attribute__((ext_vector_type(4)));
typedef unsigned u2_t __attribute__((ext_vector_type(2)));
typedef unsigned u4_t __attribute__((ext_vector_type(4)));
__device__ __forceinline__ unsigned pkbf(float lo, float hi);
__device__ __forceinline__ float bflo(unsigned u) { return __uint_as_float(u << 16); }
__device__ __forceinline__ float bfhi(unsigned u) { return __uint_as_float(u & 0xffff0000u); }
__device__ __forceinline__ void rmsnorm_rows_bf16(const float* X, const float* gain, bf16_t* Y, int rows, int width) {
    const int THR = ltid();
    const int lane = THR & 63, gw = blockIdx.x * NW + (THR >> 6), nw = gridDim.x * NW;
    f4_t g[4];
#pragma unroll
    for (int j = 0; j < 4; ++j) g[j] = ((const f4_t*)gain)[lane + 64 * j];
    for (int r0 = gw * 4; r0 < rows; r0 += nw * 4) {
        f4_t v[4][4];
#pragma unroll
        for (int r = 0; r < 4; ++r)
#pragma unroll
            for (int j = 0; j < 4; ++j) v[r][j] = ((const f4_t*)(X + (size_t)(r0 + r) * 1024))[lane + 64 * j];
#pragma unroll
        for (int r = 0; r < 4; ++r) { float ss = 0.f;
#pragma unroll
            for (int j = 0; j < 4; ++j) ss += v[r][j].x * v[r][j].x + v[r][j].y * v[r][j].y + v[r][j].z * v[r][j].z + v[r][j].w * v[r][j].w;
            const float rs = rsqrtf(wave_sum(ss) * (1.f / 1024.f) + RMS_EPS);
#pragma unroll
            for (int j = 0; j < 4; ++j) { const f4_t o = v[r][j] * rs * g[j]; u2_t w; w.x = pkbf(o.x, o.y); w.y = pkbf(o.z, o.w); ((u2_t*)(Y + (size_t)(r0 + r) * 1024))[lane + 64 * j] = w; } }
    }
}

namespace pg8 {
#define PG8_LAS __attribute__((address_space(3)))
typedef short bf16x8 __attribute__((ext_vector_type(8)));
typedef float f32x4 __attribute__((ext_vector_type(4)));
typedef unsigned u32x4 __attribute__((ext_vector_type(4)));
typedef unsigned u32x2 __attribute__((ext_vector_type(2)));
constexpr int BM = 256, BK = 64, HALF = 128, HTB = HALF * BK * 2, STAGE_BYTES = 8 * HTB;
__device__ __forceinline__ int lds_byte(int r, int c) { const int st = (r >> 4) * 2 + (c >> 5), rr = r & 15, cc = c & 31, ob = rr * 64 + cc * 2; return st * 1024 + (ob ^ (((ob >> 9) & 1) << 5)); }
__device__ __forceinline__ void stage_rc(int b, int& R, int& C) { const int st = b / 1024, sb = b % 1024, swz = sb ^ (((sb >> 9) & 1) << 5); R = (st >> 1) * 16 + swz / 64; C = (st & 1) * 32 + (swz % 64) / 2; }
__device__ __forceinline__ int perm32(int rho) { const int n = rho >> 4, i = rho & 15; return 8 * (i >> 2) + 4 * n + (i & 3); }
typedef __bf16 bf16v2_t __attribute__((ext_vector_type(2)));
typedef float f32v2_t __attribute__((ext_vector_type(2)));
__device__ __forceinline__ unsigned cvt_pk_bf16(float lo, float hi) { const f32v2_t f = {lo, hi}; const bf16v2_t h = __builtin_convertvector(f, bf16v2_t); return __builtin_bit_cast(unsigned, h); }
}
__device__ __forceinline__ unsigned pkbf(float lo, float hi) { return pg8::cvt_pk_bf16(lo, hi); }
namespace pg8 {

struct Unit { const char* a; const char* b; int orow, ocol, aux; };
struct DenseOrder {
    const char* A; const char* Bt; int lda, ldb, nM, nN, nwg, G, c;
    __device__ void init(const bf16_t* A_, int lda_, const bf16_t* Bt_, int ldb_, int M, int N, int G_, int c_) { A = (const char*)A_; Bt = (const char*)Bt_; lda = lda_; ldb = ldb_; nM = M / BM; nN = N / BM; nwg = nM * nN; G = G_; c = c_; }
    __device__ bool next(int i, Unit& u) const {
        const long L = (long)i * G + c; if (L >= nwg) return false;
        int wgid = (int)L; { const int q = nwg / 8, r = nwg % 8, xcd = wgid % 8, off = wgid / 8; wgid = (xcd < r ? xcd * (q + 1) : r * (q + 1) + (xcd - r) * q) + off; }
        const int nig = 8 * nN, gid = wgid / nig, fm = gid * 8, gsz = (nM - fm) < 8 ? (nM - fm) : 8;
        const int pm = fm + ((wgid % nig) % gsz), pn = (wgid % nig) / gsz;
        u.a = A + (size_t)pm * BM * lda * 2; u.b = Bt + (size_t)pn * BM * ldb * 2; u.orow = pm * BM; u.ocol = pn * BM; u.aux = pn; return true;
    }
};

template <class Epi, class Sched>
__device__ __forceinline__ void gemm_phase(PG8_LAS unsigned char* lds, const int K, const int lda, const int ldb, const Sched& S, const Epi& E) {
    int tid_ = threadIdx.x; asm volatile("" : "+v"(tid_));
    const int tid = tid_, wid = __builtin_amdgcn_readfirstlane(tid >> 6), lane = tid & 63, wr = wid >> 2, wc = wid & 3, fr = lane & 15, fq = lane >> 4;
    const int nt = K / BK;
    unsigned voffA[2], voffB[2];
#pragma unroll
    for (int i = 0; i < 2; ++i) { int R, C; stage_rc(tid * 16 + i * 8192, R, C); const int Rb = Epi::PERM ? ((R & ~31) + perm32(R & 31)) : R;
        voffA[i] = (unsigned)(R * lda + C) * 2u; voffB[i] = (unsigned)(Rb * ldb + C) * 2u; }
    const size_t kstep = (size_t)(BK * 2);
    const size_t hstepA = (size_t)HALF * lda * 2, hstepB = (size_t)HALF * ldb * 2;
    const unsigned ldsw = (unsigned)wid * 1024u;
    const int aoff = lds_byte(wr * 64 + fr, fq * 8), boff = lds_byte(wc * 32 + fr, fq * 8);
#define PG8_SA(b, h) (((b) * 2 + (h)) * HTB)
#define PG8_SB(b, h) ((4 + (b) * 2 + (h)) * HTB)
#define PG8_STAGE(bufoff, gbase, voff) do { _Pragma("unroll") for (int _i = 0; _i < 2; ++_i) \
        __builtin_amdgcn_global_load_lds((const unsigned*)((const char*)(gbase) + (voff)[_i]), (PG8_LAS unsigned*)(lds + (bufoff) + ldsw + _i * 8192), 16, 0, 0); } while (0)
#define PG8_LDA(dst, b, h) do { _Pragma("unroll") for (int m = 0; m < 4; ++m) _Pragma("unroll") for (int k = 0; k < 2; ++k) dst[m][k] = *(const PG8_LAS bf16x8*)(lds + PG8_SA(b, h) + aoff + m * 2048 + k * 1024); } while (0)
#define PG8_LDB(dst, b, h) do { _Pragma("unroll") for (int n = 0; n < 2; ++n) _Pragma("unroll") for (int k = 0; k < 2; ++k) dst[n][k] = *(const PG8_LAS bf16x8*)(lds + PG8_SB(b, h) + boff + n * 2048 + k * 1024); } while (0)
#define PG8_MMA(ai, bj, At, Bt) do { __builtin_amdgcn_s_setprio(1); _Pragma("unroll") for (int m = 0; m < 4; ++m) _Pragma("unroll") for (int n = 0; n < 2; ++n) _Pragma("unroll") for (int k = 0; k < 2; ++k) \
        acc[ai][bj][m][n] = __builtin_amdgcn_mfma_f32_16x16x32_bf16(Bt[n][k], At[m][k], acc[ai][bj][m][n], 0, 0, 0); __builtin_amdgcn_s_setprio(0); } while (0)
#define PG8_WAIT_V(n) asm volatile("s_waitcnt vmcnt(" #n ")" ::: "memory")
#define PG8_WAIT_L(n) asm volatile("s_waitcnt lgkmcnt(" #n ")" ::: "memory")
#define PG8_BAR __builtin_amdgcn_s_barrier()
#define PG8_SCHED __builtin_amdgcn_sched_barrier(0)
    Unit cur, nxt; int ui = 0;
    if (!S.next(0, cur)) return;
    f32x4 acc[2][2][4][2];
#pragma unroll
    for (int a = 0; a < 2; ++a)
#pragma unroll
        for (int b = 0; b < 2; ++b)
#pragma unroll
            for (int m = 0; m < 4; ++m)
#pragma unroll
                for (int n = 0; n < 2; ++n) acc[a][b][m][n] = (f32x4){0.f, 0.f, 0.f, 0.f};
    bf16x8 At[4][2], B0[2][2], B1[2][2];
    const char* cA = cur.a; const char* cB = cur.b;
    PG8_STAGE(PG8_SB(0, 0), cB, voffB); PG8_STAGE(PG8_SA(0, 0), cA, voffA); PG8_STAGE(PG8_SB(0, 1), cB + hstepB, voffB); PG8_STAGE(PG8_SA(0, 1), cA + hstepA, voffA);
    if (wr == 1) PG8_BAR;
    PG8_WAIT_V(4); PG8_BAR;
    PG8_STAGE(PG8_SB(1, 0), cB + kstep, voffB); PG8_STAGE(PG8_SA(1, 0), cA + kstep, voffA); PG8_STAGE(PG8_SB(1, 1), cB + hstepB + kstep, voffB);
    PG8_WAIT_V(6); PG8_BAR;
    for (;;) {
        const bool has_next = S.next(ui + 1, nxt);
        const char* nA = has_next ? nxt.a : cA; const char* nB = has_next ? nxt.b : cB;
        for (int t = 0; t < nt; t += 2) {
            const bool last = (t == nt - 2);
            const char* a1 = cA + (size_t)(t + 1) * kstep;
            const char* a2 = last ? nA : cA + (size_t)(t + 2) * kstep; const char* b2 = last ? nB : cB + (size_t)(t + 2) * kstep;
            const char* a3 = a2 + kstep; const char* b3 = b2 + kstep;
            PG8_LDB(B0, 0, 0); PG8_SCHED; PG8_LDA(At, 0, 0); PG8_STAGE(PG8_SA(1, 1), a1 + hstepA, voffA);
            PG8_WAIT_L(8); PG8_BAR; PG8_WAIT_L(0); PG8_MMA(0, 0, At, B0); PG8_BAR; PG8_SCHED;
            PG8_LDB(B1, 0, 1); PG8_STAGE(PG8_SB(0, 0), b2, voffB);
            PG8_BAR; PG8_WAIT_L(0); PG8_MMA(0, 1, At, B1); PG8_BAR;
            PG8_LDA(At, 0, 1); PG8_STAGE(PG8_SA(0, 0), a2, voffA);
            PG8_BAR; PG8_WAIT_L(0); PG8_MMA(1, 0, At, B0); PG8_BAR; PG8_SCHED;
            PG8_STAGE(PG8_SB(0, 1), b2 + hstepB, voffB);
            PG8_WAIT_V(6); PG8_BAR; PG8_MMA(1, 1, At, B1); PG8_BAR;
            PG8_LDB(B0, 1, 0); PG8_SCHED; PG8_LDA(At, 1, 0); PG8_STAGE(PG8_SA(0, 1), a2 + hstepA, voffA);
            PG8_WAIT_L(8); PG8_BAR; PG8_WAIT_L(0); PG8_MMA(0, 0, At, B0); PG8_BAR; PG8_SCHED;
            PG8_LDB(B1, 1, 1); PG8_STAGE(PG8_SB(1, 0), b3, voffB);
            PG8_BAR; PG8_WAIT_L(0); PG8_MMA(0, 1, At, B1); PG8_BAR;
            PG8_LDA(At, 1, 1); PG8_STAGE(PG8_SA(1, 0), a3, voffA);
            PG8_BAR; PG8_WAIT_L(0); PG8_MMA(1, 0, At, B0); PG8_BAR; PG8_SCHED;
            PG8_STAGE(PG8_SB(1, 1), b3 + hstepB, voffB);
            PG8_WAIT_V(6); PG8_BAR; PG8_MMA(1, 1, At, B1); PG8_BAR;
        }
        E(acc, cur, wr, wc, fr, fq);
        if (!has_next) break;
#pragma unroll
        for (int a = 0; a < 2; ++a)
#pragma unroll
            for (int b = 0; b < 2; ++b)
#pragma unroll
                for (int m = 0; m < 4; ++m)
#pragma unroll
                    for (int n = 0; n < 2; ++n) acc[a][b][m][n] = (f32x4){0.f, 0.f, 0.f, 0.f};
        cur = nxt; cA = nA; cB = nB; ++ui;
    }
    PG8_WAIT_V(0);
    if (wr == 0) PG8_BAR;
    PG8_BAR;
#undef PG8_SA
#undef PG8_SB
#undef PG8_STAGE
#undef PG8_LDA
#undef PG8_LDB
#undef PG8_MMA
#undef PG8_WAIT_V
#undef PG8_WAIT_L
#undef PG8_BAR
#undef PG8_SCHED
}
}
typedef pg8::f32x4 f32x4; typedef pg8::u32x4 u32x4;
#define LAS __attribute__((address_space(3)))

#define LAS __attribute__((address_space(3)))

__device__ __forceinline__ void ph_norm1(const Params& p, float* smem) {
    rmsnorm_rows_bf16(p.in[I_X], p.in[I_NORM_MIX], (bf16_t*)(p.ws + WS_HB), T_, D_);
}
__device__ __forceinline__ void ph_memnorm(const Params& p, float* smem) {
    rmsnorm_rows_bf16(p.in[I_MEM], p.in[I_NORM_MEM], (bf16_t*)(p.ws + WS_MEMN), B_ * MEM, D_);
}
__device__ __forceinline__ void ph_s5mat(const Params& p, float* smem) {
    const int THR = ltid();
    bf16_t* Mm = (bf16_t*)((unsigned char*)p.out + OUT_MMAT); bf16_t* Em = (bf16_t*)((unsigned char*)p.out + OUT_EMAT);
    float* lp = smem;
    float* cf = smem + 640;
    float* Bb = smem + 896;
    float* kk = smem + 896 + 4096;
    __syncthreads();
    for (int item = blockIdx.x; item < NG * S5L; item += gridDim.x) {
        const int g = item >> 4, j = item & 15;
        if (THR < 320) {
            const int which = THR >> 6, pp = THR & 63; const int dir = (which == 1 || which == 4) ? 1 : 0;
            const int o = dir ? (I_LAM_RE_B - I_LAM_RE_F) : 0;
            const float lre = p.in[I_LAM_RE_F + o][g * NP + pp], lim = p.in[I_LAM_IM_F + o][g * NP + pp], step = __expf(p.in[I_LOG_STEP_F + o][g]);
            const float pw = (float)(which == 0 ? j : which == 1 ? j : which == 2 ? (15 - j) : which == 3 ? (j + 1) : (16 - j));
            const float er = expf(lre * step * pw); float sn, cs; sincosf(lim * step * pw, &sn, &cs);
            lp[(which * 64 + pp) * 2] = er * cs; lp[(which * 64 + pp) * 2 + 1] = er * sn;
            if (which < 2) {
                const float e1 = expf(lre * step); float s1, c1; sincosf(lim * step, &s1, &c1);
                const float nr = e1 * c1 - 1.f, ni = e1 * s1, den = lre * lre + lim * lim;
                cf[(dir * 64 + pp) * 2] = (nr * lre + ni * lim) / den; cf[(dir * 64 + pp) * 2 + 1] = (ni * lre - nr * lim) / den;
            }
        }
        __syncthreads();
        for (int e = THR; e < 2048; e += NT) {
            const int dir = e >> 10, pp = (e >> 4) & 63, ci = e & 15; const int o = dir ? (I_LAM_RE_B - I_LAM_RE_F) : 0;
            const float br = p.in[I_B_RE_F + o][(g * NP + pp) * 16 + ci], bi = p.in[I_B_IM_F + o][(g * NP + pp) * 16 + ci];
            const float cr = cf[(dir * 64 + pp) * 2], ci_ = cf[(dir * 64 + pp) * 2 + 1];
            Bb[e * 2] = cr * br - ci_ * bi; Bb[e * 2 + 1] = cr * bi + ci_ * br;
        }
        __syncthreads();
        {
            const int dir = THR >> 8, co = (THR >> 4) & 15, ci = THR & 15; const int o = dir ? (I_LAM_RE_B - I_LAM_RE_F) : 0;
            const float* cre = p.in[I_C_RE_F + o] + (g * 16 + co) * NP; const float* cim = p.in[I_C_IM_F + o] + (g * 16 + co) * NP;
            float acc = 0.f;
            for (int pp = 0; pp < 64; ++pp) {
                const float lr = lp[(dir * 64 + pp) * 2], li = lp[(dir * 64 + pp) * 2 + 1], c_r = cre[pp], c_i = cim[pp];
                const float clr = c_r * lr - c_i * li, cli = c_r * li + c_i * lr;
                acc += clr * Bb[((dir * 64 + pp) * 16 + ci) * 2] - cli * Bb[((dir * 64 + pp) * 16 + ci) * 2 + 1];
            }
            kk[THR] = acc;
        }
        __syncthreads();
        {
            const int dir = THR >> 8, co = (THR >> 4) & 15, ci = THR & 15; bf16_t* Mg = Mm + (size_t)g * 256 * 512;
            if (j == 0) { if (dir == 0) { const bf16_t v = f2bf(kk[THR] + kk[256 + THR] + (co == ci ? p.in[I_S5_D][g * 16 + co] : 0.f));
                    for (int jj = 0; jj < 16; ++jj) Mg[(size_t)(jj * 16 + co) * 512 + jj * 16 + ci] = v; } }
            else { const bf16_t v = f2bf(kk[THR]);
                if (dir == 0) { for (int jj = j; jj < 16; ++jj) Mg[(size_t)(jj * 16 + co) * 512 + (jj - j) * 16 + ci] = v; }
                else { for (int jj = 0; jj + j < 16; ++jj) Mg[(size_t)(jj * 16 + co) * 512 + (jj + j) * 16 + ci] = v; } }
        }
        for (int e = THR; e < 2048; e += NT) {
            const int dir = e >> 10, co = (e >> 6) & 15, pp = e & 63; const int o = dir ? (I_LAM_RE_B - I_LAM_RE_F) : 0;
            const float c_r = p.in[I_C_RE_F + o][(g * 16 + co) * NP + pp], c_i = p.in[I_C_IM_F + o][(g * 16 + co) * NP + pp];
            const int w = dir ? 4 : 3; const float lr = lp[(w * 64 + pp) * 2], li = lp[(w * 64 + pp) * 2 + 1];
            bf16_t* row = Mm + ((size_t)g * 256 + j * 16 + co) * 512 + 256 + dir * 128;
            row[pp] = f2bf(c_r * lr - c_i * li); row[64 + pp] = f2bf(-(c_r * li + c_i * lr));
        }
        for (int e = THR; e < 2048; e += NT) {
            const int dir = e >> 10, pp = (e >> 4) & 63, ci = e & 15;
            const int w = dir ? 1 : 2; const float lr = lp[(w * 64 + pp) * 2], li = lp[(w * 64 + pp) * 2 + 1];
            const float br = Bb[e * 2], bi = Bb[e * 2 + 1];
            bf16_t* Eg = Em + (size_t)g * 256 * 256;
            Eg[(size_t)(dir * 128 + pp) * 256 + j * 16 + ci] = f2bf(lr * br - li * bi);
            Eg[(size_t)(dir * 128 + 64 + pp) * 256 + j * 16 + ci] = f2bf(lr * bi + li * br);
        }
        __syncthreads();
    }
}
__device__ __forceinline__ void s5carry_unit(const Params& p, int g, int pm) {
    const int THR = ltid();
    if (THR < 256) {
        const float* Hl = (const float*)(p.ws + WS_HLOC); bf16_t* Ax = (bf16_t*)(p.ws + WS_AEXT);
        const int pp = THR & 63, dir = (THR >> 6) & 1, b = 2 * pm + (THR >> 7); const int o = dir ? (I_LAM_RE_B - I_LAM_RE_F) : 0;
        const float lre = p.in[I_LAM_RE_F + o][g * NP + pp], lim = p.in[I_LAM_IM_F + o][g * NP + pp], step = __expf(p.in[I_LOG_STEP_F + o][g]);
        const float er = expf(lre * step * (float)S5L); float sn, cs; sincosf(lim * step * (float)S5L, &sn, &cs);
        const float lr = er * cs, li = er * sn;
        float hr = 0.f, hi = 0.f;
        const size_t rowbase = (size_t)g * 1024 + (size_t)b * S5NC;
        for (int s0 = 0; s0 < S5NC; s0 += 16) {
            float lr_[16], li_[16];
#pragma unroll
            for (int k = 0; k < 16; ++k) { const int c = dir ? (S5NC - 1 - (s0 + k)) : (s0 + k); const float* hl = Hl + (rowbase + c) * 256 + dir * 128; lr_[k] = hl[pp]; li_[k] = hl[64 + pp]; }
#pragma unroll
            for (int k = 0; k < 16; ++k) { const int c = dir ? (S5NC - 1 - (s0 + k)) : (s0 + k);
                bf16_t* ar = Ax + (rowbase + c) * 512 + 256 + dir * 128; ar[pp] = f2bf(hr); ar[64 + pp] = f2bf(hi);
                const float nr = lr * hr - li * hi + lr_[k], ni = lr * hi + li * hr + li_[k]; hr = nr; hi = ni; }
        }
    }
    asm volatile("s_waitcnt vmcnt(0)" ::: "memory");
    __syncthreads();
}
constexpr size_t WS_GW   = 16 * MiB;
constexpr size_t WS_GUT  = 64 * MiB;
constexpr size_t WS_GQK  = 128 * MiB;
constexpr size_t WS_GKT  = 144 * MiB;
constexpr size_t WS_GQN  = 112 * MiB;
constexpr size_t OUT_GSC = 24 * MiB;
constexpr size_t OUT_GO  = 26 * MiB;
typedef short bf16x4 __attribute__((ext_vector_type(4)));
typedef pg8::bf16x8 bf16x8;
__device__ __forceinline__ bf16x8 cat44(bf16x4 lo, bf16x4 hi) { return __builtin_shufflevector(lo, hi, 0, 1, 2, 3, 4, 5, 6, 7); }
__device__ __forceinline__ bf16x4 pack4(float a, float b, float c, float d) { union { unsigned u[2]; bf16x4 v; } x; x.u[0] = pg8::cvt_pk_bf16(a, b); x.u[1] = pg8::cvt_pk_bf16(c, d); return x.v; }

__host__ __device__ constexpr int gdna_pieces_before(int i) { return i <= 16 ? i - 1 : i <= 32 ? 16 + 2 * (i - 17) : i <= 48 ? 48 + 3 * (i - 33) : 96 + 4 * (i - 49); }
__device__ __forceinline__ void ph_gdna(const Params& p, float* smem) {
    LAS unsigned char* L = (LAS unsigned char*)smem;
    constexpr int KS = 0, QS = 17408, VS = 34816, KT = 52224, VT = 70656, KK = 89088, QKR = 105728, SC = 122368, TB = 124416;
    constexpr int AF = KS, AB = QS, TF = KK;
    LAS float* sc = (LAS float*)(L + SC);
    const bf16_t* proj = (const bf16_t*)(p.ws + WS_QKVR); const float* ba = (const float*)((unsigned char*)p.out + OUT_BA); const float* cw = p.in[I_CONV]; bf16_t* GQN = (bf16_t*)(p.ws + WS_GQN);
    bf16_t* GW = (bf16_t*)(p.ws + WS_GW); bf16_t* GUT = (bf16_t*)(p.ws + WS_GUT); bf16_t* GQK = (bf16_t*)(p.ws + WS_GQK); bf16_t* GKT = (bf16_t*)(p.ws + WS_GKT);
    float* GSC = (float*)((unsigned char*)p.out + OUT_GSC);
    auto loadraw = [&](unsigned (&rw)[3][12], float& bav, int it) {
        const int THR = ltid(); const int lane = THR & 63, wid = THR >> 6;
        const int n = it & 31, h = (it >> 5) & 3, b = it >> 7, t0 = b * S_ + n * 64, s0 = n * 64 + wid * 8;
#pragma unroll
        for (int mat = 0; mat < 3; ++mat)
#pragma unroll
            for (int r = 0; r < 12; ++r) { const int sq = s0 - 2 + r; unsigned raw = 0u;
                if (sq >= 0 && sq < S_) raw = *(const unsigned*)(proj + (size_t)(b * S_ + sq) * QKV_LD + mat * 512 + h * 128 + lane * 2);
                rw[mat][r] = raw; }
        bav = 0.f;
        if (THR < 256) { const int i = THR & 63, w = THR >> 6; bav = ba[(size_t)(t0 + i) * 16 + (w == 0 ? 8 + h : w == 1 ? 12 + h : w == 2 ? h : 4 + h)]; }
    };
    const bool fixed_h = (gridDim.x % 128u) == 0u;
    float cwa[3][5], cwb[3][5];
    auto loadtaps = [&](int h) {
        const int lane = ltid() & 63;
#pragma unroll
        for (int mat = 0; mat < 3; ++mat)
#pragma unroll
            for (int k = 0; k < 5; ++k) { const int col = mat * 512 + h * 128 + lane * 2; cwa[mat][k] = cw[k * 1536 + col]; cwb[mat][k] = cw[k * 1536 + col + 1]; }
    };
    loadtaps((blockIdx.x >> 5) & 3);
    unsigned rawc[3][12]; float bac = 0.f;
    if ((int)blockIdx.x < B_ * NH * 32) loadraw(rawc, bac, blockIdx.x);
    for (int item = blockIdx.x; item < B_ * NH * 32; item += gridDim.x) {
        const int THR = ltid();
        const int lane = THR & 63, wid = THR >> 6, l15 = lane & 15, q4 = lane >> 4;
        const int n = item & 31, h = (item >> 5) & 3, b = item >> 7, t0 = b * S_ + n * 64;
        if (!fixed_h) loadtaps(h);
        if (THR < 256) { const int i = THR & 63, w = THR >> 6; const float r = bac;
            sc[w * 64 + i] = (w < 2) ? -__expf(p.in[w ? I_ALOG_B : I_ALOG_F][h]) * softplusf_(r + p.in[w ? I_DTB_B : I_DTB_F][h]) : sigmoidf_(r); }
        {
#pragma unroll
            for (int mat = 0; mat < 3; ++mat) {
                float w0[5], w1[5], x0[12], x1[12];
#pragma unroll
                for (int k = 0; k < 5; ++k) { w0[k] = cwa[mat][k]; w1[k] = cwb[mat][k]; }
#pragma unroll
                for (int r = 0; r < 12; ++r) { const unsigned raw = rawc[mat][r]; x0[r] = __uint_as_float(raw << 16); x1[r] = __uint_as_float(raw & 0xffff0000u); }
#pragma unroll
                for (int tk = 0; tk < 8; ++tk) { float a0 = 0.f, a1 = 0.f;
#pragma unroll
                    for (int k = 0; k < 5; ++k) { a0 = fmaf(w0[k], x0[tk + k], a0); a1 = fmaf(w1[k], x1[tk + k], a1); }
                    float y0 = siluf_(a0), y1 = siluf_(a1);
                    if (mat < 2) { float scl = rsqrtf(wave_sum(y0 * y0 + y1 * y1) + L2_EPS); if (mat == 0) scl *= 0.08838834764831845f; y0 *= scl; y1 *= scl; }
                    *(LAS unsigned*)(L + (mat == 0 ? QS : mat == 1 ? KS : VS) + (wid * 8 + tk) * 272 + lane * 4) = pg8::cvt_pk_bf16(y0, y1); }
            }
        }
        unsigned rawn[3][12]; float ban = 0.f;
        if (item + (int)gridDim.x < B_ * NH * 32) loadraw(rawn, ban, item + gridDim.x);
        __syncthreads();
        if (wid < 2) { float v = sc[wid * 64 + (wid ? 63 - lane : lane)];
#pragma unroll
            for (int o = 1; o < 64; o <<= 1) { const float t = __shfl_up(v, o); if (lane >= o) v += t; }
            sc[256 + wid * 64 + (wid ? 63 - lane : lane)] = v; }
        {
#pragma unroll
            for (int i = 0; i < 2; ++i) { const int e = THR + i * NT, row = e >> 4, ch = e & 15; *(u32x4*)(GQN + (size_t)item * 8192 + row * 128 + ch * 8) = *(const LAS u32x4*)(L + QS + row * 272 + ch * 16); }
            const int tok0 = 4 * (THR & 15), c0 = 4 * (THR >> 4);
#pragma unroll
            for (int mat = 0; mat < 2; ++mat) { const int src = mat ? VS : KS, dst = mat ? VT : KT; bf16x4 r[4];
#pragma unroll
                for (int i = 0; i < 4; ++i) r[i] = *(const LAS bf16x4*)(L + src + (tok0 + i) * 272 + c0 * 2);
#pragma unroll
                for (int c = 0; c < 4; ++c) { bf16x4 o; o[0] = r[0][c]; o[1] = r[1][c]; o[2] = r[2][c]; o[3] = r[3][c]; *(LAS bf16x4*)(L + dst + (c0 + c) * 144 + tok0 * 2) = o; } }
        }
#pragma unroll
        for (int ti = 0; ti < 4; ++ti) { const int id = wid * 4 + ti, mat = id >> 4, it = (id >> 2) & 3, jt = id & 3; f32x4 acc = {0.f, 0.f, 0.f, 0.f};
#pragma unroll
            for (int s4 = 0; s4 < 4; ++s4) { const bf16x8 a = *(const LAS bf16x8*)(L + (mat ? QS : KS) + (16 * it + l15) * 272 + (32 * s4 + 8 * q4) * 2);
                const bf16x8 bb = *(const LAS bf16x8*)(L + KS + (16 * jt + l15) * 272 + (32 * s4 + 8 * q4) * 2);
                acc = __builtin_amdgcn_mfma_f32_16x16x32_bf16(a, bb, acc, 0, 0, 0); }
            LAS float* dst = (LAS float*)(L + (mat ? QKR : KK));
#pragma unroll
            for (int r = 0; r < 4; ++r) dst[(16 * it + 4 * q4 + r) * 65 + 16 * jt + l15] = acc[r]; }
        __syncthreads();
        {
            LAS float* kk = (LAS float*)(L + KK); LAS float* qr = (LAS float*)(L + QKR); LAS float* af = (LAS float*)(L + AF); LAS float* ab = (LAS float*)(L + AB);
            bf16_t* qkf = GQK + (size_t)(item * 2) * 4096; bf16_t* qkb = qkf + 4096;
            const int i = THR >> 3, j0 = (THR & 7) * 8;
            const float gfi = sc[256 + i], gbi = sc[320 + i], bfi = sc[128 + i], bbi = sc[192 + i];
            float vf[8], vb[8], qf[8], qb[8];
#pragma unroll
            for (int e = 0; e < 8; ++e) { const int j = j0 + e; const float kv = kk[i * 65 + j], qv = qr[i * 65 + j];
                const float df = __expf(fminf(gfi - sc[256 + j], 0.f)), db = __expf(fminf(gbi - sc[320 + j], 0.f));
                vf[e] = (j < i) ? bfi * kv * df : 0.f; vb[e] = (j > i) ? bbi * kv * db : 0.f; qf[e] = (j <= i) ? qv * df : 0.f; qb[e] = (j >= i) ? qv * db : 0.f; }
            *(LAS f32x4*)(af + i * 64 + j0) = (f32x4){vf[0], vf[1], vf[2], vf[3]}; *(LAS f32x4*)(af + i * 64 + j0 + 4) = (f32x4){vf[4], vf[5], vf[6], vf[7]};
            *(LAS f32x4*)(ab + (63 - i) * 64 + 56 - j0) = (f32x4){vb[7], vb[6], vb[5], vb[4]}; *(LAS f32x4*)(ab + (63 - i) * 64 + 60 - j0) = (f32x4){vb[3], vb[2], vb[1], vb[0]};
            u32x4 w1, w2; w1.x = pkbf(qf[0], qf[1]); w1.y = pkbf(qf[2], qf[3]); w1.z = pkbf(qf[4], qf[5]); w1.w = pkbf(qf[6], qf[7]);
            w2.x = pkbf(qb[0], qb[1]); w2.y = pkbf(qb[2], qb[3]); w2.z = pkbf(qb[4], qb[5]); w2.w = pkbf(qb[6], qb[7]);
            *(u32x4*)(qkf + i * 64 + j0) = w1; *(u32x4*)(qkb + i * 64 + j0) = w2;
        }
        __syncthreads();
        {
            const int sd = wid >> 2, r4 = lane & 3, c = 16 * (wid & 3) + (lane >> 2);
            const LAS float* A = (const LAS float*)(L + (sd ? AB : AF)) + r4;
            float to[16];
#pragma unroll
            for (int m = 0; m < 16; ++m) to[m] = 0.f;
            float ar3[3][16];
            ar3[1][0] = A[1 * 64];
            ar3[2][0] = A[2 * 64];
            if (r4 == 0) to[0] = (c == 0) ? 1.f : 0.f;
#define GDNA_ROW(i) { constexpr int NM = ((i) + 3) / 4, NP2 = ((i) + 5) / 4; \
                if ((i) + 2 < 64) { _Pragma("unroll") for (int m = 0; m < NP2; ++m) ar3[((i) + 2) % 3][m] = A[((i) + 2) * 64 + 4 * m]; } \
                float p0 = 0.f, p1 = 0.f; \
                _Pragma("unroll") for (int m = 0; m < NM; ++m) { if (m & 1) p1 = fmaf(ar3[(i) % 3][m], to[m], p1); else p0 = fmaf(ar3[(i) % 3][m], to[m], p0); } \
                float ps = p0 + p1; \
                ps += __int_as_float(__builtin_amdgcn_update_dpp(0, __float_as_int(ps), 0xB1, 0xF, 0xF, true));     \
                ps += __int_as_float(__builtin_amdgcn_update_dpp(0, __float_as_int(ps), 0x4E, 0xF, 0xF, true));     \
                const float val = ((c == (i)) ? 1.f : 0.f) - ps; \
                to[(i) >> 2] = (r4 == ((i) & 3)) ? val : to[(i) >> 2]; asm volatile("" ::: "memory"); }
#define GDNA_ROWS8(b) GDNA_ROW(b) GDNA_ROW(b + 1) GDNA_ROW(b + 2) GDNA_ROW(b + 3) GDNA_ROW(b + 4) GDNA_ROW(b + 5) GDNA_ROW(b + 6) GDNA_ROW(b + 7)
            GDNA_ROW(1) GDNA_ROW(2) GDNA_ROW(3) GDNA_ROW(4) GDNA_ROW(5) GDNA_ROW(6) GDNA_ROW(7)
            GDNA_ROWS8(8) GDNA_ROWS8(16) GDNA_ROWS8(24) GDNA_ROWS8(32) GDNA_ROWS8(40) GDNA_ROWS8(48) GDNA_ROWS8(56)
#undef GDNA_ROWS8
#undef GDNA_ROW
            const int cc = sd ? 63 - c : c; const float be = sc[128 + sd * 64 + cc], s1 = be * __expf(sc[256 + sd * 64 + cc]);
            LAS bf16_t* T1 = (LAS bf16_t*)(L + (sd ? TB : TF)); LAS bf16_t* T2 = T1 + 64 * 72;
#pragma unroll
            for (int m = 0; m < 16; ++m) { const int j = 4 * m + r4, ii = sd ? 63 - j : j; T1[ii * 72 + cc] = f2bf(to[m] * s1); T2[ii * 72 + cc] = f2bf(to[m] * be); }
        }
        {
            bf16_t* kt = GKT + (size_t)item * 8192;
#pragma unroll
            for (int i = 0; i < 2; ++i) { const int e = THR + i * NT, row = e >> 3, ch = e & 7; *(u32x4*)(kt + row * 64 + ch * 8) = *(const LAS u32x4*)(L + KT + row * 144 + ch * 16); }
            if (THR < 128) { const int dir = THR >> 6, i = THR & 63; const float gc = sc[256 + dir * 64 + i], gl = sc[256 + dir * 64 + (dir ? 0 : 63)];
                float* o = GSC + (size_t)(item * 2 + dir) * 132; o[i] = __expf(gc); o[64 + i] = __expf(gl - gc); if (i == 0) o[128] = __expf(gl); }
        }
        __syncthreads();
#pragma unroll 4
        for (int ti = 0; ti < 16; ++ti) { const int id = wid * 16 + ti, dir = id >> 6, isU = (id >> 5) & 1, x = (id >> 2) & 7, y = id & 3;
            const int t1 = dir ? TB : TF; f32x4 acc = {0.f, 0.f, 0.f, 0.f};
#pragma unroll
            for (int s2 = 0; s2 < 2; ++s2) {
                bf16x8 a, bb;
                if (!isU) { a = *(const LAS bf16x8*)(L + KT + (16 * x + l15) * 144 + (32 * s2 + 8 * q4) * 2); bb = *(const LAS bf16x8*)(L + t1 + (16 * y + l15) * 144 + (32 * s2 + 8 * q4) * 2); }
                else { a = *(const LAS bf16x8*)(L + t1 + 64 * 144 + (16 * y + l15) * 144 + (32 * s2 + 8 * q4) * 2); bb = *(const LAS bf16x8*)(L + VT + (16 * x + l15) * 144 + (32 * s2 + 8 * q4) * 2); }
                acc = __builtin_amdgcn_mfma_f32_16x16x32_bf16(a, bb, acc, 0, 0, 0); }
            const bf16x4 o = pack4(acc[0], acc[1], acc[2], acc[3]);
            if (!isU) *(bf16x4*)(GW + (size_t)(item * 2 + dir) * 8192 + (16 * y + l15) * 128 + 16 * x + 4 * q4) = o;
            else *(bf16x4*)(GUT + (size_t)(item * 2 + dir) * 8192 + (16 * x + l15) * 64 + 16 * y + 4 * q4) = o; }
#pragma unroll
        for (int mat = 0; mat < 3; ++mat)
#pragma unroll
            for (int r = 0; r < 12; ++r) rawc[mat][r] = rawn[mat][r];
        bac = ban;
        __syncthreads();
    }
}

__device__ __forceinline__ void ph_gdnb(const Params& p, float* smem) {
    if (blockIdx.x >= B_ * NH * 2 * 2) return;
    LAS unsigned char* L = (LAS unsigned char*)smem;
    constexpr int BUF = 62464 + 1024, OW = 0, OQ = 17408, OK_ = 34816, OQK = 53248, OSC = 62464;
    const int half = (blockIdx.x >> 3) & 1, seq = (blockIdx.x & 7) | ((blockIdx.x >> 4) << 3), dir = seq & 1, h = (seq >> 1) & 3, b = seq >> 3;
    const bf16_t* GQN = (const bf16_t*)(p.ws + WS_GQN);
    const bf16_t* GW = (const bf16_t*)(p.ws + WS_GW); const bf16_t* GUT = (const bf16_t*)(p.ws + WS_GUT); const bf16_t* GQK = (const bf16_t*)(p.ws + WS_GQK); const bf16_t* GKT = (const bf16_t*)(p.ws + WS_GKT);
    const float* GSC = (const float*)((unsigned char*)p.out + OUT_GSC);
    bf16_t* GO = (bf16_t*)((unsigned char*)p.out + OUT_GO) + (size_t)dir * T_ * GDW;
    auto stage = [&](int n, int buf, int tt, auto nth_tag) {
        constexpr int NTH = decltype(nth_tag)::value, NCH = 3584 / NTH;
        const int item = (b * 4 + h) * 32 + n;
        u32x4 d[NCH];
#pragma unroll
        for (int i = 0; i < NCH; ++i) { const int e = tt + i * NTH; const u32x4* src;
            if (e < 1024) src = (const u32x4*)(GW + (size_t)(item * 2 + dir) * 8192) + e;
            else if (e < 2048) src = (const u32x4*)(GQN + (size_t)item * 8192) + (e - 1024);
            else if (e < 3072) src = (const u32x4*)(GKT + (size_t)item * 8192) + (e - 2048);
            else src = (const u32x4*)(GQK + (size_t)(item * 2 + dir) * 4096) + (e - 3072);
            d[i] = *src; }
        const float scv = (tt < 132) ? GSC[(size_t)(item * 2 + dir) * 132 + tt] : 0.f;
#pragma unroll
        for (int i = 0; i < NCH; ++i) { const int e = tt + i * NTH; int off;
            if (e < 1024) off = OW + (e >> 4) * 272 + (e & 15) * 16;
            else if (e < 2048) off = OQ + ((e - 1024) >> 4) * 272 + (e & 15) * 16;
            else if (e < 3072) off = OK_ + ((e - 2048) >> 3) * 144 + (e & 7) * 16;
            else off = OQK + ((e - 3072) >> 3) * 144 + (e & 7) * 16;
            *(LAS u32x4*)(L + buf * BUF + off) = d[i]; }
        if (tt < 132) *(LAS float*)(L + buf * BUF + OSC + tt * 4) = scv;
    };
    auto loadu = [&](bf16x4 (&u)[4], int n) {
        const int THR = ltid(); const int lane = THR & 63, wid = THR >> 6, l15 = lane & 15, q4 = lane >> 4, dv0 = half * 64 + (wid & 3) * 16;
        const bf16_t* ut = GUT + (size_t)(((b * 4 + h) * 32 + n) * 2 + dir) * 8192 + (size_t)(dv0 + l15) * 64 + 4 * q4;
#pragma unroll
        for (int mt = 0; mt < 4; ++mt) u[mt] = *(const bf16x4*)(ut + 16 * mt);
    };
    f32x4 S[8]; bf16x8 Sb[4];
#pragma unroll
    for (int i = 0; i < 8; ++i) S[i] = (f32x4){0.f, 0.f, 0.f, 0.f};
#pragma unroll
    for (int i = 0; i < 4; ++i) Sb[i] = (bf16x8){0, 0, 0, 0, 0, 0, 0, 0};
    auto compute = [&](int n, int buf, const bf16x4 (&uraw)[4]) {
        const int THR = ltid(); const int lane = THR & 63, wid = THR >> 6, l15 = lane & 15, q4 = lane >> 4, dv0 = half * 64 + (wid & 3) * 16;
        const LAS unsigned char* Bf = L + buf * BUF; const LAS float* scl = (const LAS float*)(Bf + OSC);
        f32x4 ws[4], qs[4];
        {
            bf16x8 fa[4][4];
#pragma unroll
            for (int mt = 0; mt < 4; ++mt)
#pragma unroll
                for (int s4 = 0; s4 < 4; ++s4) { const LAS unsigned char* r = Bf + OW + (16 * mt + l15) * 272 + (32 * s4 + 4 * q4) * 2; fa[mt][s4] = cat44(*(const LAS bf16x4*)r, *(const LAS bf16x4*)(r + 32)); }
#pragma unroll
            for (int mt = 0; mt < 4; ++mt) { ws[mt] = (f32x4){0.f, 0.f, 0.f, 0.f};
#pragma unroll
                for (int s4 = 0; s4 < 4; ++s4) ws[mt] = __builtin_amdgcn_mfma_f32_16x16x32_bf16(fa[mt][s4], Sb[s4], ws[mt], 0, 0, 0); }
        }
        {
            bf16x8 fa[4][4];
#pragma unroll
            for (int mt = 0; mt < 4; ++mt)
#pragma unroll
                for (int s4 = 0; s4 < 4; ++s4) { const LAS unsigned char* r = Bf + OQ + (16 * mt + l15) * 272 + (32 * s4 + 4 * q4) * 2; fa[mt][s4] = cat44(*(const LAS bf16x4*)r, *(const LAS bf16x4*)(r + 32)); }
#pragma unroll
            for (int mt = 0; mt < 4; ++mt) { qs[mt] = (f32x4){0.f, 0.f, 0.f, 0.f};
#pragma unroll
                for (int s4 = 0; s4 < 4; ++s4) qs[mt] = __builtin_amdgcn_mfma_f32_16x16x32_bf16(fa[mt][s4], Sb[s4], qs[mt], 0, 0, 0); }
        }
        f32x4 vn[4], vs[4];
#pragma unroll
        for (int mt = 0; mt < 4; ++mt) { const f32x4 es = *(const LAS f32x4*)(scl + 64 + 16 * mt + 4 * q4);
#pragma unroll
            for (int r = 0; r < 4; ++r) { const float u = __uint_as_float(((unsigned)(unsigned short)uraw[mt][r]) << 16); vn[mt][r] = u - ws[mt][r]; vs[mt][r] = vn[mt][r] * es[r]; } }
        bf16x8 vb[2], vsb[2];
#pragma unroll
        for (int s2 = 0; s2 < 2; ++s2) { vb[s2] = cat44(pack4(vn[2 * s2][0], vn[2 * s2][1], vn[2 * s2][2], vn[2 * s2][3]), pack4(vn[2 * s2 + 1][0], vn[2 * s2 + 1][1], vn[2 * s2 + 1][2], vn[2 * s2 + 1][3]));
            vsb[s2] = cat44(pack4(vs[2 * s2][0], vs[2 * s2][1], vs[2 * s2][2], vs[2 * s2][3]), pack4(vs[2 * s2 + 1][0], vs[2 * s2 + 1][1], vs[2 * s2 + 1][2], vs[2 * s2 + 1][3])); }
        bf16x8 fk[8][2];
        {
            bf16x8 fq[4][2];
#pragma unroll
            for (int it = 0; it < 4; ++it)
#pragma unroll
                for (int s2 = 0; s2 < 2; ++s2) { const LAS unsigned char* r = Bf + OQK + (16 * it + l15) * 144 + (32 * s2 + 4 * q4) * 2; fq[it][s2] = cat44(*(const LAS bf16x4*)r, *(const LAS bf16x4*)(r + 32)); }
#pragma unroll
            for (int t8 = 0; t8 < 8; ++t8)
#pragma unroll
                for (int s2 = 0; s2 < 2; ++s2) { const LAS unsigned char* r = Bf + OK_ + (16 * t8 + l15) * 144 + (32 * s2 + 4 * q4) * 2; fk[t8][s2] = cat44(*(const LAS bf16x4*)r, *(const LAS bf16x4*)(r + 32)); }
#pragma unroll
            for (int it = 0; it < 4; ++it) { f32x4 o2 = {0.f, 0.f, 0.f, 0.f};
#pragma unroll
                for (int s2 = 0; s2 < 2; ++s2) o2 = __builtin_amdgcn_mfma_f32_16x16x32_bf16(fq[it][s2], vb[s2], o2, 0, 0, 0);
                const f32x4 eg4 = *(const LAS f32x4*)(scl + 16 * it + 4 * q4);
#pragma unroll
                for (int r = 0; r < 4; ++r) { const int tok = 16 * it + 4 * q4 + r; const float o = eg4[r] * qs[it][r] + o2[r];
                    GO[((size_t)b * S_ + n * 64 + tok) * GDW + h * 128 + dv0 + l15] = f2bf(o); } }
        }
        const float eg = scl[128];
#pragma unroll
        for (int t8 = 0; t8 < 8; ++t8) { f32x4 c = S[t8] * eg;
#pragma unroll
            for (int s2 = 0; s2 < 2; ++s2) c = __builtin_amdgcn_mfma_f32_16x16x32_bf16(fk[t8][s2], vsb[s2], c, 0, 0, 0);
            S[t8] = c; }
#pragma unroll
        for (int s4 = 0; s4 < 4; ++s4) Sb[s4] = cat44(pack4(S[2 * s4][0], S[2 * s4][1], S[2 * s4][2], S[2 * s4][3]), pack4(S[2 * s4 + 1][0], S[2 * s4 + 1][1], S[2 * s4 + 1][2], S[2 * s4 + 1][3]));
    };
    const int n0 = dir ? 31 : 0, dn = dir ? -1 : 1;
    const int wid0 = __builtin_amdgcn_readfirstlane(ltid() >> 6);
    { const int THR = ltid(); stage(n0, 0, THR, std::integral_constant<int, 512>()); }
    __syncthreads();
    if (wid0 >= 4) {
        const int tt = ltid() - 256;
        constexpr int NCH = 14;
        auto ld = [&](u32x4 (&d)[NCH], float& scv, int n) {
            const int item = (b * 4 + h) * 32 + n;
#pragma unroll
            for (int i = 0; i < NCH; ++i) { const int e = tt + i * 256; const u32x4* src;
                if (e < 1024) src = (const u32x4*)(GW + (size_t)(item * 2 + dir) * 8192) + e;
                else if (e < 2048) src = (const u32x4*)(GQN + (size_t)item * 8192) + (e - 1024);
                else if (e < 3072) src = (const u32x4*)(GKT + (size_t)item * 8192) + (e - 2048);
                else src = (const u32x4*)(GQK + (size_t)(item * 2 + dir) * 4096) + (e - 3072);
                d[i] = *src; }
            scv = (tt < 132) ? GSC[(size_t)(item * 2 + dir) * 132 + tt] : 0.f;
        };
        auto st_ = [&](const u32x4 (&d)[NCH], float scv, int buf) {
#pragma unroll
            for (int i = 0; i < NCH; ++i) { const int e = tt + i * 256; int off;
                if (e < 1024) off = OW + (e >> 4) * 272 + (e & 15) * 16;
                else if (e < 2048) off = OQ + ((e - 1024) >> 4) * 272 + (e & 15) * 16;
                else if (e < 3072) off = OK_ + ((e - 2048) >> 3) * 144 + (e & 7) * 16;
                else off = OQK + ((e - 3072) >> 3) * 144 + (e & 7) * 16;
                *(LAS u32x4*)(L + buf * BUF + off) = d[i]; }
            if (tt < 132) *(LAS float*)(L + buf * BUF + OSC + tt * 4) = scv;
        };
        u32x4 r0[NCH], r1[NCH]; float c0 = 0.f, c1 = 0.f;
        ld(r0, c0, n0 + dn);
        for (int st = 0; st < 32; st += 2) {
            if (st + 2 < 32) ld(r1, c1, n0 + dn * (st + 2));
            st_(r0, c0, 1);
            __syncthreads();
            if (st + 3 < 32) ld(r0, c0, n0 + dn * (st + 3));
            if (st + 2 < 32) st_(r1, c1, 0);
            __syncthreads();
        }
    } else {
        bf16x4 uA[4], uB[4];
        loadu(uA, n0); loadu(uB, n0 + dn);
        for (int st = 0; st < 32; st += 2) {
            { bf16x4 uc[4];
#pragma unroll
              for (int mt = 0; mt < 4; ++mt) uc[mt] = uA[mt];
              if (st + 2 < 32) loadu(uA, n0 + dn * (st + 2));
              compute(n0 + dn * st, 0, uc);
              __syncthreads(); }
            { bf16x4 uc[4];
#pragma unroll
              for (int mt = 0; mt < 4; ++mt) uc[mt] = uB[mt];
              if (st + 3 < 32) loadu(uB, n0 + dn * (st + 3));
              compute(n0 + dn * (st + 1), 1, uc);
              __syncthreads(); }
        }
    }
}
__device__ __forceinline__ void ph_gdncomb(const Params& p, float* smem) {
    const int THR = ltid();
    const bf16_t* O = (const bf16_t*)((unsigned char*)p.out + OUT_GO); const bf16_t* zb = (const bf16_t*)(p.ws + WS_ZB); bf16_t* cat = (bf16_t*)(p.ws + WS_CAT); const float* gn = p.in[I_GDN_NORM];
    const int lane = THR & 63, gw = blockIdx.x * NW + (THR >> 6), nw = gridDim.x * NW;
    const f4_t g0 = ((const f4_t*)gn)[(lane & 15) * 2], g1 = ((const f4_t*)gn)[(lane & 15) * 2 + 1];
    const float gg[8] = {g0.x, g0.y, g0.z, g0.w, g1.x, g1.y, g1.z, g1.w};
    const float* ssq5 = (const float*)(p.ws + WS_SSQ); const f4_t n0 = ((const f4_t*)p.in[I_S5_NORM])[lane * 2], n1 = ((const f4_t*)p.in[I_S5_NORM])[lane * 2 + 1];
    const float nn[8] = {n0.x, n0.y, n0.z, n0.w, n1.x, n1.y, n1.z, n1.w};
    for (int t0 = gw * 4; t0 < T_; t0 += nw * 4) {
        u4_t of[4], ob[4], zz[4], s5[4]; float r5[4];
#pragma unroll
        for (int r = 0; r < 4; ++r) { const size_t t = t0 + r; s5[r] = ((const u4_t*)(cat + t * D_))[lane]; r5[r] = rsqrtf(ssq5[t] * (1.f / (float)S5W) + RMS_EPS); of[r] = ((const u4_t*)(O + t * GDW))[lane]; ob[r] = ((const u4_t*)(O + (size_t)T_ * GDW + t * GDW))[lane]; zz[r] = ((const u4_t*)(zb + t * GDW))[lane]; }
#pragma unroll
        for (int r = 0; r < 4; ++r) {
            float a[8]; float ss = 0.f;
#pragma unroll
            for (int k = 0; k < 4; ++k) { a[2 * k] = bflo(of[r][k]) + bflo(ob[r][k]); a[2 * k + 1] = bfhi(of[r][k]) + bfhi(ob[r][k]); ss += a[2 * k] * a[2 * k] + a[2 * k + 1] * a[2 * k + 1]; }
            ss = dpp_sum16(ss);
            const float rs = rsqrtf(ss * (1.f / 128.f) + RMS_EPS);
            float o[8];
#pragma unroll
            for (int k = 0; k < 4; ++k) { o[2 * k] = a[2 * k] * rs * gg[2 * k] * siluf_(bflo(zz[r][k])); o[2 * k + 1] = a[2 * k + 1] * rs * gg[2 * k + 1] * siluf_(bfhi(zz[r][k])); }
            u4_t w; w.x = pkbf(o[0], o[1]); w.y = pkbf(o[2], o[3]); w.z = pkbf(o[4], o[5]); w.w = pkbf(o[6], o[7]);
            ((u4_t*)(cat + (size_t)(t0 + r) * D_ + 512))[lane] = w;
            u4_t v5;
#pragma unroll
            for (int k = 0; k < 4; ++k) v5[k] = pkbf(bflo(s5[r][k]) * r5[r] * nn[2 * k], bfhi(s5[r][k]) * r5[r] * nn[2 * k + 1]);
            ((u4_t*)(cat + (size_t)(t0 + r) * D_))[lane] = v5; }
    }
}
__device__ __forceinline__ void ph_router(const Params& p, float* smem) {
    const int THR = ltid();
    const bf16_t* x2 = (const bf16_t*)(p.ws + WS_XB); bf16_t* xs = (bf16_t*)(p.ws + WS_XS); int* route = (int*)(p.ws + WS_ROUTE); int* mc = (int*)(p.ws + WS_CNT);
    const float* gn = p.in[I_NORM_MOE]; const float* bg = p.in[I_RG_B]; const float* be = p.in[I_RE_B]; const float* WrT = (const float*)(p.ws + WS_WRT);
    const int lane = THR & 63, gw = blockIdx.x * NW + (THR >> 6), nw = gridDim.x * NW;
    { LAS f4_t* lw = (LAS f4_t*)smem; const f4_t* src = (const f4_t*)(WrT + 4 * D_);
#pragma unroll 4
      for (int i = THR; i < 32 * D_ / 4; i += NT) lw[i] = src[i]; }
    __syncthreads();
    for (int t0 = gw * 4; t0 < T_; t0 += nw * 4) {
        f4_t xv[4][4]; float rs[4];
        { u2_t raw[4][4];
#pragma unroll
          for (int r = 0; r < 4; ++r)
#pragma unroll
            for (int j = 0; j < 4; ++j) raw[r][j] = ((const u2_t*)(x2 + (size_t)(t0 + r) * D_))[lane + 64 * j];
#pragma unroll
          for (int r = 0; r < 4; ++r)
#pragma unroll
            for (int j = 0; j < 4; ++j) xv[r][j] = (f4_t){bflo(raw[r][j].x), bfhi(raw[r][j].x), bflo(raw[r][j].y), bfhi(raw[r][j].y)}; }
#pragma unroll
        for (int r = 0; r < 4; ++r) { float ss = 0.f;
#pragma unroll
            for (int j = 0; j < 4; ++j) ss += xv[r][j].x * xv[r][j].x + xv[r][j].y * xv[r][j].y + xv[r][j].z * xv[r][j].z + xv[r][j].w * xv[r][j].w;
            rs[r] = rsqrtf(wave_sum(ss) * (1.f / (float)D_) + RMS_EPS); }
        LAS float* lgs = (LAS float*)smem + 32768 + (THR >> 6) * 160;
        const float* Wl = WrT + lane * 4; const LAS float* Ll = (const LAS float*)smem + lane * 4;
#pragma unroll 2
        for (int o = 0; o < 4; ++o) {
            f4_t w[4];
#pragma unroll
            for (int j = 0; j < 4; ++j) w[j] = *(const f4_t*)(Wl + (size_t)o * D_ + 256 * j);
            const float bias = bg[o];
#pragma unroll
            for (int r = 0; r < 4; ++r) { float a = 0.f;
#pragma unroll
                for (int j = 0; j < 4; ++j) a += xv[r][j].x * w[j].x + xv[r][j].y * w[j].y + xv[r][j].z * w[j].z + xv[r][j].w * w[j].w;
                const float tot = wave_sum(a) * rs[r] + bias; if (lane == 0) lgs[r * 40 + o] = tot; }
        }
#pragma unroll 2
        for (int o = 0; o < 32; ++o) {
            f4_t w[4];
#pragma unroll
            for (int j = 0; j < 4; ++j) w[j] = *(const LAS f4_t*)(Ll + o * D_ + 256 * j);
            const float bias = be[o];
#pragma unroll
            for (int r = 0; r < 4; ++r) { float a = 0.f;
#pragma unroll
                for (int j = 0; j < 4; ++j) a += xv[r][j].x * w[j].x + xv[r][j].y * w[j].y + xv[r][j].z * w[j].z + xv[r][j].w * w[j].w;
                const float tot = wave_sum(a) * rs[r] + bias; if (lane == 0) lgs[r * 40 + 4 + o] = tot; }
        }
        asm volatile("s_waitcnt lgkmcnt(0)" ::: "memory");
        float mine[36];
        if (lane < 4) {
#pragma unroll
            for (int o = 0; o < 36; ++o) mine[o] = lgs[lane * 40 + o];
        }
        int r0v = 0, r1v = 0;
        if (lane < 4) {
            int gi = 0; float gm = mine[0];
#pragma unroll
            for (int g = 1; g < 4; ++g) if (mine[g] > gm) { gm = mine[g]; gi = g; }
            float gs = 0.f;
#pragma unroll
            for (int g = 0; g < 4; ++g) gs += __expf(mine[g] - gm);
            const float ptop = 1.f / gs;
            float el[8];
#pragma unroll
            for (int e = 0; e < 8; ++e) { float v = mine[4 + e];
#pragma unroll
                for (int g = 1; g < 4; ++g) v = (gi == g) ? mine[4 + g * 8 + e] : v;
                el[e] = v; }
            int i0 = 0; float v0 = el[0];
#pragma unroll
            for (int e = 1; e < 8; ++e) if (el[e] > v0) { v0 = el[e]; i0 = e; }
            int i1 = -1; float v1 = -1e30f;
#pragma unroll
            for (int e = 0; e < 8; ++e) if (e != i0 && el[e] > v1) { v1 = el[e]; i1 = e; }
            const float e1 = __expf(v1 - v0), w0 = ptop / (1.f + e1), w1 = ptop * e1 / (1.f + e1);
            const int ea = gi * 8 + i0, eb = gi * 8 + i1;
            const int pa = atomicAdd(mc + ea * MC_CS, 1), pbb = atomicAdd(mc + eb * MC_CS, 1);
            unsigned* ma = (unsigned*)mc + MC_MAP + ea * 128 + (pa >> 8); unsigned* mb = (unsigned*)mc + MC_MAP + eb * 128 + (pbb >> 8);
            if ((pa & 255) == 0)  { const int tid = atomicAdd(mc + MC_NT, 1); mc[MC_REV + tid] = ea; __hip_atomic_store(ma, (unsigned)tid + 1u, __ATOMIC_RELAXED, __HIP_MEMORY_SCOPE_AGENT); }
            if ((pbb & 255) == 0) { const int tid = atomicAdd(mc + MC_NT, 1); mc[MC_REV + tid] = eb; __hip_atomic_store(mb, (unsigned)tid + 1u, __ATOMIC_RELAXED, __HIP_MEMORY_SCOPE_AGENT); }
            asm volatile("" ::: "memory");
            unsigned ta, tb, sp = 0u;
            while ((ta = __hip_atomic_load(ma, __ATOMIC_RELAXED, __HIP_MEMORY_SCOPE_AGENT)) == 0u) { __builtin_amdgcn_s_sleep(1); if (++sp > (1u << 22)) break; }
            while ((tb = __hip_atomic_load(mb, __ATOMIC_RELAXED, __HIP_MEMORY_SCOPE_AGENT)) == 0u) { __builtin_amdgcn_s_sleep(1); if (++sp > (1u << 22)) break; }
            r0v = (int)(ta - 1u) * 256 + (pa & 255); r1v = (int)(tb - 1u) * 256 + (pbb & 255);
            int* rr = route + (size_t)(t0 + lane) * 8; rr[0] = ea; rr[1] = eb; ((float*)rr)[2] = w0; ((float*)rr)[3] = w1; rr[6] = r0v; rr[7] = r1v;
        }
#pragma unroll
        for (int r = 0; r < 4; ++r) {
            const int d0 = __builtin_amdgcn_readlane(r0v, r), d1 = __builtin_amdgcn_readlane(r1v, r);
            u2_t* q0 = (u2_t*)(xs + (size_t)d0 * D_); u2_t* q1 = (u2_t*)(xs + (size_t)d1 * D_);
#pragma unroll
            for (int j = 0; j < 4; ++j) { const f4_t g = ((const f4_t*)gn)[lane + 64 * j]; const f4_t o = xv[r][j] * rs[r] * g; u2_t w; w.x = pkbf(o.x, o.y); w.y = pkbf(o.z, o.w); q0[lane + 64 * j] = w; q1[lane + 64 * j] = w; } }
    }
}
__device__ __forceinline__ void moe_build_table(const Params& p, int* tab) {
    const int THR = ltid();
    const int* mc = (const int*)(p.ws + WS_CNT);
    if (THR == 0) tab[0] = mc[MC_NT];
    if (THR < 160) tab[40 + THR] = mc[MC_REV + THR];
    __syncthreads();
}
__device__ __forceinline__ void ph_final(const Params& p, float* smem) {
    const int THR = ltid();
    float* out = p.out; const bf16_t* x2 = (const bf16_t*)(p.ws + WS_XB); const float* gn = p.in[I_NORM_FINAL]; const bf16_t* Y = (const bf16_t*)(p.ws + WS_XS); const int* route = (const int*)(p.ws + WS_ROUTE);
    const int lane = THR & 63, gw = blockIdx.x * NW + (THR >> 6), nw = gridDim.x * NW;
    f4_t g[4];
#pragma unroll
    for (int j = 0; j < 4; ++j) g[j] = ((const f4_t*)gn)[lane + 64 * j];
    for (int t0 = gw * 2; t0 < T_; t0 += nw * 2) {
        f4_t xv[2][4]; u2_t xr[2][4], ya[2][4], yb[2][4]; float w0[2], w1[2];
#pragma unroll
        for (int r = 0; r < 2; ++r) { const int* rr = route + (size_t)(t0 + r) * 8; w0[r] = ((const float*)rr)[2]; w1[r] = ((const float*)rr)[3];
            const u2_t* y0 = (const u2_t*)(Y + (size_t)rr[6] * D_); const u2_t* y1 = (const u2_t*)(Y + (size_t)rr[7] * D_);
#pragma unroll
            for (int j = 0; j < 4; ++j) { xr[r][j] = ((const u2_t*)(x2 + (size_t)(t0 + r) * D_))[lane + 64 * j]; ya[r][j] = y0[lane + 64 * j]; yb[r][j] = y1[lane + 64 * j]; } }
#pragma unroll
        for (int r = 0; r < 2; ++r) { float ss = 0.f;
#pragma unroll
            for (int j = 0; j < 4; ++j) { f4_t v = (f4_t){bflo(xr[r][j].x), bfhi(xr[r][j].x), bflo(xr[r][j].y), bfhi(xr[r][j].y)};
                v.x += w0[r] * bflo(ya[r][j].x) + w1[r] * bflo(yb[r][j].x); v.y += w0[r] * bfhi(ya[r][j].x) + w1[r] * bfhi(yb[r][j].x);
                v.z += w0[r] * bflo(ya[r][j].y) + w1[r] * bflo(yb[r][j].y); v.w += w0[r] * bfhi(ya[r][j].y) + w1[r] * bfhi(yb[r][j].y);
                xv[r][j] = v; ss += v.x * v.x + v.y * v.y + v.z * v.z + v.w * v.w; }
            const float rs = rsqrtf(wave_sum(ss) * (1.f / (float)D_) + RMS_EPS);
#pragma unroll
            for (int j = 0; j < 4; ++j) ((f4_t*)(out + (size_t)(t0 + r) * D_))[lane + 64 * j] = xv[r][j] * rs * g[j]; }
    }
}


typedef pg8::f32x4 f32x4; typedef pg8::u32x4 u32x4;

__device__ __forceinline__ void transpose_item(const float* W, int K, int N, bf16_t* WT, int ldt, int dst_row0, int k0, int n0, const float* rowscale, LAS float* scr, int lane) {
    f4_t v[8];
#pragma unroll
    for (int i = 0; i < 8; ++i) v[i] = *(const f4_t*)(W + (size_t)(k0 + (lane >> 3) + 8 * i) * N + n0 + 4 * (lane & 7));
#pragma unroll
    for (int i = 0; i < 8; ++i) { const int kk = (lane >> 3) + 8 * i; f4_t x = v[i]; if (rowscale) x = x * rowscale[k0 + kk];
        LAS float* d = scr + kk * 33 + 4 * (lane & 7); d[0] = x.x; d[1] = x.y; d[2] = x.z; d[3] = x.w; }
    asm volatile("s_waitcnt lgkmcnt(0)" ::: "memory");
    const int c = lane & 7;
#pragma unroll
    for (int j = 0; j < 4; ++j) { const int n = (lane >> 3) + 8 * j; const LAS float* sp = scr + (8 * c) * 33 + n;
        u32x4 o; o.x = pg8::cvt_pk_bf16(sp[0 * 33], sp[1 * 33]); o.y = pg8::cvt_pk_bf16(sp[2 * 33], sp[3 * 33]); o.z = pg8::cvt_pk_bf16(sp[4 * 33], sp[5 * 33]); o.w = pg8::cvt_pk_bf16(sp[6 * 33], sp[7 * 33]);
        *(u32x4*)(WT + (size_t)(dst_row0 + n) * ldt + k0 + 8 * c) = o; }
    asm volatile("s_waitcnt lgkmcnt(0)" ::: "memory");
}
__device__ __forceinline__ void transpose_matrix(const float* W, int K, int N, bf16_t* WT, const float* rowscale, float* smem) {
    const int THR = ltid();
    const int lane = THR & 63, wv = THR >> 6; LAS float* scr = (LAS float*)smem + wv * (64 * 33);
    const int gw = blockIdx.x * NW + wv, nw = gridDim.x * NW, nblk = N / 32, items = (K / 64) * nblk;
    for (int it = gw; it < items; it += nw) { const int kb = it / nblk, nb = it % nblk; transpose_item(W, K, N, WT, K, nb * 32, kb * 64, nb * 32, rowscale, scr, lane); }
}
__device__ __forceinline__ void ph_prep0(const Params& p, float* smem) {
    const int THR = ltid();
    bf16_t* WinT = (bf16_t*)((unsigned char*)p.out + OUT_WINT);
    {
        const int lane = THR & 63, wv = THR >> 6; LAS float* scr = (LAS float*)smem + wv * (64 * 33);
        const int gw = blockIdx.x * NW + wv, nw = gridDim.x * NW, nblk = 2560 / 32, items = 16 * nblk;
        for (int it = gw; it < items; it += nw) { const int kb = it / nblk, nb = it % nblk; transpose_item(p.in[I_W_IN], D_, DIN, WinT, D_, nb * 32, kb * 64, nb * 32, nullptr, scr, lane); }
        for (size_t i = (size_t)blockIdx.x * NT + THR; i < (size_t)256 * D_; i += (size_t)gridDim.x * NT) {
            const int n = (int)(i / D_), k = (int)(i % D_);
            WinT[(size_t)(2560 + n) * D_ + k] = n < 16 ? f2bf(p.in[I_W_IN][(size_t)k * DIN + 2560 + n]) : (bf16_t)0;
        }
    }
    transpose_matrix(p.in[I_W_GLU], S5W, S5W, (bf16_t*)((unsigned char*)p.out + OUT_WGLUT), nullptr, smem);
    transpose_matrix(p.in[I_WK], D_, D_, (bf16_t*)((unsigned char*)p.out + OUT_WKT), nullptr, smem);
    transpose_matrix(p.in[I_WV], D_, D_, (bf16_t*)((unsigned char*)p.out + OUT_WVT), nullptr, smem);
    { float* ssq = (float*)(p.ws + WS_SSQ); for (int i = blockIdx.x * NT + THR; i < 2 * T_; i += gridDim.x * NT) ssq[i] = 0.f; }
}
__device__ __forceinline__ void ph_prep1(const Params& p, float* smem) {
    transpose_matrix(p.in[I_W_OUT], D_, D_, (bf16_t*)(p.ws + WS_WOUTT), nullptr, smem);
}
__device__ __forceinline__ void ph_prepa(const Params& p, float* smem) {
    const int THR = ltid();
    bf16_t* WqB = (bf16_t*)(p.ws + WS_WQB); const float* wq = p.in[I_WQ]; const float* gx = p.in[I_NORM_XA];
    for (int i = blockIdx.x * NT + THR; i < D_ * D_ / 4; i += gridDim.x * NT) { const f4_t v = ((const f4_t*)wq)[i] * gx[i >> 8]; u2_t w; w.x = pkbf(v.x, v.y); w.y = pkbf(v.z, v.w); ((u2_t*)WqB)[i] = w; }
    transpose_matrix(p.in[I_WO], D_, D_, (bf16_t*)(p.ws + WS_WOT), nullptr, smem);
}
__device__ __forceinline__ void ph_prep2(const Params& p, float* smem) {
    const int THR = ltid();
    const int lane = THR & 63, wv = THR >> 6; LAS float* scr = (LAS float*)smem + wv * (64 * 33);
    const int gw = blockIdx.x * NW + wv, nw = gridDim.x * NW;
    bf16_t* WguT = (bf16_t*)(p.ws + WS_WGUT); bf16_t* WdT = (bf16_t*)(p.ws + WS_WDT);
    if (blockIdx.x == 0) for (int i = THR; i < MC_WORDS; i += NT) ((int*)(p.ws + WS_CNT))[i] = 0;
    { float* WrT = (float*)(p.ws + WS_WRT); const float* gnm = p.in[I_NORM_MOE];
      for (int i = blockIdx.x * NT + THR; i < 36 * D_; i += gridDim.x * NT) { const int o = i >> 10, k = i & 1023; WrT[i] = gnm[k] * (o < 4 ? p.in[I_RG_W][k * 4 + o] : p.in[I_RE_W][k * NE + (o - 4)]); } }
    for (int it = gw; it < NE * 2 * 128; it += nw) {
        const int e = it >> 8, which = (it >> 7) & 1, r = it & 127, kb = r >> 3, nb = r & 7, f0 = nb * 32;
        const float* W = p.in[which ? I_WUP : I_WGATE] + (size_t)e * D_ * DE;
        transpose_item(W, D_, DE, WguT, D_, e * 512 + (f0 >> 7) * 256 + which * 128 + (f0 & 127), kb * 64, f0, nullptr, scr, lane);
    }
    for (int it = gw; it < NE * 128; it += nw) {
        const int e = it >> 7, r = it & 127, kb = r >> 5, nb = r & 31;
        transpose_item(p.in[I_WDOWN] + (size_t)e * DE * D_, DE, D_, WdT, DE, e * D_ + nb * 32, kb * 64, nb * 32, nullptr, scr, lane);
    }
}

struct EpiInproj {
    static constexpr bool PERM = true;
    bf16_t* qkvr; bf16_t* zb; float* ba; bf16_t* aext;
    __device__ __forceinline__ void operator()(const f32x4 (&acc)[2][2][4][2], const pg8::Unit& u, int wr, int wc, int fr, int fq) const {
        const int row0 = u.orow + wr * 64 + fr;
        if (u.aux < 2) {
            const int col0 = u.ocol + wc * 32 + 8 * fq;
#pragma unroll
            for (int ai = 0; ai < 2; ++ai)
#pragma unroll
                for (int m = 0; m < 4; ++m) { const int t = row0 + ai * 128 + m * 16, n = t >> 4, j = t & 15;
#pragma unroll
                    for (int bj = 0; bj < 2; ++bj) { const int c = col0 + bj * 128, g = c >> 4, ci = c & 15; const f32x4 v0 = acc[ai][bj][m][0], v1 = acc[ai][bj][m][1];
                        u32x4 w; w.x = pg8::cvt_pk_bf16(v0[0], v0[1]); w.y = pg8::cvt_pk_bf16(v0[2], v0[3]); w.z = pg8::cvt_pk_bf16(v1[0], v1[1]); w.w = pg8::cvt_pk_bf16(v1[2], v1[3]);
                        *(u32x4*)(aext + ((size_t)g * 1024 + n) * 512 + j * 16 + ci) = w; } }
        } else if (u.aux < 10) {
            const int col0 = u.ocol + wc * 32 + 8 * fq;
#pragma unroll
            for (int ai = 0; ai < 2; ++ai)
#pragma unroll
                for (int m = 0; m < 4; ++m) { const int rr = row0 + ai * 128 + m * 16; bf16_t* rowp = (u.aux < 8) ? qkvr + (size_t)rr * QKV_LD + col0 - 512 : zb + (size_t)rr * GDW + col0 - 2048;
#pragma unroll
                    for (int bj = 0; bj < 2; ++bj) { const f32x4 v0 = acc[ai][bj][m][0], v1 = acc[ai][bj][m][1];
                        u32x4 w; w.x = pg8::cvt_pk_bf16(v0[0], v0[1]); w.y = pg8::cvt_pk_bf16(v0[2], v0[3]); w.z = pg8::cvt_pk_bf16(v1[0], v1[1]); w.w = pg8::cvt_pk_bf16(v1[2], v1[3]);
                        *(u32x4*)(rowp + bj * 128) = w; } }
        } else if (wc == 0 && fq < 2) {
#pragma unroll
            for (int ai = 0; ai < 2; ++ai)
#pragma unroll
                for (int m = 0; m < 4; ++m) { float* rowp = ba + (size_t)(row0 + ai * 128 + m * 16) * 16 + 8 * fq;
                    *(f32x4*)(rowp) = acc[ai][0][m][0]; *(f32x4*)(rowp + 4) = acc[ai][0][m][1]; }
        }
    }
};
struct EpiBf16Out {
    static constexpr bool PERM = true;
    bf16_t* O; int ldc; float scale; size_t aux_stride;
    __device__ __forceinline__ void operator()(const f32x4 (&acc)[2][2][4][2], const pg8::Unit& u, int wr, int wc, int fr, int fq) const {
        const int row0 = u.orow + wr * 64 + fr, col0 = u.ocol + wc * 32 + 8 * fq; bf16_t* base = O + (size_t)u.aux * aux_stride;
#pragma unroll
        for (int ai = 0; ai < 2; ++ai)
#pragma unroll
            for (int m = 0; m < 4; ++m) { bf16_t* rowp = base + (size_t)(row0 + ai * 128 + m * 16) * ldc + col0;
#pragma unroll
                for (int bj = 0; bj < 2; ++bj) { const f32x4 v0 = acc[ai][bj][m][0] * scale, v1 = acc[ai][bj][m][1] * scale;
                    u32x4 w; w.x = pg8::cvt_pk_bf16(v0[0], v0[1]); w.y = pg8::cvt_pk_bf16(v0[2], v0[3]); w.z = pg8::cvt_pk_bf16(v1[0], v1[1]); w.w = pg8::cvt_pk_bf16(v1[2], v1[3]);
                    *(u32x4*)(rowp + bj * 128) = w; } }
    }
};
struct EpiResid {
    static constexpr bool PERM = false;
    const float* base; const bf16_t* baseb; float* out; int ldc; bf16_t* xb; float* ssq;
    __device__ __forceinline__ void operator()(const f32x4 (&acc)[2][2][4][2], const pg8::Unit& u, int wr, int wc, int fr, int fq) const {
        const int row0 = u.orow + wr * 64 + fr, col0 = u.ocol + wc * 32 + 4 * fq;
#pragma unroll
        for (int ai = 0; ai < 2; ++ai)
#pragma unroll
            for (int m = 0; m < 4; ++m) { const size_t off = (size_t)(row0 + ai * 128 + m * 16) * ldc + col0; float ss = 0.f;
#pragma unroll
                for (int bj = 0; bj < 2; ++bj)
#pragma unroll
                    for (int n = 0; n < 2; ++n) { f32x4 b;
                        if (base) b = *(const f32x4*)(base + off + bj * 128 + n * 16);
                        else { const u2_t rb = *(const u2_t*)(baseb + off + bj * 128 + n * 16); b = (f32x4){bflo(rb.x), bfhi(rb.x), bflo(rb.y), bfhi(rb.y)}; }
                        const f32x4 o = b + acc[ai][bj][m][n]; if (out) *(f32x4*)(out + off + bj * 128 + n * 16) = o;
                        if (xb) { u2_t w; w.x = pkbf(o[0], o[1]); w.y = pkbf(o[2], o[3]); *(u2_t*)(xb + off + bj * 128 + n * 16) = w; ss += o[0] * o[0] + o[1] * o[1] + o[2] * o[2] + o[3] * o[3]; } }
                if (ssq) { ss += __shfl_xor(ss, 16); ss += __shfl_xor(ss, 32); if (fq == 0) atomicAdd(ssq + row0 + ai * 128 + m * 16, ss); }
                asm volatile("" ::: "memory"); }
    }
};
struct EpiGlu {
    static constexpr bool PERM = true;
    const bf16_t* gl; const float* bias; bf16_t* cat; float* ssq;
    __device__ __forceinline__ void operator()(const f32x4 (&acc)[2][2][4][2], const pg8::Unit& u, int wr, int wc, int fr, int fq) const {
        const int row0 = u.orow + wr * 64 + fr, col0 = u.ocol + wc * 32 + 8 * fq;
#pragma unroll
        for (int ai = 0; ai < 2; ++ai)
#pragma unroll
            for (int m = 0; m < 4; ++m) { const int r = row0 + ai * 128 + m * 16; float ss = 0.f;
#pragma unroll
                for (int bj = 0; bj < 2; ++bj) { const int c = col0 + bj * 128; const u4_t graw = *(const u4_t*)(gl + (size_t)r * S5W + c);
                    const f32x4 b0 = *(const f32x4*)(bias + c), b1 = *(const f32x4*)(bias + c + 4); const f32x4 a0 = acc[ai][bj][m][0] + b0, a1 = acc[ai][bj][m][1] + b1;
                    float o[8];
                    o[0] = bflo(graw.x) * sigmoidf_(a0[0]); o[1] = bfhi(graw.x) * sigmoidf_(a0[1]); o[2] = bflo(graw.y) * sigmoidf_(a0[2]); o[3] = bfhi(graw.y) * sigmoidf_(a0[3]);
                    o[4] = bflo(graw.z) * sigmoidf_(a1[0]); o[5] = bfhi(graw.z) * sigmoidf_(a1[1]); o[6] = bflo(graw.w) * sigmoidf_(a1[2]); o[7] = bfhi(graw.w) * sigmoidf_(a1[3]);
#pragma unroll
                    for (int e = 0; e < 8; ++e) ss += o[e] * o[e];
                    u4_t w; w.x = pkbf(o[0], o[1]); w.y = pkbf(o[2], o[3]); w.z = pkbf(o[4], o[5]); w.w = pkbf(o[6], o[7]);
                    *(u4_t*)(cat + (size_t)r * D_ + c) = w; }
                ss += __shfl_xor(ss, 16); ss += __shfl_xor(ss, 32); if (fq == 0) atomicAdd(ssq + r, ss);
                asm volatile("" ::: "memory"); }
    }
};
struct EpiBf16RowScale {
    static constexpr bool PERM = true;
    bf16_t* O; int ldc; float scale; const float* ssq;
    __device__ __forceinline__ void operator()(const f32x4 (&acc)[2][2][4][2], const pg8::Unit& u, int wr, int wc, int fr, int fq) const {
        const int row0 = u.orow + wr * 64 + fr, col0 = u.ocol + wc * 32 + 8 * fq;
#pragma unroll
        for (int ai = 0; ai < 2; ++ai)
#pragma unroll
            for (int m = 0; m < 4; ++m) { const int r = row0 + ai * 128 + m * 16; const float sc = rsqrtf(ssq[r] * (1.f / (float)D_) + RMS_EPS) * scale; bf16_t* rowp = O + (size_t)r * ldc + col0;
#pragma unroll
                for (int bj = 0; bj < 2; ++bj) { const f32x4 v0 = acc[ai][bj][m][0] * sc, v1 = acc[ai][bj][m][1] * sc;
                    u32x4 w; w.x = pg8::cvt_pk_bf16(v0[0], v0[1]); w.y = pg8::cvt_pk_bf16(v0[2], v0[3]); w.z = pg8::cvt_pk_bf16(v1[0], v1[1]); w.w = pg8::cvt_pk_bf16(v1[2], v1[3]);
                    *(u32x4*)(rowp + bj * 128) = w; } }
    }
};
struct EpiMoeUp {
    static constexpr bool PERM = true;
    bf16_t* hm;
    __device__ __forceinline__ void operator()(const f32x4 (&acc)[2][2][4][2], const pg8::Unit& u, int wr, int wc, int fr, int fq) const {
        const int row0 = u.orow + wr * 64 + fr, col0 = u.ocol + wc * 32 + 8 * fq;
#pragma unroll
        for (int ai = 0; ai < 2; ++ai)
#pragma unroll
            for (int m = 0; m < 4; ++m) { bf16_t* rowp = hm + (size_t)(row0 + ai * 128 + m * 16) * DE + col0;
                float h[8];
#pragma unroll
                for (int n = 0; n < 2; ++n)
#pragma unroll
                    for (int e = 0; e < 4; ++e) h[n * 4 + e] = siluf_(acc[ai][0][m][n][e]) * acc[ai][1][m][n][e];
                u32x4 w; w.x = pg8::cvt_pk_bf16(h[0], h[1]); w.y = pg8::cvt_pk_bf16(h[2], h[3]); w.z = pg8::cvt_pk_bf16(h[4], h[5]); w.w = pg8::cvt_pk_bf16(h[6], h[7]);
                *(u32x4*)rowp = w; }
    }
};

template <int NCOL> struct MoeOrder {
    const char* A; const char* W; const int* tab; int lda, wrows_per_expert, ldb, ocol_step, G, c;
    __device__ bool next(int i, pg8::Unit& u) const {
        const int L = i * G + c; if (L >= tab[0] * NCOL) return false;
        const int rt = L / NCOL, j = L % NCOL, e = tab[40 + rt];
        u.a = A + (size_t)rt * 256 * lda * 2; u.b = W + ((size_t)e * wrows_per_expert + j * 256) * ldb * 2; u.orow = rt * 256; u.ocol = j * ocol_step; u.aux = 0; return true;
    }
};

struct EpiF32Out {
    static constexpr bool PERM = false;
    float* O; int ldc; size_t aux_stride;
    __device__ __forceinline__ void operator()(const f32x4 (&acc)[2][2][4][2], const pg8::Unit& u, int wr, int wc, int fr, int fq) const {
        const int row0 = u.orow + wr * 64 + fr, col0 = u.ocol + wc * 32 + 4 * fq; float* base = O + (size_t)u.aux * aux_stride;
#pragma unroll
        for (int ai = 0; ai < 2; ++ai)
#pragma unroll
            for (int m = 0; m < 4; ++m) { float* rowp = base + (size_t)(row0 + ai * 128 + m * 16) * ldc + col0;
#pragma unroll
                for (int bj = 0; bj < 2; ++bj)
#pragma unroll
                    for (int n = 0; n < 2; ++n) *(f32x4*)(rowp + bj * 128 + n * 16) = acc[ai][bj][m][n]; }
    }
};
typedef float f32x2 __attribute__((ext_vector_type(2)));
__device__ __forceinline__ f32x2 gelu_pk(f32x2 v) {
    const f32x2 av = __builtin_elementwise_abs(v), d = av * 0.2316418882f + 1.0f;
    f32x2 t; t.x = __builtin_amdgcn_rcpf(d.x); t.y = __builtin_amdgcn_rcpf(d.y);
    f32x2 q = t * 0.5307027145f + (-0.7265760135f); q = q * t + 0.7107068705f; q = q * t + (-0.142248368f); q = q * t + 0.127414796f; q = q * t;
    const f32x2 s = (v * v) * (-0.72134752044f);
    f32x2 e; e.x = __builtin_amdgcn_exp2f(s.x); e.y = __builtin_amdgcn_exp2f(s.y);
    const f32x2 m = v * (q * e), r = v - m;
    f32x2 o; o.x = v.x < 0.f ? m.x : r.x; o.y = v.y < 0.f ? m.y : r.y; return o;
}
struct EpiS5Main {
    static constexpr bool PERM = true;
    bf16_t* gl;
    __device__ __forceinline__ void operator()(const f32x4 (&acc)[2][2][4][2], const pg8::Unit& u, int wr, int wc, int fr, int fq) const {
        const int row0 = u.orow + wr * 64 + fr, col0 = wc * 32 + 8 * fq, g = u.aux;
#pragma unroll
        for (int ai = 0; ai < 2; ++ai)
#pragma unroll
            for (int m = 0; m < 4; ++m) { const int n = row0 + ai * 128 + m * 16;
#pragma unroll
                for (int bj = 0; bj < 2; ++bj) { const int c = col0 + bj * 128, j = c >> 4, co = c & 15; const f32x4 v0 = acc[ai][bj][m][0], v1 = acc[ai][bj][m][1];
                    const f32x2 a = gelu_pk((f32x2){v0[0], v0[1]}), b = gelu_pk((f32x2){v0[2], v0[3]}), c2 = gelu_pk((f32x2){v1[0], v1[1]}), d2 = gelu_pk((f32x2){v1[2], v1[3]});
                    u32x4 w; w.x = pg8::cvt_pk_bf16(a.x, a.y); w.y = pg8::cvt_pk_bf16(b.x, b.y); w.z = pg8::cvt_pk_bf16(c2.x, c2.y); w.w = pg8::cvt_pk_bf16(d2.x, d2.y);
                    *(u32x4*)(gl + ((size_t)n * 16 + j) * S5W + g * 16 + co) = w; } }
    }
};
struct S5Order {
    const char* A; const char* Bm; int ldb, G, c;
    __device__ bool next(int i, pg8::Unit& u) const {
        const int L = i * G + c; if (L >= NG * 4) return false;
        const int g = L >> 2, pm = L & 3;
        u.a = A + ((size_t)g * 1024 + pm * 256) * 512 * 2; u.b = Bm + (size_t)g * 256 * ldb * 2; u.orow = pm * 256; u.ocol = 0; u.aux = g; return true;
    }
};
__device__ __forceinline__ void fp_s5estep(const Params& p, LAS unsigned char* lds, int G, int c) {
    S5Order S{(const char*)(p.ws + WS_AEXT), (const char*)p.out + OUT_EMAT, 256, G, c};
    EpiF32Out E{(float*)(p.ws + WS_HLOC), 256, (size_t)1024 * 256};
    pg8::gemm_phase(lds, 256, 512, 256, S, E);
}
__device__ __forceinline__ void fp_s5main(const Params& p, LAS unsigned char* lds, int G, int c) {
    S5Order S{(const char*)(p.ws + WS_AEXT), (const char*)p.out + OUT_MMAT, 512, G, c};
    EpiS5Main E{(bf16_t*)(p.ws + WS_GL)};
    pg8::gemm_phase(lds, 512, 512, 512, S, E);
}

__device__ __forceinline__ void fp_inproj(const Params& p, LAS unsigned char* lds) {
    pg8::DenseOrder S; S.init((const bf16_t*)(p.ws + WS_HB), D_, (const bf16_t*)((unsigned char*)p.out + OUT_WINT), D_, T_, NINP, gridDim.x, blockIdx.x);
    EpiInproj E{(bf16_t*)(p.ws + WS_QKVR), (bf16_t*)(p.ws + WS_ZB), (float*)((unsigned char*)p.out + OUT_BA), (bf16_t*)(p.ws + WS_AEXT)};
    pg8::gemm_phase(lds, D_, D_, D_, S, E);
}
__device__ __forceinline__ void fp_glu(const Params& p, LAS unsigned char* lds, int G, int c) {
    pg8::DenseOrder S; S.init((const bf16_t*)(p.ws + WS_GL), S5W, (const bf16_t*)((unsigned char*)p.out + OUT_WGLUT), S5W, T_, S5W, G, c);
    EpiGlu E{(const bf16_t*)(p.ws + WS_GL), p.in[I_B_GLU], (bf16_t*)(p.ws + WS_CAT), (float*)(p.ws + WS_SSQ)};
    pg8::gemm_phase(lds, S5W, S5W, S5W, S, E);
}
__device__ __forceinline__ void fp_outproj(const Params& p, LAS unsigned char* lds) {
    pg8::DenseOrder S; S.init((const bf16_t*)(p.ws + WS_CAT), D_, (const bf16_t*)(p.ws + WS_WOUTT), D_, T_, D_, gridDim.x, blockIdx.x);
    EpiResid E{p.in[I_X], nullptr, nullptr, D_, (bf16_t*)(p.ws + WS_XB), (float*)(p.ws + WS_SSQ) + T_};
    pg8::gemm_phase(lds, D_, D_, D_, S, E);
}
__device__ __forceinline__ void fp_kv(const Params& p, LAS unsigned char* lds) {
    {
        pg8::DenseOrder S; S.init((const bf16_t*)(p.ws + WS_MEMN), D_, (const bf16_t*)((unsigned char*)p.out + OUT_WKT), D_, B_ * MEM, D_, gridDim.x, (blockIdx.x + gridDim.x - 192) % gridDim.x);
        EpiBf16Out E{(bf16_t*)(p.ws + WS_KMEM), D_, 1.f, 0};
        pg8::gemm_phase(lds, D_, D_, D_, S, E);
    }
    {
        pg8::DenseOrder S; S.init((const bf16_t*)(p.ws + WS_MEMN), D_, (const bf16_t*)((unsigned char*)p.out + OUT_WVT), D_, B_ * MEM, D_, gridDim.x, (blockIdx.x + gridDim.x - 224) % gridDim.x);
        EpiBf16Out E{(bf16_t*)(p.ws + WS_VMEM), D_, 1.f, 0};
        pg8::gemm_phase(lds, D_, D_, D_, S, E);
    }
}
struct AttnPreOrder {
    const char* Kmem; const char* Vmem; const char* WqB; const char* WoT; int G, c;
    __device__ bool next(int i, pg8::Unit& u) const {
        const int L = i * G + c; if (L >= 256) return false;
        const int x = L & 3, h = (L >> 2) & 3, b = (L >> 4) & 7;
        if (L < 128) { u.a = Kmem + ((size_t)(b * MEM) * D_ + h * XD) * 2; u.b = WqB + ((size_t)(x * 256) * D_ + h * XD) * 2; u.orow = 0; u.ocol = x * 256; u.aux = b * 4 + h; }
        else { u.a = WoT + ((size_t)(x * 256) * D_ + h * XD) * 2; u.b = Vmem + ((size_t)(b * MEM) * D_ + h * XD) * 2; u.orow = x * 256; u.ocol = h * XD; u.aux = 64 + b; }
        return true;
    }
};
struct EpiAttnPre {
    static constexpr bool PERM = true;
    bf16_t* Mq; bf16_t* VWT;
    __device__ __forceinline__ void operator()(const f32x4 (&acc)[2][2][4][2], const pg8::Unit& u, int wr, int wc, int fr, int fq) const {
        bf16_t* base = (u.aux < 64) ? Mq + (size_t)u.aux * MEM * D_ : VWT + (size_t)(u.aux - 64) * D_ * D_;
        const int row0 = u.orow + wr * 64 + fr, col0 = u.ocol + wc * 32 + 8 * fq;
#pragma unroll
        for (int ai = 0; ai < 2; ++ai)
#pragma unroll
            for (int m = 0; m < 4; ++m) { bf16_t* rowp = base + (size_t)(row0 + ai * 128 + m * 16) * D_ + col0;
#pragma unroll
                for (int bj = 0; bj < 2; ++bj) { const f32x4 v0 = acc[ai][bj][m][0], v1 = acc[ai][bj][m][1];
                    u32x4 w; w.x = pg8::cvt_pk_bf16(v0[0], v0[1]); w.y = pg8::cvt_pk_bf16(v0[2], v0[3]); w.z = pg8::cvt_pk_bf16(v1[0], v1[1]); w.w = pg8::cvt_pk_bf16(v1[2], v1[3]);
                    *(u32x4*)(rowp + bj * 128) = w; } }
    }
};
__device__ __forceinline__ void fp_attn_pre(const Params& p, LAS unsigned char* lds) {
    AttnPreOrder S{(const char*)(p.ws + WS_KMEM), (const char*)(p.ws + WS_VMEM), (const char*)(p.ws + WS_WQB), (const char*)(p.ws + WS_WOT), (int)gridDim.x, (int)blockIdx.x};
    EpiAttnPre E{(bf16_t*)(p.ws + WS_MQ), (bf16_t*)(p.ws + WS_VWT)};
    pg8::gemm_phase(lds, XD, D_, D_, S, E);
}
struct AttnSOrder {
    const char* Xb; const char* Mq; int G, c;
    __device__ bool next(int i, pg8::Unit& u) const {
        const int L = i * G + c; if (L >= B_ * XH * 8) return false;
        const int pm = L & 7, h = (L >> 3) & 3, b = L >> 5;
        u.a = Xb + (size_t)(b * S_ + pm * 256) * D_ * 2; u.b = Mq + (size_t)((b * 4 + h) * MEM) * D_ * 2; u.orow = b * S_ + pm * 256; u.ocol = h * XD; u.aux = 0; return true;
    }
};
struct AttnWoOrder {
    const char* Pm; const char* VWT; int G, c;
    __device__ bool next(int i, pg8::Unit& u) const {
        const int L = i * G + c; if (L >= 256) return false;
        const int pn = L & 3, pm = (L >> 2) & 7, b = L >> 5;
        u.a = Pm + (size_t)(b * S_ + pm * 256) * D_ * 2; u.b = VWT + ((size_t)b * D_ + pn * 256) * D_ * 2; u.orow = b * S_ + pm * 256; u.ocol = pn * 256; u.aux = 0; return true;
    }
};
__device__ __forceinline__ void fp_attn_fused(const Params& p, LAS unsigned char* lds) {
    const int L = blockIdx.x; if (L >= B_ * XH * 8) return;
    {
        AttnSOrder S{(const char*)(p.ws + WS_XB), (const char*)(p.ws + WS_MQ), (int)gridDim.x, L};
        EpiBf16RowScale E{(bf16_t*)(p.ws + WS_PB), D_, 0.0625f, (const float*)(p.ws + WS_SSQ) + T_};
        pg8::gemm_phase(lds, D_, D_, D_, S, E);
    }
    {
        const int THR = ltid(); const int lane = THR & 63, wid = THR >> 6;
        const int pm = L & 7, h = (L >> 3) & 3, b = L >> 5;
        bf16_t* base = (bf16_t*)(p.ws + WS_PB) + (size_t)(b * S_ + pm * 256 + wid * 32 + (lane >> 4)) * D_ + h * XD + (lane & 15) * 16;
        u4_t ra[8], rb[8];
#pragma unroll
        for (int i = 0; i < 8; ++i) { ra[i] = *(const u4_t*)(base + (size_t)(4 * i) * D_); rb[i] = *(const u4_t*)(base + (size_t)(4 * i) * D_ + 8); }
#pragma unroll
        for (int i = 0; i < 8; ++i) {
            float v[16];
#pragma unroll
            for (int k = 0; k < 4; ++k) { v[2 * k] = bflo(ra[i][k]); v[2 * k + 1] = bfhi(ra[i][k]); v[8 + 2 * k] = bflo(rb[i][k]); v[9 + 2 * k] = bfhi(rb[i][k]); }
            float mx = v[0];
#pragma unroll
            for (int k = 1; k < 16; ++k) mx = fmaxf(mx, v[k]);
            mx = dpp_max16(mx);
            float sum = 0.f;
#pragma unroll
            for (int k = 0; k < 16; ++k) { v[k] = __expf(v[k] - mx); sum += v[k]; }
            const float inv = 1.f / dpp_sum16(sum);
            u4_t wa, wb;
#pragma unroll
            for (int k = 0; k < 4; ++k) { wa[k] = pkbf(v[2 * k] * inv, v[2 * k + 1] * inv); wb[k] = pkbf(v[8 + 2 * k] * inv, v[9 + 2 * k] * inv); }
            *(u4_t*)(base + (size_t)(4 * i) * D_) = wa; *(u4_t*)(base + (size_t)(4 * i) * D_ + 8) = wb; }
    }
}
__device__ __forceinline__ void fp_woproj(const Params& p, LAS unsigned char* lds) {
    AttnWoOrder S{(const char*)(p.ws + WS_PB), (const char*)(p.ws + WS_VWT), (int)gridDim.x, (int)blockIdx.x};
    EpiResid E{nullptr, (const bf16_t*)(p.ws + WS_XB), nullptr, D_, (bf16_t*)(p.ws + WS_XB), nullptr};
    pg8::gemm_phase(lds, D_, D_, D_, S, E);
}
constexpr int LDS_TAB_OFF = pg8::STAGE_BYTES;
__device__ __forceinline__ void fp_moeup(const Params& p, LAS unsigned char* lds, float* smem) {
    int* tab = (int*)((unsigned char*)smem + LDS_TAB_OFF); moe_build_table(p, tab);
    MoeOrder<2> S{(const char*)(p.ws + WS_XS), (const char*)(p.ws + WS_WGUT), tab, D_, 512, D_, 128, (int)gridDim.x, (int)blockIdx.x};
    EpiMoeUp E{(bf16_t*)(p.ws + WS_HM)};
    pg8::gemm_phase(lds, D_, D_, D_, S, E);
}
__device__ __forceinline__ void fp_moedown(const Params& p, LAS unsigned char* lds, float* smem) {
    int* tab = (int*)((unsigned char*)smem + LDS_TAB_OFF); moe_build_table(p, tab);
    MoeOrder<4> S{(const char*)(p.ws + WS_HM), (const char*)(p.ws + WS_WDT), tab, DE, D_, DE, 256, (int)gridDim.x, (int)blockIdx.x};
    EpiBf16Out E{(bf16_t*)(p.ws + WS_XS), D_, 1.f, 0};
    pg8::gemm_phase(lds, DE, DE, DE, S, E);
}


#define XB_TMO      128
#define XB_XCNT(j)  (256  + 64 * (j))
#define XB_XSUB(j)  (1280 + 64 * (j))
#define XB_XGEN(j)  (2304 + 64 * (j))
#define XB_TOP      3328
#define XB_TOPGEN   3392
#define XCD_BAR_WORDS 3456
#define XB_SPIN_CAP (1u << 18)
__device__ __forceinline__ unsigned xb_ld(unsigned* p)              { return __hip_atomic_load(p, __ATOMIC_RELAXED, __HIP_MEMORY_SCOPE_AGENT); }
__device__ __forceinline__ unsigned xb_add(unsigned* p, unsigned v) { return __hip_atomic_fetch_add(p, v, __ATOMIC_RELAXED, __HIP_MEMORY_SCOPE_AGENT); }
__device__ __forceinline__ unsigned xb_xcc_id() { return (unsigned)__builtin_amdgcn_s_getreg((3 << 11) | 20) & 0xFu; }
#define XB_SPIN(cond, bar) do { unsigned _sp = 0; while (cond) { __builtin_amdgcn_s_sleep(1); \
    if ((++_sp & 255u) == 0u) { if (xb_ld(&(bar)[XB_TMO])) break; if (_sp > XB_SPIN_CAP) { atomicAdd(&(bar)[XB_TMO], 1u); break; } } } } while (0)
struct XcdBarrier { unsigned* bar; unsigned x; volatile LAS unsigned* st; unsigned G; };
__device__ __forceinline__ XcdBarrier xcd_barrier_post(unsigned* bar, volatile LAS unsigned* st, unsigned G) {
    XcdBarrier b; b.bar = bar; b.x = xb_xcc_id(); b.st = st; b.G = G;
    if (threadIdx.x == 0) (void)xb_add(&bar[XB_XCNT(b.x)], 1u);
    return b;
}
__device__ __forceinline__ void xcd_barrier_complete(unsigned* bar, unsigned x, const unsigned G, unsigned& nloc, unsigned& nx) {
    unsigned sum, cnt, mine, sp = 0u;
    for (;;) {
        sum = 0u; cnt = 0u; mine = 0u;
#pragma unroll
        for (unsigned j = 0; j < 16; ++j) { const unsigned c = xb_ld(&bar[XB_XCNT(j)]); sum += c; cnt += (c > 0u) ? 1u : 0u; mine = (j == x) ? c : mine; }
        if (sum == G) break;
        __builtin_amdgcn_s_sleep(1);
        if ((++sp & 255u) == 0u) { if (xb_ld(&bar[XB_TMO])) break; if (sp > XB_SPIN_CAP) { atomicAdd(&bar[XB_TMO], 1u); break; } }
    }
    nloc = mine > 0u ? mine : 1u; nx = cnt > 0u ? cnt : 1u;
}
__device__ __forceinline__ void xcd_barrier(const XcdBarrier& b) {
    asm volatile("s_waitcnt vmcnt(0)" ::: "memory");
    __syncthreads();
    if (threadIdx.x == 0) {
        unsigned* bar = b.bar;
        __builtin_amdgcn_s_waitcnt(0);
        unsigned nloc = b.st[0], nx = b.st[1];
        if (nloc == 0u) { xcd_barrier_complete(bar, b.x, b.G, nloc, nx); b.st[0] = nloc; b.st[1] = nx; }
        const unsigned old = xb_add(&bar[XB_XSUB(b.x)], 1u);
        const unsigned gen = old / nloc;
        if (old + 1u == (gen + 1u) * nloc) {
            __builtin_amdgcn_fence(__ATOMIC_RELEASE, "agent");
            asm volatile("s_waitcnt vmcnt(0)" ::: "memory");
            const unsigned og = xb_add(&bar[XB_TOP], 1u);
            const unsigned tg = og / nx;
            if (og + 1u == (tg + 1u) * nx) xb_add(&bar[XB_TOPGEN], 1u);
            else XB_SPIN(xb_ld(&bar[XB_TOPGEN]) == tg, bar);
            __builtin_amdgcn_fence(__ATOMIC_ACQUIRE, "agent");
            xb_add(&bar[XB_XGEN(b.x)], 1u);
            asm volatile("s_waitcnt vmcnt(0)" ::: "memory");
        } else {
            XB_SPIN(xb_ld(&bar[XB_XGEN(b.x)]) == gen, bar);
            __builtin_amdgcn_fence(__ATOMIC_ACQUIRE, "agent");
            asm volatile("s_waitcnt vmcnt(0)" ::: "memory");
        }
    }
    __syncthreads();
}

constexpr int LDS_BYTES = 147456;
constexpr int LDS_BARST_OFF = LDS_BYTES - 16;

__global__ void __launch_bounds__(NT, 2) mega_fwd(Params p) {
    __shared__ __attribute__((aligned(16))) unsigned char lds_raw[LDS_BYTES];
    float* smem = (float*)lds_raw; LAS unsigned char* lds = (LAS unsigned char*)lds_raw;
    cg::grid_group grid = cg::this_grid();
    if (threadIdx.x < 4) ((LAS unsigned*)(lds + LDS_BARST_OFF))[threadIdx.x] = 0u;
    __syncthreads();
    const XcdBarrier bar = xcd_barrier_post((unsigned*)(p.ws + WS_BAR), (volatile LAS unsigned*)(lds + LDS_BARST_OFF), gridDim.x);
#define GSYNC() xcd_barrier(bar)
    constexpr int GDNB_BLOCKS = B_ * NH * 2 * 2; const int s5G = (int)gridDim.x - GDNB_BLOCKS, s5c = (int)blockIdx.x - GDNB_BLOCKS;
    XcdBarrier bar2 = bar;
    if (s5c >= 0) bar2 = xcd_barrier_post((unsigned*)(p.ws + WS_BAR) + 4096, (volatile LAS unsigned*)(lds + LDS_BARST_OFF) + 2, (unsigned)s5G);
    if (p.ws == nullptr) grid.sync();
    ph_norm1(p, smem); ph_memnorm(p, smem); ph_prep0(p, smem); ph_s5mat(p, smem);  GSYNC();
    fp_inproj(p, lds); fp_kv(p, lds);  GSYNC();
    ph_prepa(p, smem); __syncthreads(); ph_gdna(p, smem);    GSYNC();
    if (s5c < 0) ph_gdnb(p, smem);
    else {
        for (int L = s5c; L < NG * 4; L += s5G) { fp_s5estep(p, lds, NG * 4, L); s5carry_unit(p, L >> 2, L & 3); fp_s5main(p, lds, NG * 4, L); }
        xcd_barrier(bar2); fp_glu(p, lds, s5G, s5c); }
    GSYNC();
    ph_gdncomb(p, smem); ph_prep1(p, smem); __syncthreads(); fp_attn_pre(p, lds); GSYNC();
    fp_outproj(p, lds); ph_prep2(p, smem); GSYNC();
    fp_attn_fused(p, lds); GSYNC();
    fp_woproj(p, lds);   GSYNC();
    ph_router(p, smem);  GSYNC();
    fp_moeup(p, lds, smem);   GSYNC();
    fp_moedown(p, lds, smem); GSYNC();
    ph_final(p, smem);
}

extern "C" void kernel_launch(void* const* d_in, const int* in_sizes, int n_in, void* d_out, int out_size, void* d_ws, size_t ws_size, hipStream_t stream) {
    if (n_in != N_IN || out_size != T_ * D_ || ws_size < 256 * MiB) { fprintf(stderr, "kernel_launch: unexpected shapes n_in=%d out=%d ws=%zu\n", n_in, out_size, ws_size); return; }
    static int grid_blocks = 0;
    if (!grid_blocks) {
        int dev = 0, cus = 0, per_cu = 0;
        (void)hipGetDevice(&dev);
        (void)hipDeviceGetAttribute(&cus, hipDeviceAttributeMultiprocessorCount, dev);
        (void)hipOccupancyMaxActiveBlocksPerMultiprocessor(&per_cu, mega_fwd, NT, 0);
        if (per_cu < 1) { fprintf(stderr, "kernel_launch: occupancy query says %d blocks/CU\n", per_cu); per_cu = 1; }
        grid_blocks = cus;
    }
    Params p{};
    for (int i = 0; i < N_IN; ++i) p.in[i] = (const float*)d_in[i];
    p.out = (float*)d_out; p.ws = (unsigned char*)d_ws;
    (void)hipMemsetAsync((unsigned char*)d_ws + WS_BAR, 0, (4096 + XCD_BAR_WORDS) * 4, stream);
    void* args[] = {&p};
    hipError_t e = hipLaunchCooperativeKernel((void*)mega_fwd, dim3(grid_blocks), dim3(NT), args, 0, stream);
    if (e != hipSuccess) fprintf(stderr, "cooperative launch failed: %s (grid %d)\n", hipGetErrorString(e), grid_blocks);
}
```

```cpp
#include <hip/hip_runtime.h>
#include <hip/hip_cooperative_groups.h>
namespace cg = cooperative_groups;
#include <cstdio>
#include <cstdint>
#include <type_traits>

typedef unsigned short bf16_t;
__device__ __forceinline__ float bf2f(bf16_t v) { return __uint_as_float(((unsigned)v) << 16); }
typedef __bf16 bf16v2e_t __attribute__((ext_vector_type(2)));
typedef float f32v2e_t __attribute__((ext_vector_type(2)));
__device__ __forceinline__ bf16_t f2bf(float f) { const f32v2e_t v = {f, 0.f}; const bf16v2e_t h = __builtin_convertvector(v, bf16v2e_t); return (bf16_t)(__builtin_bit_cast(unsigned, h) & 0xffffu); }

constexpr int B_ = 8, S_ = 2048, T_ = B_ * S_, D_ = 1024, DIN = 2576;
constexpr int S5W = 512, NG = 32, NP = 64, GDW = 512, NH = 4, HD = 128, MEM = 256;
constexpr int XH = 4, XD = 256, NE = 32, DE = 256;
constexpr float RMS_EPS = 1e-6f, L2_EPS = 1e-6f;
constexpr int NT = 512, NW = NT / 64;

struct Params {
    const float* in[48];
    float* out;
    unsigned char* ws;
};
enum { I_X = 0, I_MEM, I_NORM_MIX, I_W_IN, I_W_OUT,
       I_LAM_RE_F, I_LAM_IM_F, I_LOG_STEP_F, I_B_RE_F, I_B_IM_F, I_C_RE_F, I_C_IM_F,
       I_LAM_RE_B, I_LAM_IM_B, I_LOG_STEP_B, I_B_RE_B, I_B_IM_B, I_C_RE_B, I_C_IM_B,
       I_S5_D, I_W_GLU, I_B_GLU, I_S5_NORM,
       I_CONV, I_ALOG_F, I_DTB_F, I_ALOG_B, I_DTB_B, I_GDN_NORM,
       I_NORM_XA, I_NORM_MEM, I_WQ, I_WK, I_WV, I_WO,
       I_NORM_MOE, I_RG_W, I_RG_B, I_RE_W, I_RE_B, I_WGATE, I_WUP, I_WDOWN, I_NORM_FINAL, N_IN };

constexpr size_t MiB = 1u << 20;
constexpr size_t WS_HB   = 16 * MiB;
constexpr size_t WS_GL   = 0;
constexpr size_t WS_QKVR = 192 * MiB;
constexpr size_t WS_ZB   = 48 * MiB;
constexpr size_t WS_QKVC = 112 * MiB;
constexpr size_t WS_YF   = 160 * MiB;
constexpr size_t WS_CAT  = 224 * MiB;
constexpr size_t OUT_BA = 0;
constexpr size_t OUT_GB = 1 * MiB;
constexpr size_t OUT_WINT = 4 * MiB;
constexpr size_t OUT_WGLUT = 10 * MiB;
constexpr int QKV_LD = 1536, NINP = 2816;
constexpr size_t WS_BAR  = 111 * MiB + 768 * 1024;
constexpr size_t WS_AEXT = 160 * MiB;
constexpr size_t WS_HLOC = 192 * MiB;
constexpr size_t OUT_MMAT = 12 * MiB;
constexpr size_t OUT_EMAT = 20 * MiB;
constexpr int S5L = 16, S5NC = S_ / S5L;
constexpr size_t WS_XB   = 0;
constexpr size_t WS_QB   = 32 * MiB;
constexpr size_t WS_PB   = 64 * MiB;
constexpr size_t WS_OB   = 112 * MiB;
constexpr size_t WS_ROUTE = 154 * MiB;
constexpr size_t WS_WRT  = 156 * MiB;
constexpr size_t WS_CNT  = 155 * MiB;
constexpr size_t WS_WOUTT = 144 * MiB;
constexpr size_t WS_WQB  = 104 * MiB;
constexpr size_t WS_WOT  = 106 * MiB;
constexpr size_t WS_MQ   = 160 * MiB;
constexpr size_t WS_VWT  = 128 * MiB;
constexpr size_t WS_KMEM = 96 * MiB;
constexpr size_t WS_VMEM = 100 * MiB;
constexpr size_t WS_MEMN = 104 * MiB;
constexpr size_t WS_SSQ  = 108 * MiB;
constexpr size_t OUT_WKT = 58 * MiB, OUT_WVT = 60 * MiB;
constexpr size_t WS_WGUT = 176 * MiB;
constexpr size_t WS_WDT  = 208 * MiB;
constexpr size_t WS_XS   = 32 * MiB;
constexpr size_t WS_HM   = 112 * MiB;
constexpr int MC_CS = 64, MC_NT = 2048, MC_REV = 2112, MC_MAP = 2304, MC_WORDS = 2304 + 32 * 128;
constexpr int MAXRT = 159;

__device__ __forceinline__ int ltid() { int t = threadIdx.x; asm volatile("" : "+v"(t)); return t; }
__device__ __forceinline__ float dpp_max16(float v) {
    v = fmaxf(v, __int_as_float(__builtin_amdgcn_update_dpp(0, __float_as_int(v), 0xB1, 0xF, 0xF, true)));
    v = fmaxf(v, __int_as_float(__builtin_amdgcn_update_dpp(0, __float_as_int(v), 0x4E, 0xF, 0xF, true)));
    v = fmaxf(v, __int_as_float(__builtin_amdgcn_update_dpp(0, __float_as_int(v), 0x141, 0xF, 0xF, true)));
    v = fmaxf(v, __int_as_float(__builtin_amdgcn_update_dpp(0, __float_as_int(v), 0x140, 0xF, 0xF, true)));
    return v;
}
__device__ __forceinline__ float dpp_sum16(float v) {
    v += __int_as_float(__builtin_amdgcn_update_dpp(0, __float_as_int(v), 0xB1, 0xF, 0xF, true));
    v += __int_as_float(__builtin_amdgcn_update_dpp(0, __float_as_int(v), 0x4E, 0xF, 0xF, true));
    v += __int_as_float(__builtin_amdgcn_update_dpp(0, __float_as_int(v), 0x141, 0xF, 0xF, true));
    v += __int_as_float(__builtin_amdgcn_update_dpp(0, __float_as_int(v), 0x140, 0xF, 0xF, true));
    return v;
}
__device__ __forceinline__ float wave_sum(float v) {
    v += __int_as_float(__builtin_amdgcn_update_dpp(0, __float_as_int(v), 0xB1, 0xF, 0xF, true));
    v += __int_as_float(__builtin_amdgcn_update_dpp(0, __float_as_int(v), 0x4E, 0xF, 0xF, true));
    v += __int_as_float(__builtin_amdgcn_update_dpp(0, __float_as_int(v), 0x141, 0xF, 0xF, true));
    v += __int_as_float(__builtin_amdgcn_update_dpp(0, __float_as_int(v), 0x140, 0xF, 0xF, true));
    v += __int_as_float(__builtin_amdgcn_update_dpp(0, __float_as_int(v), 0x142, 0xA, 0xF, false));
    v += __int_as_float(__builtin_amdgcn_update_dpp(0, __float_as_int(v), 0x143, 0xC, 0xF, false));
    return __int_as_float(__builtin_amdgcn_readlane(__float_as_int(v), 63));
}
__device__ __forceinline__ float sigmoidf_(float x) { return __builtin_amdgcn_rcpf(1.f + __expf(-x)); }
__device__ __forceinline__ float siluf_(float x) { return x * sigmoidf_(x); }
__device__ __forceinline__ float softplusf_(float x) { return x > 20.f ? x : log1pf(__expf(x)); }
__device__ __forceinline__ float geluf_(float x) { return 0.5f * x * (1.f + erff(x * 0.70710678118654752f)); }

template <class TA> __device__ __forceinline__ float ldA(const TA* p);
template <> __device__ __forceinline__ float ldA<float>(const float* p) { return *p; }
template <> __device__ __forceinline__ float ldA<bf16_t>(const bf16_t* p) { return bf2f(*p); }

typedef float f4_t __attribute__((ext_vector_type(4)));
typedef unsigned u2_t __attribute__((ext_vector_type(2)));
typedef unsigned u4_t __attribute__((ext_vector_type(4)));
__device__ __forceinline__ unsigned pkbf(float lo, float hi);
__device__ __forceinline__ float bflo(unsigned u) { return __uint_as_float(u << 16); }
__device__ __forceinline__ float bfhi(unsigned u) { return __uint_as_float(u & 0xffff0000u); }
__device__ __forceinline__ void rmsnorm_rows_bf16(const float* X, const float* gain, bf16_t* Y, int rows, int width) {
    const int THR = ltid();
    const int lane = THR & 63, gw = blockIdx.x * NW + (THR >> 6), nw = gridDim.x * NW;
    f4_t g[4];
#pragma unroll
    for (int j = 0; j < 4; ++j) g[j] = ((const f4_t*)gain)[lane + 64 * j];
    for (int r0 = gw * 4; r0 < rows; r0 += nw * 4) {
        f4_t v[4][4];
#pragma unroll
        for (int r = 0; r < 4; ++r)
#pragma unroll
            for (int j = 0; j < 4; ++j) v[r][j] = ((const f4_t*)(X + (size_t)(r0 + r) * 1024))[lane + 64 * j];
#pragma unroll
        for (int r = 0; r < 4; ++r) { float ss = 0.f;
#pragma unroll
            for (int j = 0; j < 4; ++j) ss += v[r][j].x * v[r][j].x + v[r][j].y * v[r][j].y + v[r][j].z * v[r][j].z + v[r][j].w * v[r][j].w;
            const float rs = rsqrtf(wave_sum(ss) * (1.f / 1024.f) + RMS_EPS);
#pragma unroll
            for (int j = 0; j < 4; ++j) { const f4_t o = v[r][j] * rs * g[j]; u2_t w; w.x = pkbf(o.x, o.y); w.y = pkbf(o.z, o.w); ((u2_t*)(Y + (size_t)(r0 + r) * 1024))[lane + 64 * j] = w; } }
    }
}

namespace pg8 {
#define PG8_LAS __attribute__((address_space(3)))
typedef short bf16x8 __attribute__((ext_vector_type(8)));
typedef float f32x4 __attribute__((ext_vector_type(4)));
typedef unsigned u32x4 __attribute__((ext_vector_type(4)));
typedef unsigned u32x2 __attribute__((ext_vector_type(2)));
constexpr int BM = 256, BK = 64, HALF = 128, HTB = HALF * BK * 2, STAGE_BYTES = 8 * HTB;
__device__ __forceinline__ int lds_byte(int r, int c) { const int st = (r >> 4) * 2 + (c >> 5), rr = r & 15, cc = c & 31, ob = rr * 64 + cc * 2; return st * 1024 + (ob ^ (((ob >> 9) & 1) << 5)); }
__device__ __forceinline__ void stage_rc(int b, int& R, int& C) { const int st = b / 1024, sb = b % 1024, swz = sb ^ (((sb >> 9) & 1) << 5); R = (st >> 1) * 16 + swz / 64; C = (st & 1) * 32 + (swz % 64) / 2; }
__device__ __forceinline__ int perm32(int rho) { const int n = rho >> 4, i = rho & 15; return 8 * (i >> 2) + 4 * n + (i & 3); }
typedef __bf16 bf16v2_t __attribute__((ext_vector_type(2)));
typedef float f32v2_t __attribute__((ext_vector_type(2)));
__device__ __forceinline__ unsigned cvt_pk_bf16(float lo, float hi) { const f32v2_t f = {lo, hi}; const bf16v2_t h = __builtin_convertvector(f, bf16v2_t); return __builtin_bit_cast(unsigned, h); }
}
__device__ __forceinline__ unsigned pkbf(float lo, float hi) { return pg8::cvt_pk_bf16(lo, hi); }
namespace pg8 {

struct Unit { const char* a; const char* b; int orow, ocol, aux; };
struct DenseOrder {
    const char* A; const char* Bt; int lda, ldb, nM, nN, nwg, G, c;
    __device__ void init(const bf16_t* A_, int lda_, const bf16_t* Bt_, int ldb_, int M, int N, int G_, int c_) { A = (const char*)A_; Bt = (const char*)Bt_; lda = lda_; ldb = ldb_; nM = M / BM; nN = N / BM; nwg = nM * nN; G = G_; c = c_; }
    __device__ bool next(int i, Unit& u) const {
        const long L = (long)i * G + c; if (L >= nwg) return false;
        int wgid = (int)L; { const int q = nwg / 8, r = nwg % 8, xcd = wgid % 8, off = wgid / 8; wgid = (xcd < r ? xcd * (q + 1) : r * (q + 1) + (xcd - r) * q) + off; }
        const int nig = 8 * nN, gid = wgid / nig, fm = gid * 8, gsz = (nM - fm) < 8 ? (nM - fm) : 8;
        const int pm = fm + ((wgid % nig) % gsz), pn = (wgid % nig) / gsz;
        u.a = A + (size_t)pm * BM * lda * 2; u.b = Bt + (size_t)pn * BM * ldb * 2; u.orow = pm * BM; u.ocol = pn * BM; u.aux = pn; return true;
    }
};

template <class Epi, class Sched>
__device__ __forceinline__ void gemm_phase(PG8_LAS unsigned char* lds, const int K, const int lda, const int ldb, const Sched& S, const Epi& E) {
    int tid_ = threadIdx.x; asm volatile("" : "+v"(tid_));
    const int tid = tid_, wid = __builtin_amdgcn_readfirstlane(tid >> 6), lane = tid & 63, wr = wid >> 2, wc = wid & 3, fr = lane & 15, fq = lane >> 4;
    const int nt = K / BK;
    unsigned voffA[2], voffB[2];
#pragma unroll
    for (int i = 0; i < 2; ++i) { int R, C; stage_rc(tid * 16 + i * 8192, R, C); const int Rb = Epi::PERM ? ((R & ~31) + perm32(R & 31)) : R;
        voffA[i] = (unsigned)(R * lda + C) * 2u; voffB[i] = (unsigned)(Rb * ldb + C) * 2u; }
    const size_t kstep = (size_t)(BK * 2);
    const size_t hstepA = (size_t)HALF * lda * 2, hstepB = (size_t)HALF * ldb * 2;
    const unsigned ldsw = (unsigned)wid * 1024u;
    const int aoff = lds_byte(wr * 64 + fr, fq * 8), boff = lds_byte(wc * 32 + fr, fq * 8);
#define PG8_SA(b, h) (((b) * 2 + (h)) * HTB)
#define PG8_SB(b, h) ((4 + (b) * 2 + (h)) * HTB)
#define PG8_STAGE(bufoff, gbase, voff) do { _Pragma("unroll") for (int _i = 0; _i < 2; ++_i) \
        __builtin_amdgcn_global_load_lds((const unsigned*)((const char*)(gbase) + (voff)[_i]), (PG8_LAS unsigned*)(lds + (bufoff) + ldsw + _i * 8192), 16, 0, 0); } while (0)
#define PG8_LDA(dst, b, h) do { _Pragma("unroll") for (int m = 0; m < 4; ++m) _Pragma("unroll") for (int k = 0; k < 2; ++k) dst[m][k] = *(const PG8_LAS bf16x8*)(lds + PG8_SA(b, h) + aoff + m * 2048 + k * 1024); } while (0)
#define PG8_LDB(dst, b, h) do { _Pragma("unroll") for (int n = 0; n < 2; ++n) _Pragma("unroll") for (int k = 0; k < 2; ++k) dst[n][k] = *(const PG8_LAS bf16x8*)(lds + PG8_SB(b, h) + boff + n * 2048 + k * 1024); } while (0)
#define PG8_MMA(ai, bj, At, Bt) do { __builtin_amdgcn_s_setprio(1); _Pragma("unroll") for (int m = 0; m < 4; ++m) _Pragma("unroll") for (int n = 0; n < 2; ++n) _Pragma("unroll") for (int k = 0; k < 2; ++k) \
        acc[ai][bj][m][n] = __builtin_amdgcn_mfma_f32_16x16x32_bf16(Bt[n][k], At[m][k], acc[ai][bj][m][n], 0, 0, 0); __builtin_amdgcn_s_setprio(0); } while (0)
#define PG8_WAIT_V(n) asm volatile("s_waitcnt vmcnt(" #n ")" ::: "memory")
#define PG8_WAIT_L(n) asm volatile("s_waitcnt lgkmcnt(" #n ")" ::: "memory")
#define PG8_BAR __builtin_amdgcn_s_barrier()
#define PG8_SCHED __builtin_amdgcn_sched_barrier(0)
    Unit cur, nxt; int ui = 0;
    if (!S.next(0, cur)) return;
    f32x4 acc[2][2][4][2];
#pragma unroll
    for (int a = 0; a < 2; ++a)
#pragma unroll
        for (int b = 0; b < 2; ++b)
#pragma unroll
            for (int m = 0; m < 4; ++m)
#pragma unroll
                for (int n = 0; n < 2; ++n) acc[a][b][m][n] = (f32x4){0.f, 0.f, 0.f, 0.f};
    bf16x8 At[4][2], B0[2][2], B1[2][2];
    const char* cA = cur.a; const char* cB = cur.b;
    PG8_STAGE(PG8_SB(0, 0), cB, voffB); PG8_STAGE(PG8_SA(0, 0), cA, voffA); PG8_STAGE(PG8_SB(0, 1), cB + hstepB, voffB); PG8_STAGE(PG8_SA(0, 1), cA + hstepA, voffA);
    if (wr == 1) PG8_BAR;
    PG8_WAIT_V(4); PG8_BAR;
    PG8_STAGE(PG8_SB(1, 0), cB + kstep, voffB); PG8_STAGE(PG8_SA(1, 0), cA + kstep, voffA); PG8_STAGE(PG8_SB(1, 1), cB + hstepB + kstep, voffB);
    PG8_WAIT_V(6); PG8_BAR;
    for (;;) {
        const bool has_next = S.next(ui + 1, nxt);
        const char* nA = has_next ? nxt.a : cA; const char* nB = has_next ? nxt.b : cB;
        for (int t = 0; t < nt; t += 2) {
            const bool last = (t == nt - 2);
            const char* a1 = cA + (size_t)(t + 1) * kstep;
            const char* a2 = last ? nA : cA + (size_t)(t + 2) * kstep; const char* b2 = last ? nB : cB + (size_t)(t + 2) * kstep;
            const char* a3 = a2 + kstep; const char* b3 = b2 + kstep;
            PG8_LDB(B0, 0, 0); PG8_SCHED; PG8_LDA(At, 0, 0); PG8_STAGE(PG8_SA(1, 1), a1 + hstepA, voffA);
            PG8_WAIT_L(8); PG8_BAR; PG8_WAIT_L(0); PG8_MMA(0, 0, At, B0); PG8_BAR; PG8_SCHED;
            PG8_LDB(B1, 0, 1); PG8_STAGE(PG8_SB(0, 0), b2, voffB);
            PG8_BAR; PG8_WAIT_L(0); PG8_MMA(0, 1, At, B1); PG8_BAR;
            PG8_LDA(At, 0, 1); PG8_STAGE(PG8_SA(0, 0), a2, voffA);
            PG8_BAR; PG8_WAIT_L(0); PG8_MMA(1, 0, At, B0); PG8_BAR; PG8_SCHED;
            PG8_STAGE(PG8_SB(0, 1), b2 + hstepB, voffB);
            PG8_WAIT_V(6); PG8_BAR; PG8_MMA(1, 1, At, B1); PG8_BAR;
            PG8_LDB(B0, 1, 0); PG8_SCHED; PG8_LDA(At, 1, 0); PG8_STAGE(PG8_SA(0, 1), a2 + hstepA, voffA);
            PG8_WAIT_L(8); PG8_BAR; PG8_WAIT_L(0); PG8_MMA(0, 0, At, B0); PG8_BAR; PG8_SCHED;
            PG8_LDB(B1, 1, 1); PG8_STAGE(PG8_SB(1, 0), b3, voffB);
            PG8_BAR; PG8_WAIT_L(0); PG8_MMA(0, 1, At, B1); PG8_BAR;
            PG8_LDA(At, 1, 1); PG8_STAGE(PG8_SA(1, 0), a3, voffA);
            PG8_BAR; PG8_WAIT_L(0); PG8_MMA(1, 0, At, B0); PG8_BAR; PG8_SCHED;
            PG8_STAGE(PG8_SB(1, 1), b3 + hstepB, voffB);
            PG8_WAIT_V(6); PG8_BAR; PG8_MMA(1, 1, At, B1); PG8_BAR;
        }
        E(acc, cur, wr, wc, fr, fq);
        if (!has_next) break;
#pragma unroll
        for (int a = 0; a < 2; ++a)
#pragma unroll
            for (int b = 0; b < 2; ++b)
#pragma unroll
                for (int m = 0; m < 4; ++m)
#pragma unroll
                    for (int n = 0; n < 2; ++n) acc[a][b][m][n] = (f32x4){0.f, 0.f, 0.f, 0.f};
        cur = nxt; cA = nA; cB = nB; ++ui;
    }
    PG8_WAIT_V(0);
    if (wr == 0) PG8_BAR;
    PG8_BAR;
#undef PG8_SA
#undef PG8_SB
#undef PG8_STAGE
#undef PG8_LDA
#undef PG8_LDB
#undef PG8_MMA
#undef PG8_WAIT_V
#undef PG8_WAIT_L
#undef PG8_BAR
#undef PG8_SCHED
}
}
typedef pg8::f32x4 f32x4; typedef pg8::u32x4 u32x4;
#define LAS __attribute__((address_space(3)))

#define LAS __attribute__((address_space(3)))

__device__ __forceinline__ void ph_norm1(const Params& p, float* smem) {
    rmsnorm_rows_bf16(p.in[I_X], p.in[I_NORM_MIX], (bf16_t*)(p.ws + WS_HB), T_, D_);
}
__device__ __forceinline__ void ph_memnorm(const Params& p, float* smem) {
    rmsnorm_rows_bf16(p.in[I_MEM], p.in[I_NORM_MEM], (bf16_t*)(p.ws + WS_MEMN), B_ * MEM, D_);
}
__device__ __forceinline__ void ph_s5mat(const Params& p, float* smem) {
    const int THR = ltid();
    bf16_t* Mm = (bf16_t*)((unsigned char*)p.out + OUT_MMAT); bf16_t* Em = (bf16_t*)((unsigned char*)p.out + OUT_EMAT);
    float* lp = smem;
    float* cf = smem + 640;
    float* Bb = smem + 896;
    float* kk = smem + 896 + 4096;
    __syncthreads();
    for (int item = blockIdx.x; item < NG * S5L; item += gridDim.x) {
        const int g = item >> 4, j = item & 15;
        if (THR < 320) {
            const int which = THR >> 6, pp = THR & 63; const int dir = (which == 1 || which == 4) ? 1 : 0;
            const int o = dir ? (I_LAM_RE_B - I_LAM_RE_F) : 0;
            const float lre = p.in[I_LAM_RE_F + o][g * NP + pp], lim = p.in[I_LAM_IM_F + o][g * NP + pp], step = __expf(p.in[I_LOG_STEP_F + o][g]);
            const float pw = (float)(which == 0 ? j : which == 1 ? j : which == 2 ? (15 - j) : which == 3 ? (j + 1) : (16 - j));
            const float er = expf(lre * step * pw); float sn, cs; sincosf(lim * step * pw, &sn, &cs);
            lp[(which * 64 + pp) * 2] = er * cs; lp[(which * 64 + pp) * 2 + 1] = er * sn;
            if (which < 2) {
                const float e1 = expf(lre * step); float s1, c1; sincosf(lim * step, &s1, &c1);
                const float nr = e1 * c1 - 1.f, ni = e1 * s1, den = lre * lre + lim * lim;
                cf[(dir * 64 + pp) * 2] = (nr * lre + ni * lim) / den; cf[(dir * 64 + pp) * 2 + 1] = (ni * lre - nr * lim) / den;
            }
        }
        __syncthreads();
        for (int e = THR; e < 2048; e += NT) {
            const int dir = e >> 10, pp = (e >> 4) & 63, ci = e & 15; const int o = dir ? (I_LAM_RE_B - I_LAM_RE_F) : 0;
            const float br = p.in[I_B_RE_F + o][(g * NP + pp) * 16 + ci], bi = p.in[I_B_IM_F + o][(g * NP + pp) * 16 + ci];
            const float cr = cf[(dir * 64 + pp) * 2], ci_ = cf[(dir * 64 + pp) * 2 + 1];
            Bb[e * 2] = cr * br - ci_ * bi; Bb[e * 2 + 1] = cr * bi + ci_ * br;
        }
        __syncthreads();
        {
            const int dir = THR >> 8, co = (THR >> 4) & 15, ci = THR & 15; const int o = dir ? (I_LAM_RE_B - I_LAM_RE_F) : 0;
            const float* cre = p.in[I_C_RE_F + o] + (g * 16 + co) * NP; const float* cim = p.in[I_C_IM_F + o] + (g * 16 + co) * NP;
            float acc = 0.f;
            for (int pp = 0; pp < 64; ++pp) {
                const float lr = lp[(dir * 64 + pp) * 2], li = lp[(dir * 64 + pp) * 2 + 1], c_r = cre[pp], c_i = cim[pp];
                const float clr = c_r * lr - c_i * li, cli = c_r * li + c_i * lr;
                acc += clr * Bb[((dir * 64 + pp) * 16 + ci) * 2] - cli * Bb[((dir * 64 + pp) * 16 + ci) * 2 + 1];
            }
            kk[THR] = acc;
        }
        __syncthreads();
        {
            const int dir = THR >> 8, co = (THR >> 4) & 15, ci = THR & 15; bf16_t* Mg = Mm + (size_t)g * 256 * 512;
            if (j == 0) { if (dir == 0) { const bf16_t v = f2bf(kk[THR] + kk[256 + THR] + (co == ci ? p.in[I_S5_D][g * 16 + co] : 0.f));
                    for (int jj = 0; jj < 16; ++jj) Mg[(size_t)(jj * 16 + co) * 512 + jj * 16 + ci] = v; } }
            else { const bf16_t v = f2bf(kk[THR]);
                if (dir == 0) { for (int jj = j; jj < 16; ++jj) Mg[(size_t)(jj * 16 + co) * 512 + (jj - j) * 16 + ci] = v; }
                else { for (int jj = 0; jj + j < 16; ++jj) Mg[(size_t)(jj * 16 + co) * 512 + (jj + j) * 16 + ci] = v; } }
        }
        for (int e = THR; e < 2048; e += NT) {
            const int dir = e >> 10, co = (e >> 6) & 15, pp = e & 63; const int o = dir ? (I_LAM_RE_B - I_LAM_RE_F) : 0;
            const float c_r = p.in[I_C_RE_F + o][(g * 16 + co) * NP + pp], c_i = p.in[I_C_IM_F + o][(g * 16 + co) * NP + pp];
            const int w = dir ? 4 : 3; const float lr = lp[(w * 64 + pp) * 2], li = lp[(w * 64 + pp) * 2 + 1];
            bf16_t* row = Mm + ((size_t)g * 256 + j * 16 + co) * 512 + 256 + dir * 128;
            row[pp] = f2bf(c_r * lr - c_i * li); row[64 + pp] = f2bf(-(c_r * li + c_i * lr));
        }
        for (int e = THR; e < 2048; e += NT) {
            const int dir = e >> 10, pp = (e >> 4) & 63, ci = e & 15;
            const int w = dir ? 1 : 2; const float lr = lp[(w * 64 + pp) * 2], li = lp[(w * 64 + pp) * 2 + 1];
            const float br = Bb[e * 2], bi = Bb[e * 2 + 1];
            bf16_t* Eg = Em + (size_t)g * 256 * 256;
            Eg[(size_t)(dir * 128 + pp) * 256 + j * 16 + ci] = f2bf(lr * br - li * bi);
            Eg[(size_t)(dir * 128 + 64 + pp) * 256 + j * 16 + ci] = f2bf(lr * bi + li * br);
        }
        __syncthreads();
    }
}
__device__ __forceinline__ void s5carry_unit(const Params& p, int g, int pm) {
    const int THR = ltid();
    if (THR < 256) {
        const float* Hl = (const float*)(p.ws + WS_HLOC); bf16_t* Ax = (bf16_t*)(p.ws + WS_AEXT);
        const int pp = THR & 63, dir = (THR >> 6) & 1, b = 2 * pm + (THR >> 7); const int o = dir ? (I_LAM_RE_B - I_LAM_RE_F) : 0;
        const float lre = p.in[I_LAM_RE_F + o][g * NP + pp], lim = p.in[I_LAM_IM_F + o][g * NP + pp], step = __expf(p.in[I_LOG_STEP_F + o][g]);
        const float er = expf(lre * step * (float)S5L); float sn, cs; sincosf(lim * step * (float)S5L, &sn, &cs);
        const float lr = er * cs, li = er * sn;
        float hr = 0.f, hi = 0.f;
        const size_t rowbase = (size_t)g * 1024 + (size_t)b * S5NC;
        for (int s0 = 0; s0 < S5NC; s0 += 16) {
            float lr_[16], li_[16];
#pragma unroll
            for (int k = 0; k < 16; ++k) { const int c = dir ? (S5NC - 1 - (s0 + k)) : (s0 + k); const float* hl = Hl + (rowbase + c) * 256 + dir * 128; lr_[k] = hl[pp]; li_[k] = hl[64 + pp]; }
#pragma unroll
            for (int k = 0; k < 16; ++k) { const int c = dir ? (S5NC - 1 - (s0 + k)) : (s0 + k);
                bf16_t* ar = Ax + (rowbase + c) * 512 + 256 + dir * 128; ar[pp] = f2bf(hr); ar[64 + pp] = f2bf(hi);
                const float nr = lr * hr - li * hi + lr_[k], ni = lr * hi + li * hr + li_[k]; hr = nr; hi = ni; }
        }
    }
    asm volatile("s_waitcnt vmcnt(0)" ::: "memory");
    __syncthreads();
}
constexpr size_t WS_GW   = 16 * MiB;
constexpr size_t WS_GUT  = 64 * MiB;
constexpr size_t WS_GQK  = 128 * MiB;
constexpr size_t WS_GKT  = 144 * MiB;
constexpr size_t WS_GQN  = 112 * MiB;
constexpr size_t OUT_GSC = 24 * MiB;
constexpr size_t OUT_GO  = 26 * MiB;
typedef short bf16x4 __attribute__((ext_vector_type(4)));
typedef pg8::bf16x8 bf16x8;
__device__ __forceinline__ bf16x8 cat44(bf16x4 lo, bf16x4 hi) { return __builtin_shufflevector(lo, hi, 0, 1, 2, 3, 4, 5, 6, 7); }
__device__ __forceinline__ bf16x4 pack4(float a, float b, float c, float d) { union { unsigned u[2]; bf16x4 v; } x; x.u[0] = pg8::cvt_pk_bf16(a, b); x.u[1] = pg8::cvt_pk_bf16(c, d); return x.v; }

__host__ __device__ constexpr int gdna_pieces_before(int i) { return i <= 16 ? i - 1 : i <= 32 ? 16 + 2 * (i - 17) : i <= 48 ? 48 + 3 * (i - 33) : 96 + 4 * (i - 49); }
__device__ __forceinline__ void ph_gdna(const Params& p, float* smem) {
    LAS unsigned char* L = (LAS unsigned char*)smem;
    constexpr int KS = 0, QS = 17408, VS = 34816, KT = 52224, VT = 70656, KK = 89088, QKR = 105728, SC = 122368, TB = 124416;
    constexpr int AF = KS, AB = QS, TF = KK;
    LAS float* sc = (LAS float*)(L + SC);
    const bf16_t* proj = (const bf16_t*)(p.ws + WS_QKVR); const float* ba = (const float*)((unsigned char*)p.out + OUT_BA); const float* cw = p.in[I_CONV]; bf16_t* GQN = (bf16_t*)(p.ws + WS_GQN);
    bf16_t* GW = (bf16_t*)(p.ws + WS_GW); bf16_t* GUT = (bf16_t*)(p.ws + WS_GUT); bf16_t* GQK = (bf16_t*)(p.ws + WS_GQK); bf16_t* GKT = (bf16_t*)(p.ws + WS_GKT);
    float* GSC = (float*)((unsigned char*)p.out + OUT_GSC);
    auto loadraw = [&](unsigned (&rw)[3][12], float& bav, int it) {
        const int THR = ltid(); const int lane = THR & 63, wid = THR >> 6;
        const int n = it & 31, h = (it >> 5) & 3, b = it >> 7, t0 = b * S_ + n * 64, s0 = n * 64 + wid * 8;
#pragma unroll
        for (int mat = 0; mat < 3; ++mat)
#pragma unroll
            for (int r = 0; r < 12; ++r) { const int sq = s0 - 2 + r; unsigned raw = 0u;
                if (sq >= 0 && sq < S_) raw = *(const unsigned*)(proj + (size_t)(b * S_ + sq) * QKV_LD + mat * 512 + h * 128 + lane * 2);
                rw[mat][r] = raw; }
        bav = 0.f;
        if (THR < 256) { const int i = THR & 63, w = THR >> 6; bav = ba[(size_t)(t0 + i) * 16 + (w == 0 ? 8 + h : w == 1 ? 12 + h : w == 2 ? h : 4 + h)]; }
    };
    const bool fixed_h = (gridDim.x % 128u) == 0u;
    float cwa[3][5], cwb[3][5];
    auto loadtaps = [&](int h) {
        const int lane = ltid() & 63;
#pragma unroll
        for (int mat = 0; mat < 3; ++mat)
#pragma unroll
            for (int k = 0; k < 5; ++k) { const int col = mat * 512 + h * 128 + lane * 2; cwa[mat][k] = cw[k * 1536 + col]; cwb[mat][k] = cw[k * 1536 + col + 1]; }
    };
    loadtaps((blockIdx.x >> 5) & 3);
    unsigned rawc[3][12]; float bac = 0.f;
    if ((int)blockIdx.x < B_ * NH * 32) loadraw(rawc, bac, blockIdx.x);
    for (int item = blockIdx.x; item < B_ * NH * 32; item += gridDim.x) {
        const int THR = ltid();
        const int lane = THR & 63, wid = THR >> 6, l15 = lane & 15, q4 = lane >> 4;
        const int n = item & 31, h = (item >> 5) & 3, b = item >> 7, t0 = b * S_ + n * 64;
        if (!fixed_h) loadtaps(h);
        if (THR < 256) { const int i = THR & 63, w = THR >> 6; const float r = bac;
            sc[w * 64 + i] = (w < 2) ? -__expf(p.in[w ? I_ALOG_B : I_ALOG_F][h]) * softplusf_(r + p.in[w ? I_DTB_B : I_DTB_F][h]) : sigmoidf_(r); }
        {
#pragma unroll
            for (int mat = 0; mat < 3; ++mat) {
                float w0[5], w1[5], x0[12], x1[12];
#pragma unroll
                for (int k = 0; k < 5; ++k) { w0[k] = cwa[mat][k]; w1[k] = cwb[mat][k]; }
#pragma unroll
                for (int r = 0; r < 12; ++r) { const unsigned raw = rawc[mat][r]; x0[r] = __uint_as_float(raw << 16); x1[r] = __uint_as_float(raw & 0xffff0000u); }
#pragma unroll
                for (int tk = 0; tk < 8; ++tk) { float a0 = 0.f, a1 = 0.f;
#pragma unroll
                    for (int k = 0; k < 5; ++k) { a0 = fmaf(w0[k], x0[tk + k], a0); a1 = fmaf(w1[k], x1[tk + k], a1); }
                    float y0 = siluf_(a0), y1 = siluf_(a1);
                    if (mat < 2) { float scl = rsqrtf(wave_sum(y0 * y0 + y1 * y1) + L2_EPS); if (mat == 0) scl *= 0.08838834764831845f; y0 *= scl; y1 *= scl; }
                    *(LAS unsigned*)(L + (mat == 0 ? QS : mat == 1 ? KS : VS) + (wid * 8 + tk) * 272 + lane * 4) = pg8::cvt_pk_bf16(y0, y1); }
            }
        }
        unsigned rawn[3][12]; float ban = 0.f;
        if (item + (int)gridDim.x < B_ * NH * 32) loadraw(rawn, ban, item + gridDim.x);
        __syncthreads();
        if (wid < 2) { float v = sc[wid * 64 + (wid ? 63 - lane : lane)];
#pragma unroll
            for (int o = 1; o < 64; o <<= 1) { const float t = __shfl_up(v, o); if (lane >= o) v += t; }
            sc[256 + wid * 64 + (wid ? 63 - lane : lane)] = v; }
        {
#pragma unroll
            for (int i = 0; i < 2; ++i) { const int e = THR + i * NT, row = e >> 4, ch = e & 15; *(u32x4*)(GQN + (size_t)item * 8192 + row * 128 + ch * 8) = *(const LAS u32x4*)(L + QS + row * 272 + ch * 16); }
            const int tok0 = 4 * (THR & 15), c0 = 4 * (THR >> 4);
#pragma unroll
            for (int mat = 0; mat < 2; ++mat) { const int src = mat ? VS : KS, dst = mat ? VT : KT; bf16x4 r[4];
#pragma unroll
                for (int i = 0; i < 4; ++i) r[i] = *(const LAS bf16x4*)(L + src + (tok0 + i) * 272 + c0 * 2);
#pragma unroll
                for (int c = 0; c < 4; ++c) { bf16x4 o; o[0] = r[0][c]; o[1] = r[1][c]; o[2] = r[2][c]; o[3] = r[3][c]; *(LAS bf16x4*)(L + dst + (c0 + c) * 144 + tok0 * 2) = o; } }
        }
#pragma unroll
        for (int ti = 0; ti < 4; ++ti) { const int id = wid * 4 + ti, mat = id >> 4, it = (id >> 2) & 3, jt = id & 3; f32x4 acc = {0.f, 0.f, 0.f, 0.f};
#pragma unroll
            for (int s4 = 0; s4 < 4; ++s4) { const bf16x8 a = *(const LAS bf16x8*)(L + (mat ? QS : KS) + (16 * it + l15) * 272 + (32 * s4 + 8 * q4) * 2);
                const bf16x8 bb = *(const LAS bf16x8*)(L + KS + (16 * jt + l15) * 272 + (32 * s4 + 8 * q4) * 2);
                acc = __builtin_amdgcn_mfma_f32_16x16x32_bf16(a, bb, acc, 0, 0, 0); }
            LAS float* dst = (LAS float*)(L + (mat ? QKR : KK));
#pragma unroll
            for (int r = 0; r < 4; ++r) dst[(16 * it + 4 * q4 + r) * 65 + 16 * jt + l15] = acc[r]; }
        __syncthreads();
        {
            LAS float* kk = (LAS float*)(L + KK); LAS float* qr = (LAS float*)(L + QKR); LAS float* af = (LAS float*)(L + AF); LAS float* ab = (LAS float*)(L + AB);
            bf16_t* qkf = GQK + (size_t)(item * 2) * 4096; bf16_t* qkb = qkf + 4096;
            const int i = THR >> 3, j0 = (THR & 7) * 8;
            const float gfi = sc[256 + i], gbi = sc[320 + i], bfi = sc[128 + i], bbi = sc[192 + i];
            float vf[8], vb[8], qf[8], qb[8];
#pragma unroll
            for (int e = 0; e < 8; ++e) { const int j = j0 + e; const float kv = kk[i * 65 + j], qv = qr[i * 65 + j];
                const float df = __expf(fminf(gfi - sc[256 + j], 0.f)), db = __expf(fminf(gbi - sc[320 + j], 0.f));
                vf[e] = (j < i) ? bfi * kv * df : 0.f; vb[e] = (j > i) ? bbi * kv * db : 0.f; qf[e] = (j <= i) ? qv * df : 0.f; qb[e] = (j >= i) ? qv * db : 0.f; }
            *(LAS f32x4*)(af + i * 64 + j0) = (f32x4){vf[0], vf[1], vf[2], vf[3]}; *(LAS f32x4*)(af + i * 64 + j0 + 4) = (f32x4){vf[4], vf[5], vf[6], vf[7]};
            *(LAS f32x4*)(ab + (63 - i) * 64 + 56 - j0) = (f32x4){vb[7], vb[6], vb[5], vb[4]}; *(LAS f32x4*)(ab + (63 - i) * 64 + 60 - j0) = (f32x4){vb[3], vb[2], vb[1], vb[0]};
            u32x4 w1, w2; w1.x = pkbf(qf[0], qf[1]); w1.y = pkbf(qf[2], qf[3]); w1.z = pkbf(qf[4], qf[5]); w1.w = pkbf(qf[6], qf[7]);
            w2.x = pkbf(qb[0], qb[1]); w2.y = pkbf(qb[2], qb[3]); w2.z = pkbf(qb[4], qb[5]); w2.w = pkbf(qb[6], qb[7]);
            *(u32x4*)(qkf + i * 64 + j0) = w1; *(u32x4*)(qkb + i * 64 + j0) = w2;
        }
        __syncthreads();
        {
            const int sd = wid >> 2, r4 = lane & 3, c = 16 * (wid & 3) + (lane >> 2);
            const LAS float* A = (const LAS float*)(L + (sd ? AB : AF)) + r4;
            float to[16];
#pragma unroll
            for (int m = 0; m < 16; ++m) to[m] = 0.f;
            float ar3[3][16];
            ar3[1][0] = A[1 * 64];
            ar3[2][0] = A[2 * 64];
            if (r4 == 0) to[0] = (c == 0) ? 1.f : 0.f;
#define GDNA_ROW(i) { constexpr int NM = ((i) + 3) / 4, NP2 = ((i) + 5) / 4; \
                if ((i) + 2 < 64) { _Pragma("unroll") for (int m = 0; m < NP2; ++m) ar3[((i) + 2) % 3][m] = A[((i) + 2) * 64 + 4 * m]; } \
                float p0 = 0.f, p1 = 0.f; \
                _Pragma("unroll") for (int m = 0; m < NM; ++m) { if (m & 1) p1 = fmaf(ar3[(i) % 3][m], to[m], p1); else p0 = fmaf(ar3[(i) % 3][m], to[m], p0); } \
                float ps = p0 + p1; \
                ps += __int_as_float(__builtin_amdgcn_update_dpp(0, __float_as_int(ps), 0xB1, 0xF, 0xF, true));     \
                ps += __int_as_float(__builtin_amdgcn_update_dpp(0, __float_as_int(ps), 0x4E, 0xF, 0xF, true));     \
                const float val = ((c == (i)) ? 1.f : 0.f) - ps; \
                to[(i) >> 2] = (r4 == ((i) & 3)) ? val : to[(i) >> 2]; asm volatile("" ::: "memory"); }
#define GDNA_ROWS8(b) GDNA_ROW(b) GDNA_ROW(b + 1) GDNA_ROW(b + 2) GDNA_ROW(b + 3) GDNA_ROW(b + 4) GDNA_ROW(b + 5) GDNA_ROW(b + 6) GDNA_ROW(b + 7)
            GDNA_ROW(1) GDNA_ROW(2) GDNA_ROW(3) GDNA_ROW(4) GDNA_ROW(5) GDNA_ROW(6) GDNA_ROW(7)
            GDNA_ROWS8(8) GDNA_ROWS8(16) GDNA_ROWS8(24) GDNA_ROWS8(32) GDNA_ROWS8(40) GDNA_ROWS8(48) GDNA_ROWS8(56)
#undef GDNA_ROWS8
#undef GDNA_ROW
            const int cc = sd ? 63 - c : c; const float be = sc[128 + sd * 64 + cc], s1 = be * __expf(sc[256 + sd * 64 + cc]);
            LAS bf16_t* T1 = (LAS bf16_t*)(L + (sd ? TB : TF)); LAS bf16_t* T2 = T1 + 64 * 72;
#pragma unroll
            for (int m = 0; m < 16; ++m) { const int j = 4 * m + r4, ii = sd ? 63 - j : j; T1[ii * 72 + cc] = f2bf(to[m] * s1); T2[ii * 72 + cc] = f2bf(to[m] * be); }
        }
        {
            bf16_t* kt = GKT + (size_t)item * 8192;
#pragma unroll
            for (int i = 0; i < 2; ++i) { const int e = THR + i * NT, row = e >> 3, ch = e & 7; *(u32x4*)(kt + row * 64 + ch * 8) = *(const LAS u32x4*)(L + KT + row * 144 + ch * 16); }
            if (THR < 128) { const int dir = THR >> 6, i = THR & 63; const float gc = sc[256 + dir * 64 + i], gl = sc[256 + dir * 64 + (dir ? 0 : 63)];
                float* o = GSC + (size_t)(item * 2 + dir) * 132; o[i] = __expf(gc); o[64 + i] = __expf(gl - gc); if (i == 0) o[128] = __expf(gl); }
        }
        __syncthreads();
#pragma unroll 4
        for (int ti = 0; ti < 16; ++ti) { const int id = wid * 16 + ti, dir = id >> 6, isU = (id >> 5) & 1, x = (id >> 2) & 7, y = id & 3;
            const int t1 = dir ? TB : TF; f32x4 acc = {0.f, 0.f, 0.f, 0.f};
#pragma unroll
            for (int s2 = 0; s2 < 2; ++s2) {
                bf16x8 a, bb;
                if (!isU) { a = *(const LAS bf16x8*)(L + KT + (16 * x + l15) * 144 + (32 * s2 + 8 * q4) * 2); bb = *(const LAS bf16x8*)(L + t1 + (16 * y + l15) * 144 + (32 * s2 + 8 * q4) * 2); }
                else { a = *(const LAS bf16x8*)(L + t1 + 64 * 144 + (16 * y + l15) * 144 + (32 * s2 + 8 * q4) * 2); bb = *(const LAS bf16x8*)(L + VT + (16 * x + l15) * 144 + (32 * s2 + 8 * q4) * 2); }
                acc = __builtin_amdgcn_mfma_f32_16x16x32_bf16(a, bb, acc, 0, 0, 0); }
            const bf16x4 o = pack4(acc[0], acc[1], acc[2], acc[3]);
            if (!isU) *(bf16x4*)(GW + (size_t)(item * 2 + dir) * 8192 + (16 * y + l15) * 128 + 16 * x + 4 * q4) = o;
            else *(bf16x4*)(GUT + (size_t)(item * 2 + dir) * 8192 + (16 * x + l15) * 64 + 16 * y + 4 * q4) = o; }
#pragma unroll
        for (int mat = 0; mat < 3; ++mat)
#pragma unroll
            for (int r = 0; r < 12; ++r) rawc[mat][r] = rawn[mat][r];
        bac = ban;
        __syncthreads();
    }
}

__device__ __forceinline__ void ph_gdnb(const Params& p, float* smem) {
    if (blockIdx.x >= B_ * NH * 2 * 2) return;
    LAS unsigned char* L = (LAS unsigned char*)smem;
    constexpr int BUF = 62464 + 1024, OW = 0, OQ = 17408, OK_ = 34816, OQK = 53248, OSC = 62464;
    const int half = (blockIdx.x >> 3) & 1, seq = (blockIdx.x & 7) | ((blockIdx.x >> 4) << 3), dir = seq & 1, h = (seq >> 1) & 3, b = seq >> 3;
    const bf16_t* GQN = (const bf16_t*)(p.ws + WS_GQN);
    const bf16_t* GW = (const bf16_t*)(p.ws + WS_GW); const bf16_t* GUT = (const bf16_t*)(p.ws + WS_GUT); const bf16_t* GQK = (const bf16_t*)(p.ws + WS_GQK); const bf16_t* GKT = (const bf16_t*)(p.ws + WS_GKT);
    const float* GSC = (const float*)((unsigned char*)p.out + OUT_GSC);
    bf16_t* GO = (bf16_t*)((unsigned char*)p.out + OUT_GO) + (size_t)dir * T_ * GDW;
    auto stage = [&](int n, int buf, int tt, auto nth_tag) {
        constexpr int NTH = decltype(nth_tag)::value, NCH = 3584 / NTH;
        const int item = (b * 4 + h) * 32 + n;
        u32x4 d[NCH];
#pragma unroll
        for (int i = 0; i < NCH; ++i) { const int e = tt + i * NTH; const u32x4* src;
            if (e < 1024) src = (const u32x4*)(GW + (size_t)(item * 2 + dir) * 8192) + e;
            else if (e < 2048) src = (const u32x4*)(GQN + (size_t)item * 8192) + (e - 1024);
            else if (e < 3072) src = (const u32x4*)(GKT + (size_t)item * 8192) + (e - 2048);
            else src = (const u32x4*)(GQK + (size_t)(item * 2 + dir) * 4096) + (e - 3072);
            d[i] = *src; }
        const float scv = (tt < 132) ? GSC[(size_t)(item * 2 + dir) * 132 + tt] : 0.f;
#pragma unroll
        for (int i = 0; i < NCH; ++i) { const int e = tt + i * NTH; int off;
            if (e < 1024) off = OW + (e >> 4) * 272 + (e & 15) * 16;
            else if (e < 2048) off = OQ + ((e - 1024) >> 4) * 272 + (e & 15) * 16;
            else if (e < 3072) off = OK_ + ((e - 2048) >> 3) * 144 + (e & 7) * 16;
            else off = OQK + ((e - 3072) >> 3) * 144 + (e & 7) * 16;
            *(LAS u32x4*)(L + buf * BUF + off) = d[i]; }
        if (tt < 132) *(LAS float*)(L + buf * BUF + OSC + tt * 4) = scv;
    };
    auto loadu = [&](bf16x4 (&u)[4], int n) {
        const int THR = ltid(); const int lane = THR & 63, wid = THR >> 6, l15 = lane & 15, q4 = lane >> 4, dv0 = half * 64 + (wid & 3) * 16;
        const bf16_t* ut = GUT + (size_t)(((b * 4 + h) * 32 + n) * 2 + dir) * 8192 + (size_t)(dv0 + l15) * 64 + 4 * q4;
#pragma unroll
        for (int mt = 0; mt < 4; ++mt) u[mt] = *(const bf16x4*)(ut + 16 * mt);
    };
    f32x4 S[8]; bf16x8 Sb[4];
#pragma unroll
    for (int i = 0; i < 8; ++i) S[i] = (f32x4){0.f, 0.f, 0.f, 0.f};
#pragma unroll
    for (int i = 0; i < 4; ++i) Sb[i] = (bf16x8){0, 0, 0, 0, 0, 0, 0, 0};
    auto compute = [&](int n, int buf, const bf16x4 (&uraw)[4]) {
        const int THR = ltid(); const int lane = THR & 63, wid = THR >> 6, l15 = lane & 15, q4 = lane >> 4, dv0 = half * 64 + (wid & 3) * 16;
        const LAS unsigned char* Bf = L + buf * BUF; const LAS float* scl = (const LAS float*)(Bf + OSC);
        f32x4 ws[4], qs[4];
        {
            bf16x8 fa[4][4];
#pragma unroll
            for (int mt = 0; mt < 4; ++mt)
#pragma unroll
                for (int s4 = 0; s4 < 4; ++s4) { const LAS unsigned char* r = Bf + OW + (16 * mt + l15) * 272 + (32 * s4 + 4 * q4) * 2; fa[mt][s4] = cat44(*(const LAS bf16x4*)r, *(const LAS bf16x4*)(r + 32)); }
#pragma unroll
            for (int mt = 0; mt < 4; ++mt) { ws[mt] = (f32x4){0.f, 0.f, 0.f, 0.f};
#pragma unroll
                for (int s4 = 0; s4 < 4; ++s4) ws[mt] = __builtin_amdgcn_mfma_f32_16x16x32_bf16(fa[mt][s4], Sb[s4], ws[mt], 0, 0, 0); }
        }
        {
            bf16x8 fa[4][4];
#pragma unroll
            for (int mt = 0; mt < 4; ++mt)
#pragma unroll
                for (int s4 = 0; s4 < 4; ++s4) { const LAS unsigned char* r = Bf + OQ + (16 * mt + l15) * 272 + (32 * s4 + 4 * q4) * 2; fa[mt][s4] = cat44(*(const LAS bf16x4*)r, *(const LAS bf16x4*)(r + 32)); }
#pragma unroll
            for (int mt = 0; mt < 4; ++mt) { qs[mt] = (f32x4){0.f, 0.f, 0.f, 0.f};
#pragma unroll
                for (int s4 = 0; s4 < 4; ++s4) qs[mt] = __builtin_amdgcn_mfma_f32_16x16x32_bf16(fa[mt][s4], Sb[s4], qs[mt], 0, 0, 0); }
        }
        f32x4 vn[4], vs[4];
#pragma unroll
        for (int mt = 0; mt < 4; ++mt) { const f32x4 es = *(const LAS f32x4*)(scl + 64 + 16 * mt + 4 * q4);
#pragma unroll
            for (int r = 0; r < 4; ++r) { const float u = __uint_as_float(((unsigned)(unsigned short)uraw[mt][r]) << 16); vn[mt][r] = u - ws[mt][r]; vs[mt][r] = vn[mt][r] * es[r]; } }
        bf16x8 vb[2], vsb[2];
#pragma unroll
        for (int s2 = 0; s2 < 2; ++s2) { vb[s2] = cat44(pack4(vn[2 * s2][0], vn[2 * s2][1], vn[2 * s2][2], vn[2 * s2][3]), pack4(vn[2 * s2 + 1][0], vn[2 * s2 + 1][1], vn[2 * s2 + 1][2], vn[2 * s2 + 1][3]));
            vsb[s2] = cat44(pack4(vs[2 * s2][0], vs[2 * s2][1], vs[2 * s2][2], vs[2 * s2][3]), pack4(vs[2 * s2 + 1][0], vs[2 * s2 + 1][1], vs[2 * s2 + 1][2], vs[2 * s2 + 1][3])); }
        bf16x8 fk[8][2];
        {
            bf16x8 fq[4][2];
#pragma unroll
            for (int it = 0; it < 4; ++it)
#pragma unroll
                for (int s2 = 0; s2 < 2; ++s2) { const LAS unsigned char* r = Bf + OQK + (16 * it + l15) * 144 + (32 * s2 + 4 * q4) * 2; fq[it][s2] = cat44(*(const LAS bf16x4*)r, *(const LAS bf16x4*)(r + 32)); }
#pragma unroll
            for (int t8 = 0; t8 < 8; ++t8)
#pragma unroll
                for (int s2 = 0; s2 < 2; ++s2) { const LAS unsigned char* r = Bf + OK_ + (16 * t8 + l15) * 144 + (32 * s2 + 4 * q4) * 2; fk[t8][s2] = cat44(*(const LAS bf16x4*)r, *(const LAS bf16x4*)(r + 32)); }
#pragma unroll
            for (int it = 0; it < 4; ++it) { f32x4 o2 = {0.f, 0.f, 0.f, 0.f};
#pragma unroll
                for (int s2 = 0; s2 < 2; ++s2) o2 = __builtin_amdgcn_mfma_f32_16x16x32_bf16(fq[it][s2], vb[s2], o2, 0, 0, 0);
                const f32x4 eg4 = *(const LAS f32x4*)(scl + 16 * it + 4 * q4);
#pragma unroll
                for (int r = 0; r < 4; ++r) { const int tok = 16 * it + 4 * q4 + r; const float o = eg4[r] * qs[it][r] + o2[r];
                    GO[((size_t)b * S_ + n * 64 + tok) * GDW + h * 128 + dv0 + l15] = f2bf(o); } }
        }
        const float eg = scl[128];
#pragma unroll
        for (int t8 = 0; t8 < 8; ++t8) { f32x4 c = S[t8] * eg;
#pragma unroll
            for (int s2 = 0; s2 < 2; ++s2) c = __builtin_amdgcn_mfma_f32_16x16x32_bf16(fk[t8][s2], vsb[s2], c, 0, 0, 0);
            S[t8] = c; }
#pragma unroll
        for (int s4 = 0; s4 < 4; ++s4) Sb[s4] = cat44(pack4(S[2 * s4][0], S[2 * s4][1], S[2 * s4][2], S[2 * s4][3]), pack4(S[2 * s4 + 1][0], S[2 * s4 + 1][1], S[2 * s4 + 1][2], S[2 * s4 + 1][3]));
    };
    const int n0 = dir ? 31 : 0, dn = dir ? -1 : 1;
    const int wid0 = __builtin_amdgcn_readfirstlane(ltid() >> 6);
    { const int THR = ltid(); stage(n0, 0, THR, std::integral_constant<int, 512>()); }
    __syncthreads();
    if (wid0 >= 4) {
        const int tt = ltid() - 256;
        constexpr int NCH = 14;
        auto ld = [&](u32x4 (&d)[NCH], float& scv, int n) {
            const int item = (b * 4 + h) * 32 + n;
#pragma unroll
            for (int i = 0; i < NCH; ++i) { const int e = tt + i * 256; const u32x4* src;
                if (e < 1024) src = (const u32x4*)(GW + (size_t)(item * 2 + dir) * 8192) + e;
                else if (e < 2048) src = (const u32x4*)(GQN + (size_t)item * 8192) + (e - 1024);
                else if (e < 3072) src = (const u32x4*)(GKT + (size_t)item * 8192) + (e - 2048);
                else src = (const u32x4*)(GQK + (size_t)(item * 2 + dir) * 4096) + (e - 3072);
                d[i] = *src; }
            scv = (tt < 132) ? GSC[(size_t)(item * 2 + dir) * 132 + tt] : 0.f;
        };
        auto st_ = [&](const u32x4 (&d)[NCH], float scv, int buf) {
#pragma unroll
            for (int i = 0; i < NCH; ++i) { const int e = tt + i * 256; int off;
                if (e < 1024) off = OW + (e >> 4) * 272 + (e & 15) * 16;
                else if (e < 2048) off = OQ + ((e - 1024) >> 4) * 272 + (e & 15) * 16;
                else if (e < 3072) off = OK_ + ((e - 2048) >> 3) * 144 + (e & 7) * 16;
                else off = OQK + ((e - 3072) >> 3) * 144 + (e & 7) * 16;
                *(LAS u32x4*)(L + buf * BUF + off) = d[i]; }
            if (tt < 132) *(LAS float*)(L + buf * BUF + OSC + tt * 4) = scv;
        };
        u32x4 r0[NCH], r1[NCH]; float c0 = 0.f, c1 = 0.f;
        ld(r0, c0, n0 + dn);
        for (int st = 0; st < 32; st += 2) {
            if (st + 2 < 32) ld(r1, c1, n0 + dn * (st + 2));
            st_(r0, c0, 1);
            __syncthreads();
            if (st + 3 < 32) ld(r0, c0, n0 + dn * (st + 3));
            if (st + 2 < 32) st_(r1, c1, 0);
            __syncthreads();
        }
    } else {
        bf16x4 uA[4], uB[4];
        loadu(uA, n0); loadu(uB, n0 + dn);
        for (int st = 0; st < 32; st += 2) {
            { bf16x4 uc[4];
#pragma unroll
              for (int mt = 0; mt < 4; ++mt) uc[mt] = uA[mt];
              if (st + 2 < 32) loadu(uA, n0 + dn * (st + 2));
              compute(n0 + dn * st, 0, uc);
              __syncthreads(); }
            { bf16x4 uc[4];
#pragma unroll
              for (int mt = 0; mt < 4; ++mt) uc[mt] = uB[mt];
              if (st + 3 < 32) loadu(uB, n0 + dn * (st + 3));
              compute(n0 + dn * (st + 1), 1, uc);
              __syncthreads(); }
        }
    }
}
__device__ __forceinline__ void ph_gdncomb(const Params& p, float* smem) {
    const int THR = ltid();
    const bf16_t* O = (const bf16_t*)((unsigned char*)p.out + OUT_GO); const bf16_t* zb = (const bf16_t*)(p.ws + WS_ZB); bf16_t* cat = (bf16_t*)(p.ws + WS_CAT); const float* gn = p.in[I_GDN_NORM];
    const int lane = THR & 63, gw = blockIdx.x * NW + (THR >> 6), nw = gridDim.x * NW;
    const f4_t g0 = ((const f4_t*)gn)[(lane & 15) * 2], g1 = ((const f4_t*)gn)[(lane & 15) * 2 + 1];
    const float gg[8] = {g0.x, g0.y, g0.z, g0.w, g1.x, g1.y, g1.z, g1.w};
    const float* ssq5 = (const float*)(p.ws + WS_SSQ); const f4_t n0 = ((const f4_t*)p.in[I_S5_NORM])[lane * 2], n1 = ((const f4_t*)p.in[I_S5_NORM])[lane * 2 + 1];
    const float nn[8] = {n0.x, n0.y, n0.z, n0.w, n1.x, n1.y, n1.z, n1.w};
    for (int t0 = gw * 4; t0 < T_; t0 += nw * 4) {
        u4_t of[4], ob[4], zz[4], s5[4]; float r5[4];
#pragma unroll
        for (int r = 0; r < 4; ++r) { const size_t t = t0 + r; s5[r] = ((const u4_t*)(cat + t * D_))[lane]; r5[r] = rsqrtf(ssq5[t] * (1.f / (float)S5W) + RMS_EPS); of[r] = ((const u4_t*)(O + t * GDW))[lane]; ob[r] = ((const u4_t*)(O + (size_t)T_ * GDW + t * GDW))[lane]; zz[r] = ((const u4_t*)(zb + t * GDW))[lane]; }
#pragma unroll
        for (int r = 0; r < 4; ++r) {
            float a[8]; float ss = 0.f;
#pragma unroll
            for (int k = 0; k < 4; ++k) { a[2 * k] = bflo(of[r][k]) + bflo(ob[r][k]); a[2 * k + 1] = bfhi(of[r][k]) + bfhi(ob[r][k]); ss += a[2 * k] * a[2 * k] + a[2 * k + 1] * a[2 * k + 1]; }
            ss = dpp_sum16(ss);
            const float rs = rsqrtf(ss * (1.f / 128.f) + RMS_EPS);
            float o[8];
#pragma unroll
            for (int k = 0; k < 4; ++k) { o[2 * k] = a[2 * k] * rs * gg[2 * k] * siluf_(bflo(zz[r][k])); o[2 * k + 1] = a[2 * k + 1] * rs * gg[2 * k + 1] * siluf_(bfhi(zz[r][k])); }
            u4_t w; w.x = pkbf(o[0], o[1]); w.y = pkbf(o[2], o[3]); w.z = pkbf(o[4], o[5]); w.w = pkbf(o[6], o[7]);
            ((u4_t*)(cat + (size_t)(t0 + r) * D_ + 512))[lane] = w;
            u4_t v5;
#pragma unroll
            for (int k = 0; k < 4; ++k) v5[k] = pkbf(bflo(s5[r][k]) * r5[r] * nn[2 * k], bfhi(s5[r][k]) * r5[r] * nn[2 * k + 1]);
            ((u4_t*)(cat + (size_t)(t0 + r) * D_))[lane] = v5; }
    }
}
constexpr int RT_GN_OFF = 73728, RT_LG_OFF = 77824, RT_LG_STRIDE = 2688;
__device__ __forceinline__ void router_stage(const u4_t* src, LAS unsigned char* L, int half, int THR) {
#pragma unroll 3
    for (int i = THR; i < 72 * 64; i += NT) { const int R = i >> 6, ch = i & 63, o = R >= 36 ? R - 36 : R, key = (o < 4 ? o : o - 4) & 15;
        *(LAS u4_t*)(L + (size_t)((R * 64 + (ch ^ key)) * 16)) = src[R * 128 + half * 64 + ch]; }
}
__device__ __forceinline__ void ph_router(const Params& p, float* smem) {
    const int THR = ltid();
    const bf16_t* x2 = (const bf16_t*)(p.ws + WS_XB); bf16_t* xs = (bf16_t*)(p.ws + WS_XS); int* route = (int*)(p.ws + WS_ROUTE); int* mc = (int*)(p.ws + WS_CNT);
    const float* gn = p.in[I_NORM_MOE]; const float* bg = p.in[I_RG_B]; const float* be = p.in[I_RE_B]; const u4_t* WrHL = (const u4_t*)(p.ws + WS_WRT);
    LAS unsigned char* L = (LAS unsigned char*)smem;
    for (int i = THR; i < D_ / 4; i += NT) *(LAS f4_t*)(L + RT_GN_OFF + i * 16) = ((const f4_t*)gn)[i];
    for (int base = 0; base < T_ / 16; base += (int)gridDim.x * 4) {
        const int TH2 = ltid(); const int lane = TH2 & 63, wid = TH2 >> 6, c = lane & 15, q = lane >> 4;
        LAS float* lgs = (LAS float*)(L + RT_LG_OFF + (wid & 3) * RT_LG_STRIDE); LAS float* lrs = lgs + 640;
        const int tg = base + (int)blockIdx.x * 4 + wid; const bool act = (wid < 4) && (tg < T_ / 16);
        const int t0 = act ? tg * 16 : 0;
        u4_t A[32];
        if (act) { const u4_t* xr = (const u4_t*)(x2 + (size_t)(t0 + c) * D_) + q;
#pragma unroll
          for (int s = 0; s < 32; ++s) A[s] = xr[4 * s]; }
        f32x4 acc0 = {0.f, 0.f, 0.f, 0.f}, acc1 = acc0, acc2 = acc0;
#pragma unroll
        for (int half = 0; half < 2; ++half) {
            if (half) __syncthreads();
            router_stage(WrHL, L, half, THR);
            __syncthreads();
            if (act) {
#pragma unroll
                for (int ls = 0; ls < 16; ++ls) {
                    const bf16x8 a = __builtin_bit_cast(bf16x8, A[half * 16 + ls]);
                    const int swe = ((4 * ls + q) ^ c) * 16, swg = ((4 * ls + q) ^ (c & 3)) * 16;
#pragma unroll
                    for (int hl = 0; hl < 2; ++hl) {
                        const bf16x8 b0 = *(const LAS bf16x8*)(L + (hl * 36 + 4 + c) * 1024 + swe);
                        const bf16x8 b1 = *(const LAS bf16x8*)(L + (hl * 36 + 20 + c) * 1024 + swe);
                        const bf16x8 b2 = *(const LAS bf16x8*)(L + (hl * 36 + (c & 3)) * 1024 + swg);
                        acc0 = __builtin_amdgcn_mfma_f32_16x16x32_bf16(a, b0, acc0, 0, 0, 0);
                        acc1 = __builtin_amdgcn_mfma_f32_16x16x32_bf16(a, b1, acc1, 0, 0, 0);
                        acc2 = __builtin_amdgcn_mfma_f32_16x16x32_bf16(a, b2, acc2, 0, 0, 0);
                    }
                    if (ls & 1) asm volatile("" ::: "memory");
                }
            }
        }
        if (act) {
            float ss = 0.f;
#pragma unroll
            for (int s = 0; s < 32; ++s)
#pragma unroll
                for (int k = 0; k < 4; ++k) { const float lo = bflo(A[s][k]), hi = bfhi(A[s][k]); ss += lo * lo + hi * hi; }
            ss += __shfl_xor(ss, 16); ss += __shfl_xor(ss, 32);
            const float rs = rsqrtf(ss * (1.f / (float)D_) + RMS_EPS);
#pragma unroll
            for (int r = 0; r < 4; ++r) { LAS float* row = lgs + (4 * q + r) * 40; row[4 + c] = acc0[r]; row[20 + c] = acc1[r]; if (c < 4) row[c] = acc2[r]; }
            if (q == 0) lrs[c] = rs;
            asm volatile("s_waitcnt lgkmcnt(0)" ::: "memory");
            float mine[36];
            if (lane < 16) {
                const float rt = lrs[lane];
#pragma unroll
                for (int o = 0; o < 36; ++o) mine[o] = lgs[lane * 40 + o] * rt + (o < 4 ? bg[o] : be[o - 4]);
            }
            int r0v = 0, r1v = 0;
            if (lane < 16) {
                int gi = 0; float gm = mine[0];
#pragma unroll
                for (int g = 1; g < 4; ++g) if (mine[g] > gm) { gm = mine[g]; gi = g; }
                float gs = 0.f;
#pragma unroll
                for (int g = 0; g < 4; ++g) gs += __expf(mine[g] - gm);
                const float ptop = 1.f / gs;
                float el[8];
#pragma unroll
                for (int e = 0; e < 8; ++e) { float v = mine[4 + e];
#pragma unroll
                    for (int g = 1; g < 4; ++g) v = (gi == g) ? mine[4 + g * 8 + e] : v;
                    el[e] = v; }
                int i0 = 0; float v0 = el[0];
#pragma unroll
                for (int e = 1; e < 8; ++e) if (el[e] > v0) { v0 = el[e]; i0 = e; }
                int i1 = -1; float v1 = -1e30f;
#pragma unroll
                for (int e = 0; e < 8; ++e) if (e != i0 && el[e] > v1) { v1 = el[e]; i1 = e; }
                const float e1 = __expf(v1 - v0), w0 = ptop / (1.f + e1), w1 = ptop * e1 / (1.f + e1);
                const int ea = gi * 8 + i0, eb = gi * 8 + i1;
                const int pa = atomicAdd(mc + ea * MC_CS, 1), pbb = atomicAdd(mc + eb * MC_CS, 1);
                unsigned* ma = (unsigned*)mc + MC_MAP + ea * 128 + (pa >> 8); unsigned* mb = (unsigned*)mc + MC_MAP + eb * 128 + (pbb >> 8);
                if ((pa & 255) == 0)  { const int tid = atomicAdd(mc + MC_NT, 1); mc[MC_REV + tid] = ea; __hip_atomic_store(ma, (unsigned)tid + 1u, __ATOMIC_RELAXED, __HIP_MEMORY_SCOPE_AGENT); }
                if ((pbb & 255) == 0) { const int tid = atomicAdd(mc + MC_NT, 1); mc[MC_REV + tid] = eb; __hip_atomic_store(mb, (unsigned)tid + 1u, __ATOMIC_RELAXED, __HIP_MEMORY_SCOPE_AGENT); }
                asm volatile("" ::: "memory");
                unsigned ta, tb, sp = 0u;
                while ((ta = __hip_atomic_load(ma, __ATOMIC_RELAXED, __HIP_MEMORY_SCOPE_AGENT)) == 0u) { __builtin_amdgcn_s_sleep(1); if (++sp > (1u << 22)) break; }
                while ((tb = __hip_atomic_load(mb, __ATOMIC_RELAXED, __HIP_MEMORY_SCOPE_AGENT)) == 0u) { __builtin_amdgcn_s_sleep(1); if (++sp > (1u << 22)) break; }
                r0v = (int)(ta - 1u) * 256 + (pa & 255); r1v = (int)(tb - 1u) * 256 + (pbb & 255);
                int* rr = route + (size_t)(t0 + lane) * 8; rr[0] = ea; rr[1] = eb; ((float*)rr)[2] = w0; ((float*)rr)[3] = w1; rr[6] = r0v; rr[7] = r1v;
            }
            const int d0 = __shfl(r0v, c), d1 = __shfl(r1v, c);
            u4_t* q0 = (u4_t*)(xs + (size_t)d0 * D_) + q; u4_t* q1 = (u4_t*)(xs + (size_t)d1 * D_) + q;
#pragma unroll
            for (int s = 0; s < 32; ++s) {
                const f4_t g0 = *(const LAS f4_t*)(L + RT_GN_OFF + (32 * s + 8 * q) * 4), g1 = *(const LAS f4_t*)(L + RT_GN_OFF + (32 * s + 8 * q) * 4 + 16);
                u4_t w; asm volatile("" : "+v"(A[s]));
                w.x = pkbf(bflo(A[s].x) * rs * g0.x, bfhi(A[s].x) * rs * g0.y); w.y = pkbf(bflo(A[s].y) * rs * g0.z, bfhi(A[s].y) * rs * g0.w);
                w.z = pkbf(bflo(A[s].z) * rs * g1.x, bfhi(A[s].z) * rs * g1.y); w.w = pkbf(bflo(A[s].w) * rs * g1.z, bfhi(A[s].w) * rs * g1.w);
                q0[4 * s] = w; q1[4 * s] = w;
                if ((s & 3) == 3) asm volatile("" ::: "memory");
            }
        }
        __syncthreads();
    }
}
__device__ __forceinline__ void moe_build_table(const Params& p, int* tab) {
    const int THR = ltid();
    const int* mc = (const int*)(p.ws + WS_CNT);
    if (THR == 0) tab[0] = mc[MC_NT];
    if (THR < 160) tab[40 + THR] = mc[MC_REV + THR];
    __syncthreads();
}
__device__ __forceinline__ void ph_final(const Params& p, float* smem) {
    const int THR = ltid();
    float* out = p.out; const bf16_t* x2 = (const bf16_t*)(p.ws + WS_XB); const float* gn = p.in[I_NORM_FINAL]; const bf16_t* Y = (const bf16_t*)(p.ws + WS_XS); const int* route = (const int*)(p.ws + WS_ROUTE);
    const int lane = THR & 63, gw = blockIdx.x * NW + (THR >> 6), nw = gridDim.x * NW;
    f4_t g[4];
#pragma unroll
    for (int j = 0; j < 4; ++j) g[j] = ((const f4_t*)gn)[lane + 64 * j];
    for (int t0 = gw * 2; t0 < T_; t0 += nw * 2) {
        f4_t xv[2][4]; u2_t xr[2][4], ya[2][4], yb[2][4]; float w0[2], w1[2];
#pragma unroll
        for (int r = 0; r < 2; ++r) { const int* rr = route + (size_t)(t0 + r) * 8; w0[r] = ((const float*)rr)[2]; w1[r] = ((const float*)rr)[3];
            const u2_t* y0 = (const u2_t*)(Y + (size_t)rr[6] * D_); const u2_t* y1 = (const u2_t*)(Y + (size_t)rr[7] * D_);
#pragma unroll
            for (int j = 0; j < 4; ++j) { xr[r][j] = ((const u2_t*)(x2 + (size_t)(t0 + r) * D_))[lane + 64 * j]; ya[r][j] = y0[lane + 64 * j]; yb[r][j] = y1[lane + 64 * j]; } }
#pragma unroll
        for (int r = 0; r < 2; ++r) { float ss = 0.f;
#pragma unroll
            for (int j = 0; j < 4; ++j) { f4_t v = (f4_t){bflo(xr[r][j].x), bfhi(xr[r][j].x), bflo(xr[r][j].y), bfhi(xr[r][j].y)};
                v.x += w0[r] * bflo(ya[r][j].x) + w1[r] * bflo(yb[r][j].x); v.y += w0[r] * bfhi(ya[r][j].x) + w1[r] * bfhi(yb[r][j].x);
                v.z += w0[r] * bflo(ya[r][j].y) + w1[r] * bflo(yb[r][j].y); v.w += w0[r] * bfhi(ya[r][j].y) + w1[r] * bfhi(yb[r][j].y);
                xv[r][j] = v; ss += v.x * v.x + v.y * v.y + v.z * v.z + v.w * v.w; }
            const float rs = rsqrtf(wave_sum(ss) * (1.f / (float)D_) + RMS_EPS);
#pragma unroll
            for (int j = 0; j < 4; ++j) ((f4_t*)(out + (size_t)(t0 + r) * D_))[lane + 64 * j] = xv[r][j] * rs * g[j]; }
    }
}


typedef pg8::f32x4 f32x4; typedef pg8::u32x4 u32x4;

__device__ __forceinline__ void transpose_item(const float* W, int K, int N, bf16_t* WT, int ldt, int dst_row0, int k0, int n0, const float* rowscale, LAS float* scr, int lane) {
    f4_t v[8];
#pragma unroll
    for (int i = 0; i < 8; ++i) v[i] = *(const f4_t*)(W + (size_t)(k0 + (lane >> 3) + 8 * i) * N + n0 + 4 * (lane & 7));
#pragma unroll
    for (int i = 0; i < 8; ++i) { const int kk = (lane >> 3) + 8 * i; f4_t x = v[i]; if (rowscale) x = x * rowscale[k0 + kk];
        LAS float* d = scr + kk * 33 + 4 * (lane & 7); d[0] = x.x; d[1] = x.y; d[2] = x.z; d[3] = x.w; }
    asm volatile("s_waitcnt lgkmcnt(0)" ::: "memory");
    const int c = lane & 7;
#pragma unroll
    for (int j = 0; j < 4; ++j) { const int n = (lane >> 3) + 8 * j; const LAS float* sp = scr + (8 * c) * 33 + n;
        u32x4 o; o.x = pg8::cvt_pk_bf16(sp[0 * 33], sp[1 * 33]); o.y = pg8::cvt_pk_bf16(sp[2 * 33], sp[3 * 33]); o.z = pg8::cvt_pk_bf16(sp[4 * 33], sp[5 * 33]); o.w = pg8::cvt_pk_bf16(sp[6 * 33], sp[7 * 33]);
        *(u32x4*)(WT + (size_t)(dst_row0 + n) * ldt + k0 + 8 * c) = o; }
    asm volatile("s_waitcnt lgkmcnt(0)" ::: "memory");
}
__device__ __forceinline__ void transpose_matrix(const float* W, int K, int N, bf16_t* WT, const float* rowscale, float* smem) {
    const int THR = ltid();
    const int lane = THR & 63, wv = THR >> 6; LAS float* scr = (LAS float*)smem + wv * (64 * 33);
    const int gw = blockIdx.x * NW + wv, nw = gridDim.x * NW, nblk = N / 32, items = (K / 64) * nblk;
    for (int it = gw; it < items; it += nw) { const int kb = it / nblk, nb = it % nblk; transpose_item(W, K, N, WT, K, nb * 32, kb * 64, nb * 32, rowscale, scr, lane); }
}
__device__ __forceinline__ void ph_prep0(const Params& p, float* smem) {
    const int THR = ltid();
    bf16_t* WinT = (bf16_t*)((unsigned char*)p.out + OUT_WINT);
    {
        const int lane = THR & 63, wv = THR >> 6; LAS float* scr = (LAS float*)smem + wv * (64 * 33);
        const int gw = blockIdx.x * NW + wv, nw = gridDim.x * NW, nblk = 2560 / 32, items = 16 * nblk;
        for (int it = gw; it < items; it += nw) { const int kb = it / nblk, nb = it % nblk; transpose_item(p.in[I_W_IN], D_, DIN, WinT, D_, nb * 32, kb * 64, nb * 32, nullptr, scr, lane); }
        for (size_t i = (size_t)blockIdx.x * NT + THR; i < (size_t)256 * D_; i += (size_t)gridDim.x * NT) {
            const int n = (int)(i / D_), k = (int)(i % D_);
            WinT[(size_t)(2560 + n) * D_ + k] = n < 16 ? f2bf(p.in[I_W_IN][(size_t)k * DIN + 2560 + n]) : (bf16_t)0;
        }
    }
    transpose_matrix(p.in[I_W_GLU], S5W, S5W, (bf16_t*)((unsigned char*)p.out + OUT_WGLUT), nullptr, smem);
    transpose_matrix(p.in[I_WK], D_, D_, (bf16_t*)((unsigned char*)p.out + OUT_WKT), nullptr, smem);
    transpose_matrix(p.in[I_WV], D_, D_, (bf16_t*)((unsigned char*)p.out + OUT_WVT), nullptr, smem);
    { float* ssq = (float*)(p.ws + WS_SSQ); for (int i = blockIdx.x * NT + THR; i < 2 * T_; i += gridDim.x * NT) ssq[i] = 0.f; }
}
__device__ __forceinline__ void ph_prep1(const Params& p, float* smem) {
    transpose_matrix(p.in[I_W_OUT], D_, D_, (bf16_t*)(p.ws + WS_WOUTT), nullptr, smem);
}
__device__ __forceinline__ void ph_prepa(const Params& p, float* smem) {
    const int THR = ltid();
    bf16_t* WqB = (bf16_t*)(p.ws + WS_WQB); const float* wq = p.in[I_WQ]; const float* gx = p.in[I_NORM_XA];
    for (int i = blockIdx.x * NT + THR; i < D_ * D_ / 4; i += gridDim.x * NT) { const f4_t v = ((const f4_t*)wq)[i] * gx[i >> 8]; u2_t w; w.x = pkbf(v.x, v.y); w.y = pkbf(v.z, v.w); ((u2_t*)WqB)[i] = w; }
    transpose_matrix(p.in[I_WO], D_, D_, (bf16_t*)(p.ws + WS_WOT), nullptr, smem);
}
__device__ __forceinline__ void ph_prep2(const Params& p, float* smem) {
    const int THR = ltid();
    const int lane = THR & 63, wv = THR >> 6; LAS float* scr = (LAS float*)smem + wv * (64 * 33);
    const int gw = blockIdx.x * NW + wv, nw = gridDim.x * NW;
    bf16_t* WguT = (bf16_t*)(p.ws + WS_WGUT); bf16_t* WdT = (bf16_t*)(p.ws + WS_WDT);
    if (blockIdx.x == 0) for (int i = THR; i < MC_WORDS; i += NT) ((int*)(p.ws + WS_CNT))[i] = 0;
    { bf16_t* WrHL = (bf16_t*)(p.ws + WS_WRT); const float* gnm = p.in[I_NORM_MOE];
      for (int i = blockIdx.x * NT + THR; i < 36 * D_; i += gridDim.x * NT) { const int o = i >> 10, k = i & 1023; const float w = gnm[k] * (o < 4 ? p.in[I_RG_W][k * 4 + o] : p.in[I_RE_W][k * NE + (o - 4)]);
          const bf16_t hi = f2bf(w); WrHL[i] = hi; WrHL[36 * D_ + i] = f2bf(w - bf2f(hi)); } }
    for (int it = gw; it < NE * 2 * 128; it += nw) {
        const int e = it >> 8, which = (it >> 7) & 1, r = it & 127, kb = r >> 3, nb = r & 7, f0 = nb * 32;
        const float* W = p.in[which ? I_WUP : I_WGATE] + (size_t)e * D_ * DE;
        transpose_item(W, D_, DE, WguT, D_, e * 512 + (f0 >> 7) * 256 + which * 128 + (f0 & 127), kb * 64, f0, nullptr, scr, lane);
    }
    for (int it = gw; it < NE * 128; it += nw) {
        const int e = it >> 7, r = it & 127, kb = r >> 5, nb = r & 31;
        transpose_item(p.in[I_WDOWN] + (size_t)e * DE * D_, DE, D_, WdT, DE, e * D_ + nb * 32, kb * 64, nb * 32, nullptr, scr, lane);
    }
}

struct EpiInproj {
    static constexpr bool PERM = true;
    bf16_t* qkvr; bf16_t* zb; float* ba; bf16_t* aext;
    __device__ __forceinline__ void operator()(const f32x4 (&acc)[2][2][4][2], const pg8::Unit& u, int wr, int wc, int fr, int fq) const {
        const int row0 = u.orow + wr * 64 + fr;
        if (u.aux < 2) {
            const int col0 = u.ocol + wc * 32 + 8 * fq;
#pragma unroll
            for (int ai = 0; ai < 2; ++ai)
#pragma unroll
                for (int m = 0; m < 4; ++m) { const int t = row0 + ai * 128 + m * 16, n = t >> 4, j = t & 15;
#pragma unroll
                    for (int bj = 0; bj < 2; ++bj) { const int c = col0 + bj * 128, g = c >> 4, ci = c & 15; const f32x4 v0 = acc[ai][bj][m][0], v1 = acc[ai][bj][m][1];
                        u32x4 w; w.x = pg8::cvt_pk_bf16(v0[0], v0[1]); w.y = pg8::cvt_pk_bf16(v0[2], v0[3]); w.z = pg8::cvt_pk_bf16(v1[0], v1[1]); w.w = pg8::cvt_pk_bf16(v1[2], v1[3]);
                        *(u32x4*)(aext + ((size_t)g * 1024 + n) * 512 + j * 16 + ci) = w; } }
        } else if (u.aux < 10) {
            const int col0 = u.ocol + wc * 32 + 8 * fq;
#pragma unroll
            for (int ai = 0; ai < 2; ++ai)
#pragma unroll
                for (int m = 0; m < 4; ++m) { const int rr = row0 + ai * 128 + m * 16; bf16_t* rowp = (u.aux < 8) ? qkvr + (size_t)rr * QKV_LD + col0 - 512 : zb + (size_t)rr * GDW + col0 - 2048;
#pragma unroll
                    for (int bj = 0; bj < 2; ++bj) { const f32x4 v0 = acc[ai][bj][m][0], v1 = acc[ai][bj][m][1];
                        u32x4 w; w.x = pg8::cvt_pk_bf16(v0[0], v0[1]); w.y = pg8::cvt_pk_bf16(v0[2], v0[3]); w.z = pg8::cvt_pk_bf16(v1[0], v1[1]); w.w = pg8::cvt_pk_bf16(v1[2], v1[3]);
                        *(u32x4*)(rowp + bj * 128) = w; } }
        } else if (wc == 0 && fq < 2) {
#pragma unroll
            for (int ai = 0; ai < 2; ++ai)
#pragma unroll
                for (int m = 0; m < 4; ++m) { float* rowp = ba + (size_t)(row0 + ai * 128 + m * 16) * 16 + 8 * fq;
                    *(f32x4*)(rowp) = acc[ai][0][m][0]; *(f32x4*)(rowp + 4) = acc[ai][0][m][1]; }
        }
    }
};
struct EpiBf16Out {
    static constexpr bool PERM = true;
    bf16_t* O; int ldc; float scale; size_t aux_stride;
    __device__ __forceinline__ void operator()(const f32x4 (&acc)[2][2][4][2], const pg8::Unit& u, int wr, int wc, int fr, int fq) const {
        const int row0 = u.orow + wr * 64 + fr, col0 = u.ocol + wc * 32 + 8 * fq; bf16_t* base = O + (size_t)u.aux * aux_stride;
#pragma unroll
        for (int ai = 0; ai < 2; ++ai)
#pragma unroll
            for (int m = 0; m < 4; ++m) { bf16_t* rowp = base + (size_t)(row0 + ai * 128 + m * 16) * ldc + col0;
#pragma unroll
                for (int bj = 0; bj < 2; ++bj) { const f32x4 v0 = acc[ai][bj][m][0] * scale, v1 = acc[ai][bj][m][1] * scale;
                    u32x4 w; w.x = pg8::cvt_pk_bf16(v0[0], v0[1]); w.y = pg8::cvt_pk_bf16(v0[2], v0[3]); w.z = pg8::cvt_pk_bf16(v1[0], v1[1]); w.w = pg8::cvt_pk_bf16(v1[2], v1[3]);
                    *(u32x4*)(rowp + bj * 128) = w; } }
    }
};
struct EpiResid {
    static constexpr bool PERM = false;
    const float* base; const bf16_t* baseb; float* out; int ldc; bf16_t* xb; float* ssq;
    __device__ __forceinline__ void operator()(const f32x4 (&acc)[2][2][4][2], const pg8::Unit& u, int wr, int wc, int fr, int fq) const {
        const int row0 = u.orow + wr * 64 + fr, col0 = u.ocol + wc * 32 + 4 * fq;
#pragma unroll
        for (int ai = 0; ai < 2; ++ai)
#pragma unroll
            for (int m = 0; m < 4; ++m) { const size_t off = (size_t)(row0 + ai * 128 + m * 16) * ldc + col0; float ss = 0.f;
#pragma unroll
                for (int bj = 0; bj < 2; ++bj)
#pragma unroll
                    for (int n = 0; n < 2; ++n) { f32x4 b;
                        if (base) b = *(const f32x4*)(base + off + bj * 128 + n * 16);
                        else { const u2_t rb = *(const u2_t*)(baseb + off + bj * 128 + n * 16); b = (f32x4){bflo(rb.x), bfhi(rb.x), bflo(rb.y), bfhi(rb.y)}; }
                        const f32x4 o = b + acc[ai][bj][m][n]; if (out) *(f32x4*)(out + off + bj * 128 + n * 16) = o;
                        if (xb) { u2_t w; w.x = pkbf(o[0], o[1]); w.y = pkbf(o[2], o[3]); *(u2_t*)(xb + off + bj * 128 + n * 16) = w; ss += o[0] * o[0] + o[1] * o[1] + o[2] * o[2] + o[3] * o[3]; } }
                if (ssq) { ss += __shfl_xor(ss, 16); ss += __shfl_xor(ss, 32); if (fq == 0) atomicAdd(ssq + row0 + ai * 128 + m * 16, ss); }
                asm volatile("" ::: "memory"); }
    }
};
struct EpiGlu {
    static constexpr bool PERM = true;
    const bf16_t* gl; const float* bias; bf16_t* cat; float* ssq;
    __device__ __forceinline__ void operator()(const f32x4 (&acc)[2][2][4][2], const pg8::Unit& u, int wr, int wc, int fr, int fq) const {
        const int row0 = u.orow + wr * 64 + fr, col0 = u.ocol + wc * 32 + 8 * fq;
#pragma unroll
        for (int ai = 0; ai < 2; ++ai)
#pragma unroll
            for (int m = 0; m < 4; ++m) { const int r = row0 + ai * 128 + m * 16; float ss = 0.f;
#pragma unroll
                for (int bj = 0; bj < 2; ++bj) { const int c = col0 + bj * 128; const u4_t graw = *(const u4_t*)(gl + (size_t)r * S5W + c);
                    const f32x4 b0 = *(const f32x4*)(bias + c), b1 = *(const f32x4*)(bias + c + 4); const f32x4 a0 = acc[ai][bj][m][0] + b0, a1 = acc[ai][bj][m][1] + b1;
                    float o[8];
                    o[0] = bflo(graw.x) * sigmoidf_(a0[0]); o[1] = bfhi(graw.x) * sigmoidf_(a0[1]); o[2] = bflo(graw.y) * sigmoidf_(a0[2]); o[3] = bfhi(graw.y) * sigmoidf_(a0[3]);
                    o[4] = bflo(graw.z) * sigmoidf_(a1[0]); o[5] = bfhi(graw.z) * sigmoidf_(a1[1]); o[6] = bflo(graw.w) * sigmoidf_(a1[2]); o[7] = bfhi(graw.w) * sigmoidf_(a1[3]);
#pragma unroll
                    for (int e = 0; e < 8; ++e) ss += o[e] * o[e];
                    u4_t w; w.x = pkbf(o[0], o[1]); w.y = pkbf(o[2], o[3]); w.z = pkbf(o[4], o[5]); w.w = pkbf(o[6], o[7]);
                    *(u4_t*)(cat + (size_t)r * D_ + c) = w; }
                ss += __shfl_xor(ss, 16); ss += __shfl_xor(ss, 32); if (fq == 0) atomicAdd(ssq + r, ss);
                asm volatile("" ::: "memory"); }
    }
};
struct EpiBf16RowScale {
    static constexpr bool PERM = true;
    bf16_t* O; int ldc; float scale; const float* ssq;
    __device__ __forceinline__ void operator()(const f32x4 (&acc)[2][2][4][2], const pg8::Unit& u, int wr, int wc, int fr, int fq) const {
        const int row0 = u.orow + wr * 64 + fr, col0 = u.ocol + wc * 32 + 8 * fq;
#pragma unroll
        for (int ai = 0; ai < 2; ++ai)
#pragma unroll
            for (int m = 0; m < 4; ++m) { const int r = row0 + ai * 128 + m * 16; const float sc = rsqrtf(ssq[r] * (1.f / (float)D_) + RMS_EPS) * scale; bf16_t* rowp = O + (size_t)r * ldc + col0;
#pragma unroll
                for (int bj = 0; bj < 2; ++bj) { const f32x4 v0 = acc[ai][bj][m][0] * sc, v1 = acc[ai][bj][m][1] * sc;
                    u32x4 w; w.x = pg8::cvt_pk_bf16(v0[0], v0[1]); w.y = pg8::cvt_pk_bf16(v0[2], v0[3]); w.z = pg8::cvt_pk_bf16(v1[0], v1[1]); w.w = pg8::cvt_pk_bf16(v1[2], v1[3]);
                    *(u32x4*)(rowp + bj * 128) = w; } }
    }
};
struct EpiMoeUp {
    static constexpr bool PERM = true;
    bf16_t* hm;
    __device__ __forceinline__ void operator()(const f32x4 (&acc)[2][2][4][2], const pg8::Unit& u, int wr, int wc, int fr, int fq) const {
        const int row0 = u.orow + wr * 64 + fr, col0 = u.ocol + wc * 32 + 8 * fq;
#pragma unroll
        for (int ai = 0; ai < 2; ++ai)
#pragma unroll
            for (int m = 0; m < 4; ++m) { bf16_t* rowp = hm + (size_t)(row0 + ai * 128 + m * 16) * DE + col0;
                float h[8];
#pragma unroll
                for (int n = 0; n < 2; ++n)
#pragma unroll
                    for (int e = 0; e < 4; ++e) h[n * 4 + e] = siluf_(acc[ai][0][m][n][e]) * acc[ai][1][m][n][e];
                u32x4 w; w.x = pg8::cvt_pk_bf16(h[0], h[1]); w.y = pg8::cvt_pk_bf16(h[2], h[3]); w.z = pg8::cvt_pk_bf16(h[4], h[5]); w.w = pg8::cvt_pk_bf16(h[6], h[7]);
                *(u32x4*)rowp = w; }
    }
};

template <int NCOL> struct MoeOrder {
    const char* A; const char* W; const int* tab; int lda, wrows_per_expert, ldb, ocol_step, G, c;
    __device__ bool next(int i, pg8::Unit& u) const {
        const int L = i * G + c; if (L >= tab[0] * NCOL) return false;
        const int rt = L / NCOL, j = L % NCOL, e = tab[40 + rt];
        u.a = A + (size_t)rt * 256 * lda * 2; u.b = W + ((size_t)e * wrows_per_expert + j * 256) * ldb * 2; u.orow = rt * 256; u.ocol = j * ocol_step; u.aux = 0; return true;
    }
};

struct EpiF32Out {
    static constexpr bool PERM = false;
    float* O; int ldc; size_t aux_stride;
    __device__ __forceinline__ void operator()(const f32x4 (&acc)[2][2][4][2], const pg8::Unit& u, int wr, int wc, int fr, int fq) const {
        const int row0 = u.orow + wr * 64 + fr, col0 = u.ocol + wc * 32 + 4 * fq; float* base = O + (size_t)u.aux * aux_stride;
#pragma unroll
        for (int ai = 0; ai < 2; ++ai)
#pragma unroll
            for (int m = 0; m < 4; ++m) { float* rowp = base + (size_t)(row0 + ai * 128 + m * 16) * ldc + col0;
#pragma unroll
                for (int bj = 0; bj < 2; ++bj)
#pragma unroll
                    for (int n = 0; n < 2; ++n) *(f32x4*)(rowp + bj * 128 + n * 16) = acc[ai][bj][m][n]; }
    }
};
typedef float f32x2 __attribute__((ext_vector_type(2)));
__device__ __forceinline__ f32x2 gelu_pk(f32x2 v) {
    const f32x2 av = __builtin_elementwise_abs(v), d = av * 0.2316418882f + 1.0f;
    f32x2 t; t.x = __builtin_amdgcn_rcpf(d.x); t.y = __builtin_amdgcn_rcpf(d.y);
    f32x2 q = t * 0.5307027145f + (-0.7265760135f); q = q * t + 0.7107068705f; q = q * t + (-0.142248368f); q = q * t + 0.127414796f; q = q * t;
    const f32x2 s = (v * v) * (-0.72134752044f);
    f32x2 e; e.x = __builtin_amdgcn_exp2f(s.x); e.y = __builtin_amdgcn_exp2f(s.y);
    const f32x2 m = v * (q * e), r = v - m;
    f32x2 o; o.x = v.x < 0.f ? m.x : r.x; o.y = v.y < 0.f ? m.y : r.y; return o;
}
struct EpiS5Main {
    static constexpr bool PERM = true;
    bf16_t* gl;
    __device__ __forceinline__ void operator()(const f32x4 (&acc)[2][2][4][2], const pg8::Unit& u, int wr, int wc, int fr, int fq) const {
        const int row0 = u.orow + wr * 64 + fr, col0 = wc * 32 + 8 * fq, g = u.aux;
#pragma unroll
        for (int ai = 0; ai < 2; ++ai)
#pragma unroll
            for (int m = 0; m < 4; ++m) { const int n = row0 + ai * 128 + m * 16;
#pragma unroll
                for (int bj = 0; bj < 2; ++bj) { const int c = col0 + bj * 128, j = c >> 4, co = c & 15; const f32x4 v0 = acc[ai][bj][m][0], v1 = acc[ai][bj][m][1];
                    const f32x2 a = gelu_pk((f32x2){v0[0], v0[1]}), b = gelu_pk((f32x2){v0[2], v0[3]}), c2 = gelu_pk((f32x2){v1[0], v1[1]}), d2 = gelu_pk((f32x2){v1[2], v1[3]});
                    u32x4 w; w.x = pg8::cvt_pk_bf16(a.x, a.y); w.y = pg8::cvt_pk_bf16(b.x, b.y); w.z = pg8::cvt_pk_bf16(c2.x, c2.y); w.w = pg8::cvt_pk_bf16(d2.x, d2.y);
                    *(u32x4*)(gl + ((size_t)n * 16 + j) * S5W + g * 16 + co) = w; } }
    }
};
struct S5Order {
    const char* A; const char* Bm; int ldb, G, c;
    __device__ bool next(int i, pg8::Unit& u) const {
        const int L = i * G + c; if (L >= NG * 4) return false;
        const int g = L >> 2, pm = L & 3;
        u.a = A + ((size_t)g * 1024 + pm * 256) * 512 * 2; u.b = Bm + (size_t)g * 256 * ldb * 2; u.orow = pm * 256; u.ocol = 0; u.aux = g; return true;
    }
};
__device__ __forceinline__ void fp_s5estep(const Params& p, LAS unsigned char* lds, int G, int c) {
    S5Order S{(const char*)(p.ws + WS_AEXT), (const char*)p.out + OUT_EMAT, 256, G, c};
    EpiF32Out E{(float*)(p.ws + WS_HLOC), 256, (size_t)1024 * 256};
    pg8::gemm_phase(lds, 256, 512, 256, S, E);
}
__device__ __forceinline__ void fp_s5main(const Params& p, LAS unsigned char* lds, int G, int c) {
    S5Order S{(const char*)(p.ws + WS_AEXT), (const char*)p.out + OUT_MMAT, 512, G, c};
    EpiS5Main E{(bf16_t*)(p.ws + WS_GL)};
    pg8::gemm_phase(lds, 512, 512, 512, S, E);
}

__device__ __forceinline__ void fp_inproj(const Params& p, LAS unsigned char* lds) {
    pg8::DenseOrder S; S.init((const bf16_t*)(p.ws + WS_HB), D_, (const bf16_t*)((unsigned char*)p.out + OUT_WINT), D_, T_, NINP, gridDim.x, blockIdx.x);
    EpiInproj E{(bf16_t*)(p.ws + WS_QKVR), (bf16_t*)(p.ws + WS_ZB), (float*)((unsigned char*)p.out + OUT_BA), (bf16_t*)(p.ws + WS_AEXT)};
    pg8::gemm_phase(lds, D_, D_, D_, S, E);
}
__device__ __forceinline__ void fp_glu(const Params& p, LAS unsigned char* lds, int G, int c) {
    pg8::DenseOrder S; S.init((const bf16_t*)(p.ws + WS_GL), S5W, (const bf16_t*)((unsigned char*)p.out + OUT_WGLUT), S5W, T_, S5W, G, c);
    EpiGlu E{(const bf16_t*)(p.ws + WS_GL), p.in[I_B_GLU], (bf16_t*)(p.ws + WS_CAT), (float*)(p.ws + WS_SSQ)};
    pg8::gemm_phase(lds, S5W, S5W, S5W, S, E);
}
__device__ __forceinline__ void fp_outproj(const Params& p, LAS unsigned char* lds) {
    pg8::DenseOrder S; S.init((const bf16_t*)(p.ws + WS_CAT), D_, (const bf16_t*)(p.ws + WS_WOUTT), D_, T_, D_, gridDim.x, blockIdx.x);
    EpiResid E{p.in[I_X], nullptr, nullptr, D_, (bf16_t*)(p.ws + WS_XB), (float*)(p.ws + WS_SSQ) + T_};
    pg8::gemm_phase(lds, D_, D_, D_, S, E);
}
__device__ __forceinline__ void fp_kv(const Params& p, LAS unsigned char* lds) {
    {
        pg8::DenseOrder S; S.init((const bf16_t*)(p.ws + WS_MEMN), D_, (const bf16_t*)((unsigned char*)p.out + OUT_WKT), D_, B_ * MEM, D_, gridDim.x, (blockIdx.x + gridDim.x - 192) % gridDim.x);
        EpiBf16Out E{(bf16_t*)(p.ws + WS_KMEM), D_, 1.f, 0};
        pg8::gemm_phase(lds, D_, D_, D_, S, E);
    }
    {
        pg8::DenseOrder S; S.init((const bf16_t*)(p.ws + WS_MEMN), D_, (const bf16_t*)((unsigned char*)p.out + OUT_WVT), D_, B_ * MEM, D_, gridDim.x, (blockIdx.x + gridDim.x - 224) % gridDim.x);
        EpiBf16Out E{(bf16_t*)(p.ws + WS_VMEM), D_, 1.f, 0};
        pg8::gemm_phase(lds, D_, D_, D_, S, E);
    }
}
struct AttnPreOrder {
    const char* Kmem; const char* Vmem; const char* WqB; const char* WoT; int G, c;
    __device__ bool next(int i, pg8::Unit& u) const {
        const int L = i * G + c; if (L >= 256) return false;
        const int x = L & 3, h = (L >> 2) & 3, b = (L >> 4) & 7;
        if (L < 128) { u.a = Kmem + ((size_t)(b * MEM) * D_ + h * XD) * 2; u.b = WqB + ((size_t)(x * 256) * D_ + h * XD) * 2; u.orow = 0; u.ocol = x * 256; u.aux = b * 4 + h; }
        else { u.a = WoT + ((size_t)(x * 256) * D_ + h * XD) * 2; u.b = Vmem + ((size_t)(b * MEM) * D_ + h * XD) * 2; u.orow = x * 256; u.ocol = h * XD; u.aux = 64 + b; }
        return true;
    }
};
struct EpiAttnPre {
    static constexpr bool PERM = true;
    bf16_t* Mq; bf16_t* VWT;
    __device__ __forceinline__ void operator()(const f32x4 (&acc)[2][2][4][2], const pg8::Unit& u, int wr, int wc, int fr, int fq) const {
        bf16_t* base = (u.aux < 64) ? Mq + (size_t)u.aux * MEM * D_ : VWT + (size_t)(u.aux - 64) * D_ * D_;
        const int row0 = u.orow + wr * 64 + fr, col0 = u.ocol + wc * 32 + 8 * fq;
#pragma unroll
        for (int ai = 0; ai < 2; ++ai)
#pragma unroll
            for (int m = 0; m < 4; ++m) { bf16_t* rowp = base + (size_t)(row0 + ai * 128 + m * 16) * D_ + col0;
#pragma unroll
                for (int bj = 0; bj < 2; ++bj) { const f32x4 v0 = acc[ai][bj][m][0], v1 = acc[ai][bj][m][1];
                    u32x4 w; w.x = pg8::cvt_pk_bf16(v0[0], v0[1]); w.y = pg8::cvt_pk_bf16(v0[2], v0[3]); w.z = pg8::cvt_pk_bf16(v1[0], v1[1]); w.w = pg8::cvt_pk_bf16(v1[2], v1[3]);
                    *(u32x4*)(rowp + bj * 128) = w; } }
    }
};
__device__ __forceinline__ void fp_attn_pre(const Params& p, LAS unsigned char* lds) {
    AttnPreOrder S{(const char*)(p.ws + WS_KMEM), (const char*)(p.ws + WS_VMEM), (const char*)(p.ws + WS_WQB), (const char*)(p.ws + WS_WOT), (int)gridDim.x, (int)blockIdx.x};
    EpiAttnPre E{(bf16_t*)(p.ws + WS_MQ), (bf16_t*)(p.ws + WS_VWT)};
    pg8::gemm_phase(lds, XD, D_, D_, S, E);
}
struct AttnSOrder {
    const char* Xb; const char* Mq; int G, c;
    __device__ bool next(int i, pg8::Unit& u) const {
        const int L = i * G + c; if (L >= B_ * XH * 8) return false;
        const int pm = L & 7, h = (L >> 3) & 3, b = L >> 5;
        u.a = Xb + (size_t)(b * S_ + pm * 256) * D_ * 2; u.b = Mq + (size_t)((b * 4 + h) * MEM) * D_ * 2; u.orow = b * S_ + pm * 256; u.ocol = h * XD; u.aux = 0; return true;
    }
};
struct AttnWoOrder {
    const char* Pm; const char* VWT; int G, c;
    __device__ bool next(int i, pg8::Unit& u) const {
        const int L = i * G + c; if (L >= 256) return false;
        const int pn = L & 3, pm = (L >> 2) & 7, b = L >> 5;
        u.a = Pm + (size_t)(b * S_ + pm * 256) * D_ * 2; u.b = VWT + ((size_t)b * D_ + pn * 256) * D_ * 2; u.orow = b * S_ + pm * 256; u.ocol = pn * 256; u.aux = 0; return true;
    }
};
__device__ __forceinline__ void fp_attn_fused(const Params& p, LAS unsigned char* lds) {
    const int L = blockIdx.x; if (L >= B_ * XH * 8) return;
    {
        AttnSOrder S{(const char*)(p.ws + WS_XB), (const char*)(p.ws + WS_MQ), (int)gridDim.x, L};
        EpiBf16RowScale E{(bf16_t*)(p.ws + WS_PB), D_, 0.0625f, (const float*)(p.ws + WS_SSQ) + T_};
        pg8::gemm_phase(lds, D_, D_, D_, S, E);
    }
    {
        const int THR = ltid(); const int lane = THR & 63, wid = THR >> 6;
        const int pm = L & 7, h = (L >> 3) & 3, b = L >> 5;
        bf16_t* base = (bf16_t*)(p.ws + WS_PB) + (size_t)(b * S_ + pm * 256 + wid * 32 + (lane >> 4)) * D_ + h * XD + (lane & 15) * 16;
        u4_t ra[8], rb[8];
#pragma unroll
        for (int i = 0; i < 8; ++i) { ra[i] = *(const u4_t*)(base + (size_t)(4 * i) * D_); rb[i] = *(const u4_t*)(base + (size_t)(4 * i) * D_ + 8); }
#pragma unroll
        for (int i = 0; i < 8; ++i) {
            float v[16];
#pragma unroll
            for (int k = 0; k < 4; ++k) { v[2 * k] = bflo(ra[i][k]); v[2 * k + 1] = bfhi(ra[i][k]); v[8 + 2 * k] = bflo(rb[i][k]); v[9 + 2 * k] = bfhi(rb[i][k]); }
            float mx = v[0];
#pragma unroll
            for (int k = 1; k < 16; ++k) mx = fmaxf(mx, v[k]);
            mx = dpp_max16(mx);
            float sum = 0.f;
#pragma unroll
            for (int k = 0; k < 16; ++k) { v[k] = __expf(v[k] - mx); sum += v[k]; }
            const float inv = 1.f / dpp_sum16(sum);
            u4_t wa, wb;
#pragma unroll
            for (int k = 0; k < 4; ++k) { wa[k] = pkbf(v[2 * k] * inv, v[2 * k + 1] * inv); wb[k] = pkbf(v[8 + 2 * k] * inv, v[9 + 2 * k] * inv); }
            *(u4_t*)(base + (size_t)(4 * i) * D_) = wa; *(u4_t*)(base + (size_t)(4 * i) * D_ + 8) = wb; }
    }
}
__device__ __forceinline__ void fp_woproj(const Params& p, LAS unsigned char* lds) {
    AttnWoOrder S{(const char*)(p.ws + WS_PB), (const char*)(p.ws + WS_VWT), (int)gridDim.x, (int)blockIdx.x};
    EpiResid E{nullptr, (const bf16_t*)(p.ws + WS_XB), nullptr, D_, (bf16_t*)(p.ws + WS_XB), nullptr};
    pg8::gemm_phase(lds, D_, D_, D_, S, E);
}
constexpr int LDS_TAB_OFF = pg8::STAGE_BYTES;
__device__ __forceinline__ void fp_moeup(const Params& p, LAS unsigned char* lds, float* smem) {
    int* tab = (int*)((unsigned char*)smem + LDS_TAB_OFF); moe_build_table(p, tab);
    MoeOrder<2> S{(const char*)(p.ws + WS_XS), (const char*)(p.ws + WS_WGUT), tab, D_, 512, D_, 128, (int)gridDim.x, (int)blockIdx.x};
    EpiMoeUp E{(bf16_t*)(p.ws + WS_HM)};
    pg8::gemm_phase(lds, D_, D_, D_, S, E);
}
__device__ __forceinline__ void fp_moedown(const Params& p, LAS unsigned char* lds, float* smem) {
    int* tab = (int*)((unsigned char*)smem + LDS_TAB_OFF); moe_build_table(p, tab);
    MoeOrder<4> S{(const char*)(p.ws + WS_HM), (const char*)(p.ws + WS_WDT), tab, DE, D_, DE, 256, (int)gridDim.x, (int)blockIdx.x};
    EpiBf16Out E{(bf16_t*)(p.ws + WS_XS), D_, 1.f, 0};
    pg8::gemm_phase(lds, DE, DE, DE, S, E);
}


#define XB_TMO      128
#define XB_XCNT(j)  (256  + 64 * (j))
#define XB_XSUB(j)  (1280 + 64 * (j))
#define XB_XGEN(j)  (2304 + 64 * (j))
#define XB_TOP      3328
#define XB_TOPGEN   3392
#define XCD_BAR_WORDS 3456
#define XB_SPIN_CAP (1u << 18)
__device__ __forceinline__ unsigned xb_ld(unsigned* p)              { return __hip_atomic_load(p, __ATOMIC_RELAXED, __HIP_MEMORY_SCOPE_AGENT); }
__device__ __forceinline__ unsigned xb_add(unsigned* p, unsigned v) { return __hip_atomic_fetch_add(p, v, __ATOMIC_RELAXED, __HIP_MEMORY_SCOPE_AGENT); }
__device__ __forceinline__ unsigned xb_xcc_id() { return (unsigned)__builtin_amdgcn_s_getreg((3 << 11) | 20) & 0xFu; }
#define XB_SPIN(cond, bar) do { unsigned _sp = 0; while (cond) { __builtin_amdgcn_s_sleep(1); \
    if ((++_sp & 255u) == 0u) { if (xb_ld(&(bar)[XB_TMO])) break; if (_sp > XB_SPIN_CAP) { atomicAdd(&(bar)[XB_TMO], 1u); break; } } } } while (0)
struct XcdBarrier { unsigned* bar; unsigned x; volatile LAS unsigned* st; unsigned G; };
__device__ __forceinline__ XcdBarrier xcd_barrier_post(unsigned* bar, volatile LAS unsigned* st, unsigned G) {
    XcdBarrier b; b.bar = bar; b.x = xb_xcc_id(); b.st = st; b.G = G;
    if (threadIdx.x == 0) (void)xb_add(&bar[XB_XCNT(b.x)], 1u);
    return b;
}
__device__ __forceinline__ void xcd_barrier_complete(unsigned* bar, unsigned x, const unsigned G, unsigned& nloc, unsigned& nx) {
    unsigned sum, cnt, mine, sp = 0u;
    for (;;) {
        sum = 0u; cnt = 0u; mine = 0u;
#pragma unroll
        for (unsigned j = 0; j < 16; ++j) { const unsigned c = xb_ld(&bar[XB_XCNT(j)]); sum += c; cnt += (c > 0u) ? 1u : 0u; mine = (j == x) ? c : mine; }
        if (sum == G) break;
        __builtin_amdgcn_s_sleep(1);
        if ((++sp & 255u) == 0u) { if (xb_ld(&bar[XB_TMO])) break; if (sp > XB_SPIN_CAP) { atomicAdd(&bar[XB_TMO], 1u); break; } }
    }
    nloc = mine > 0u ? mine : 1u; nx = cnt > 0u ? cnt : 1u;
}
__device__ __forceinline__ void xcd_barrier(const XcdBarrier& b) {
    asm volatile("s_waitcnt vmcnt(0)" ::: "memory");
    __syncthreads();
    if (threadIdx.x == 0) {
        unsigned* bar = b.bar;
        __builtin_amdgcn_s_waitcnt(0);
        unsigned nloc = b.st[0], nx = b.st[1];
        if (nloc == 0u) { xcd_barrier_complete(bar, b.x, b.G, nloc, nx); b.st[0] = nloc; b.st[1] = nx; }
        const unsigned old = xb_add(&bar[XB_XSUB(b.x)], 1u);
        const unsigned gen = old / nloc;
        if (old + 1u == (gen + 1u) * nloc) {
            __builtin_amdgcn_fence(__ATOMIC_RELEASE, "agent");
            asm volatile("s_waitcnt vmcnt(0)" ::: "memory");
            const unsigned og = xb_add(&bar[XB_TOP], 1u);
            const unsigned tg = og / nx;
            if (og + 1u == (tg + 1u) * nx) xb_add(&bar[XB_TOPGEN], 1u);
            else XB_SPIN(xb_ld(&bar[XB_TOPGEN]) == tg, bar);
            __builtin_amdgcn_fence(__ATOMIC_ACQUIRE, "agent");
            xb_add(&bar[XB_XGEN(b.x)], 1u);
            asm volatile("s_waitcnt vmcnt(0)" ::: "memory");
        } else {
            XB_SPIN(xb_ld(&bar[XB_XGEN(b.x)]) == gen, bar);
            __builtin_amdgcn_fence(__ATOMIC_ACQUIRE, "agent");
            asm volatile("s_waitcnt vmcnt(0)" ::: "memory");
        }
    }
    __syncthreads();
}

constexpr int LDS_BYTES = 147456;
constexpr int LDS_BARST_OFF = LDS_BYTES - 16;

__global__ void __launch_bounds__(NT, 2) mega_fwd(Params p) {
    __shared__ __attribute__((aligned(16))) unsigned char lds_raw[LDS_BYTES];
    float* smem = (float*)lds_raw; LAS unsigned char* lds = (LAS unsigned char*)lds_raw;
    cg::grid_group grid = cg::this_grid();
    if (threadIdx.x < 4) ((LAS unsigned*)(lds + LDS_BARST_OFF))[threadIdx.x] = 0u;
    __syncthreads();
    const XcdBarrier bar = xcd_barrier_post((unsigned*)(p.ws + WS_BAR), (volatile LAS unsigned*)(lds + LDS_BARST_OFF), gridDim.x);
#define GSYNC() xcd_barrier(bar)
    constexpr int GDNB_BLOCKS = B_ * NH * 2 * 2; const int s5G = (int)gridDim.x - GDNB_BLOCKS, s5c = (int)blockIdx.x - GDNB_BLOCKS;
    XcdBarrier bar2 = bar;
    if (s5c >= 0) bar2 = xcd_barrier_post((unsigned*)(p.ws + WS_BAR) + 4096, (volatile LAS unsigned*)(lds + LDS_BARST_OFF) + 2, (unsigned)s5G);
    if (p.ws == nullptr) grid.sync();
    ph_norm1(p, smem); ph_memnorm(p, smem); ph_prep0(p, smem); ph_s5mat(p, smem);  GSYNC();
    fp_inproj(p, lds); fp_kv(p, lds);  GSYNC();
    ph_prepa(p, smem); __syncthreads(); ph_gdna(p, smem);    GSYNC();
    if (s5c < 0) ph_gdnb(p, smem);
    else {
        for (int L = s5c; L < NG * 4; L += s5G) { fp_s5estep(p, lds, NG * 4, L); s5carry_unit(p, L >> 2, L & 3); fp_s5main(p, lds, NG * 4, L); }
        xcd_barrier(bar2); fp_glu(p, lds, s5G, s5c); }
    GSYNC();
    ph_gdncomb(p, smem); ph_prep1(p, smem); __syncthreads(); fp_attn_pre(p, lds); GSYNC();
    fp_outproj(p, lds); ph_prep2(p, smem); GSYNC();
    fp_attn_fused(p, lds); GSYNC();
    fp_woproj(p, lds);   GSYNC();
    ph_router(p, smem);  GSYNC();
    fp_moeup(p, lds, smem);   GSYNC();
    fp_moedown(p, lds, smem); GSYNC();
    ph_final(p, smem);
}

extern "C" void kernel_launch(void* const* d_in, const int* in_sizes, int n_in, void* d_out, int out_size, void* d_ws, size_t ws_size, hipStream_t stream) {
    if (n_in != N_IN || out_size != T_ * D_ || ws_size < 256 * MiB) { fprintf(stderr, "kernel_launch: unexpected shapes n_in=%d out=%d ws=%zu\n", n_in, out_size, ws_size); return; }
    static int grid_blocks = 0;
    if (!grid_blocks) {
        int dev = 0, cus = 0, per_cu = 0;
        (void)hipGetDevice(&dev);
        (void)hipDeviceGetAttribute(&cus, hipDeviceAttributeMultiprocessorCount, dev);
        (void)hipOccupancyMaxActiveBlocksPerMultiprocessor(&per_cu, mega_fwd, NT, 0);
        if (per_cu < 1) { fprintf(stderr, "kernel_launch: occupancy query says %d blocks/CU\n", per_cu); per_cu = 1; }
        grid_blocks = cus;
    }
    Params p{};
    for (int i = 0; i < N_IN; ++i) p.in[i] = (const float*)d_in[i];
    p.out = (float*)d_out; p.ws = (unsigned char*)d_ws;
    (void)hipMemsetAsync((unsigned char*)d_ws + WS_BAR, 0, (4096 + XCD_BAR_WORDS) * 4, stream);
    void* args[] = {&p};
    hipError_t e = hipLaunchCooperativeKernel((void*)mega_fwd, dim3(grid_blocks), dim3(NT), args, 0, stream);
    if (e != hipSuccess) fprintf(stderr, "cooperative launch failed: %s (grid %d)\n", hipGetErrorString(e), grid_blocks);
}
```

```cpp
#include <hip/hip_runtime.h>
#include <hip/hip_cooperative_groups.h>
namespace cg = cooperative_groups;
#include <cstdio>
#include <cstdint>
#include <type_traits>

typedef unsigned short bf16_t;
__device__ __forceinline__ float bf2f(bf16_t v) { return __uint_as_float(((unsigned)v) << 16); }
typedef __bf16 bf16v2e_t __attribute__((ext_vector_type(2)));
typedef float f32v2e_t __attribute__((ext_vector_type(2)));
__device__ __forceinline__ bf16_t f2bf(float f) { const f32v2e_t v = {f, 0.f}; const bf16v2e_t h = __builtin_convertvector(v, bf16v2e_t); return (bf16_t)(__builtin_bit_cast(unsigned, h) & 0xffffu); }

constexpr int B_ = 8, S_ = 2048, T_ = B_ * S_, D_ = 1024, DIN = 2576;
constexpr int S5W = 512, NG = 32, NP = 64, GDW = 512, NH = 4, HD = 128, MEM = 256;
constexpr int XH = 4, XD = 256, NE = 32, DE = 256;
constexpr float RMS_EPS = 1e-6f, L2_EPS = 1e-6f;
constexpr int NT = 512, NW = NT / 64;

struct Params {
    const float* in[48];
    float* out;
    unsigned char* ws;
};
enum { I_X = 0, I_MEM, I_NORM_MIX, I_W_IN, I_W_OUT,
       I_LAM_RE_F, I_LAM_IM_F, I_LOG_STEP_F, I_B_RE_F, I_B_IM_F, I_C_RE_F, I_C_IM_F,
       I_LAM_RE_B, I_LAM_IM_B, I_LOG_STEP_B, I_B_RE_B, I_B_IM_B, I_C_RE_B, I_C_IM_B,
       I_S5_D, I_W_GLU, I_B_GLU, I_S5_NORM,
       I_CONV, I_ALOG_F, I_DTB_F, I_ALOG_B, I_DTB_B, I_GDN_NORM,
       I_NORM_XA, I_NORM_MEM, I_WQ, I_WK, I_WV, I_WO,
       I_NORM_MOE, I_RG_W, I_RG_B, I_RE_W, I_RE_B, I_WGATE, I_WUP, I_WDOWN, I_NORM_FINAL, N_IN };

constexpr size_t MiB = 1u << 20;
constexpr size_t WS_HB   = 16 * MiB;
constexpr size_t WS_GL   = 0;
constexpr size_t WS_QKVR = 192 * MiB;
constexpr size_t WS_ZB   = 48 * MiB;
constexpr size_t WS_QKVC = 112 * MiB;
constexpr size_t WS_YF   = 160 * MiB;
constexpr size_t WS_CAT  = 224 * MiB;
constexpr size_t OUT_BA = 0;
constexpr size_t OUT_GB = 1 * MiB;
constexpr size_t OUT_WINT = 4 * MiB;
constexpr size_t OUT_WGLUT = 10 * MiB;
constexpr int QKV_LD = 1536, NINP = 2816;
constexpr size_t WS_BAR  = 111 * MiB + 768 * 1024;
constexpr size_t WS_AEXT = 160 * MiB;
constexpr size_t WS_HLOC = 192 * MiB;
constexpr size_t OUT_MMAT = 12 * MiB;
constexpr size_t OUT_EMAT = 20 * MiB;
constexpr int S5L = 16, S5NC = S_ / S5L;
constexpr size_t WS_XB   = 0;
constexpr size_t WS_QB   = 32 * MiB;
constexpr size_t WS_PB   = 64 * MiB;
constexpr size_t WS_OB   = 112 * MiB;
constexpr size_t WS_ROUTE = 154 * MiB;
constexpr size_t WS_WRT  = 156 * MiB;
constexpr size_t WS_CNT  = 155 * MiB;
constexpr size_t WS_WOUTT = 144 * MiB;
constexpr size_t WS_WQB  = 104 * MiB;
constexpr size_t WS_WOT  = 106 * MiB;
constexpr size_t WS_MQ   = 160 * MiB;
constexpr size_t WS_VWT  = 128 * MiB;
constexpr size_t WS_KMEM = 96 * MiB;
constexpr size_t WS_VMEM = 100 * MiB;
constexpr size_t WS_MEMN = 104 * MiB;
constexpr size_t WS_SSQ  = 108 * MiB;
constexpr size_t OUT_WKT = 58 * MiB, OUT_WVT = 60 * MiB;
constexpr size_t WS_WGUT = 176 * MiB;
constexpr size_t WS_WDT  = 208 * MiB;
constexpr size_t WS_XS   = 32 * MiB;
constexpr size_t WS_HM   = 112 * MiB;
constexpr int MC_TOT = 0, MC_HIST = 8192;
constexpr int MAXRT = 159;

__device__ __forceinline__ int ltid() { int t = threadIdx.x; asm volatile("" : "+v"(t)); return t; }
__device__ __forceinline__ float dpp_max16(float v) {
    v = fmaxf(v, __int_as_float(__builtin_amdgcn_update_dpp(0, __float_as_int(v), 0xB1, 0xF, 0xF, true)));
    v = fmaxf(v, __int_as_float(__builtin_amdgcn_update_dpp(0, __float_as_int(v), 0x4E, 0xF, 0xF, true)));
    v = fmaxf(v, __int_as_float(__builtin_amdgcn_update_dpp(0, __float_as_int(v), 0x141, 0xF, 0xF, true)));
    v = fmaxf(v, __int_as_float(__builtin_amdgcn_update_dpp(0, __float_as_int(v), 0x140, 0xF, 0xF, true)));
    return v;
}
__device__ __forceinline__ float dpp_sum16(float v) {
    v += __int_as_float(__builtin_amdgcn_update_dpp(0, __float_as_int(v), 0xB1, 0xF, 0xF, true));
    v += __int_as_float(__builtin_amdgcn_update_dpp(0, __float_as_int(v), 0x4E, 0xF, 0xF, true));
    v += __int_as_float(__builtin_amdgcn_update_dpp(0, __float_as_int(v), 0x141, 0xF, 0xF, true));
    v += __int_as_float(__builtin_amdgcn_update_dpp(0, __float_as_int(v), 0x140, 0xF, 0xF, true));
    return v;
}
__device__ __forceinline__ float wave_sum(float v) {
    v += __int_as_float(__builtin_amdgcn_update_dpp(0, __float_as_int(v), 0xB1, 0xF, 0xF, true));
    v += __int_as_float(__builtin_amdgcn_update_dpp(0, __float_as_int(v), 0x4E, 0xF, 0xF, true));
    v += __int_as_float(__builtin_amdgcn_update_dpp(0, __float_as_int(v), 0x141, 0xF, 0xF, true));
    v += __int_as_float(__builtin_amdgcn_update_dpp(0, __float_as_int(v), 0x140, 0xF, 0xF, true));
    v += __int_as_float(__builtin_amdgcn_update_dpp(0, __float_as_int(v), 0x142, 0xA, 0xF, false));
    v += __int_as_float(__builtin_amdgcn_update_dpp(0, __float_as_int(v), 0x143, 0xC, 0xF, false));
    return __int_as_float(__builtin_amdgcn_readlane(__float_as_int(v), 63));
}
__device__ __forceinline__ float sigmoidf_(float x) { return __builtin_amdgcn_rcpf(1.f + __expf(-x)); }
__device__ __forceinline__ float siluf_(float x) { return x * sigmoidf_(x); }
__device__ __forceinline__ float softplusf_(float x) { return x > 20.f ? x : log1pf(__expf(x)); }
__device__ __forceinline__ float geluf_(float x) { return 0.5f * x * (1.f + erff(x * 0.70710678118654752f)); }

template <class TA> __device__ __forceinline__ float ldA(const TA* p);
template <> __device__ __forceinline__ float ldA<float>(const float* p) { return *p; }
template <> __device__ __forceinline__ float ldA<bf16_t>(const bf16_t* p) { return bf2f(*p); }

typedef float f4_t __attribute__((ext_vector_type(4)));
typedef unsigned u2_t __attribute__((ext_vector_type(2)));
typedef unsigned u4_t __attribute__((ext_vector_type(4)));
__device__ __forceinline__ unsigned pkbf(float lo, float hi);
__device__ __forceinline__ float bflo(unsigned u) { return __uint_as_float(u << 16); }
__device__ __forceinline__ float bfhi(unsigned u) { return __uint_as_float(u & 0xffff0000u); }
__device__ __forceinline__ void rmsnorm_rows_bf16(const float* X, const float* gain, bf16_t* Y, int rows, int width) {
    const int THR = ltid();
    const int lane = THR & 63, gw = blockIdx.x * NW + (THR >> 6), nw = gridDim.x * NW;
    f4_t g[4];
#pragma unroll
    for (int j = 0; j < 4; ++j) g[j] = ((const f4_t*)gain)[lane + 64 * j];
    for (int r0 = gw * 4; r0 < rows; r0 += nw * 4) {
        f4_t v[4][4];
#pragma unroll
        for (int r = 0; r < 4; ++r)
#pragma unroll
            for (int j = 0; j < 4; ++j) v[r][j] = ((const f4_t*)(X + (size_t)(r0 + r) * 1024))[lane + 64 * j];
#pragma unroll
        for (int r = 0; r < 4; ++r) { float ss = 0.f;
#pragma unroll
            for (int j = 0; j < 4; ++j) ss += v[r][j].x * v[r][j].x + v[r][j].y * v[r][j].y + v[r][j].z * v[r][j].z + v[r][j].w * v[r][j].w;
            const float rs = rsqrtf(wave_sum(ss) * (1.f / 1024.f) + RMS_EPS);
#pragma unroll
            for (int j = 0; j < 4; ++j) { const f4_t o = v[r][j] * rs * g[j]; u2_t w; w.x = pkbf(o.x, o.y); w.y = pkbf(o.z, o.w); ((u2_t*)(Y + (size_t)(r0 + r) * 1024))[lane + 64 * j] = w; } }
    }
}

namespace pg8 {
#define PG8_LAS __attribute__((address_space(3)))
typedef short bf16x8 __attribute__((ext_vector_type(8)));
typedef float f32x4 __attribute__((ext_vector_type(4)));
typedef unsigned u32x4 __attribute__((ext_vector_type(4)));
typedef unsigned u32x2 __attribute__((ext_vector_type(2)));
constexpr int BM = 256, BK = 64, HALF = 128, HTB = HALF * BK * 2, STAGE_BYTES = 8 * HTB;
__device__ __forceinline__ int lds_byte(int r, int c) { const int st = (r >> 4) * 2 + (c >> 5), rr = r & 15, cc = c & 31, ob = rr * 64 + cc * 2; return st * 1024 + (ob ^ (((ob >> 9) & 1) << 5)); }
__device__ __forceinline__ void stage_rc(int b, int& R, int& C) { const int st = b / 1024, sb = b % 1024, swz = sb ^ (((sb >> 9) & 1) << 5); R = (st >> 1) * 16 + swz / 64; C = (st & 1) * 32 + (swz % 64) / 2; }
__device__ __forceinline__ int perm32(int rho) { const int n = rho >> 4, i = rho & 15; return 8 * (i >> 2) + 4 * n + (i & 3); }
typedef __bf16 bf16v2_t __attribute__((ext_vector_type(2)));
typedef float f32v2_t __attribute__((ext_vector_type(2)));
__device__ __forceinline__ unsigned cvt_pk_bf16(float lo, float hi) { const f32v2_t f = {lo, hi}; const bf16v2_t h = __builtin_convertvector(f, bf16v2_t); return __builtin_bit_cast(unsigned, h); }
}
__device__ __forceinline__ unsigned pkbf(float lo, float hi) { return pg8::cvt_pk_bf16(lo, hi); }
namespace pg8 {

struct Unit { const char* a; const char* b; int orow, ocol, aux; };
struct DenseOrder {
    const char* A; const char* Bt; int lda, ldb, nM, nN, nwg, G, c;
    __device__ void init(const bf16_t* A_, int lda_, const bf16_t* Bt_, int ldb_, int M, int N, int G_, int c_) { A = (const char*)A_; Bt = (const char*)Bt_; lda = lda_; ldb = ldb_; nM = M / BM; nN = N / BM; nwg = nM * nN; G = G_; c = c_; }
    __device__ bool next(int i, Unit& u) const {
        const long L = (long)i * G + c; if (L >= nwg) return false;
        int wgid = (int)L; { const int q = nwg / 8, r = nwg % 8, xcd = wgid % 8, off = wgid / 8; wgid = (xcd < r ? xcd * (q + 1) : r * (q + 1) + (xcd - r) * q) + off; }
        const int nig = 8 * nN, gid = wgid / nig, fm = gid * 8, gsz = (nM - fm) < 8 ? (nM - fm) : 8;
        const int pm = fm + ((wgid % nig) % gsz), pn = (wgid % nig) / gsz;
        u.a = A + (size_t)pm * BM * lda * 2; u.b = Bt + (size_t)pn * BM * ldb * 2; u.orow = pm * BM; u.ocol = pn * BM; u.aux = pn; return true;
    }
};

template <class Epi, class Sched>
__device__ __forceinline__ void gemm_phase(PG8_LAS unsigned char* lds, const int K, const int lda, const int ldb, const Sched& S, const Epi& E) {
    int tid_ = threadIdx.x; asm volatile("" : "+v"(tid_));
    const int tid = tid_, wid = __builtin_amdgcn_readfirstlane(tid >> 6), lane = tid & 63, wr = wid >> 2, wc = wid & 3, fr = lane & 15, fq = lane >> 4;
    const int nt = K / BK;
    unsigned voffA[2], voffB[2];
#pragma unroll
    for (int i = 0; i < 2; ++i) { int R, C; stage_rc(tid * 16 + i * 8192, R, C); const int Rb = Epi::PERM ? ((R & ~31) + perm32(R & 31)) : R;
        voffA[i] = (unsigned)(R * lda + C) * 2u; voffB[i] = (unsigned)(Rb * ldb + C) * 2u; }
    const size_t kstep = (size_t)(BK * 2);
    const size_t hstepA = (size_t)HALF * lda * 2, hstepB = (size_t)HALF * ldb * 2;
    const unsigned ldsw = (unsigned)wid * 1024u;
    const int aoff = lds_byte(wr * 64 + fr, fq * 8), boff = lds_byte(wc * 32 + fr, fq * 8);
#define PG8_SA(b, h) (((b) * 2 + (h)) * HTB)
#define PG8_SB(b, h) ((4 + (b) * 2 + (h)) * HTB)
#define PG8_STAGE(bufoff, gbase, voff) do { _Pragma("unroll") for (int _i = 0; _i < 2; ++_i) \
        __builtin_amdgcn_global_load_lds((const unsigned*)((const char*)(gbase) + (voff)[_i]), (PG8_LAS unsigned*)(lds + (bufoff) + ldsw + _i * 8192), 16, 0, 0); } while (0)
#define PG8_LDA(dst, b, h) do { _Pragma("unroll") for (int m = 0; m < 4; ++m) _Pragma("unroll") for (int k = 0; k < 2; ++k) dst[m][k] = *(const PG8_LAS bf16x8*)(lds + PG8_SA(b, h) + aoff + m * 2048 + k * 1024); } while (0)
#define PG8_LDB(dst, b, h) do { _Pragma("unroll") for (int n = 0; n < 2; ++n) _Pragma("unroll") for (int k = 0; k < 2; ++k) dst[n][k] = *(const PG8_LAS bf16x8*)(lds + PG8_SB(b, h) + boff + n * 2048 + k * 1024); } while (0)
#define PG8_MMA(ai, bj, At, Bt) do { __builtin_amdgcn_s_setprio(1); _Pragma("unroll") for (int m = 0; m < 4; ++m) _Pragma("unroll") for (int n = 0; n < 2; ++n) _Pragma("unroll") for (int k = 0; k < 2; ++k) \
        acc[ai][bj][m][n] = __builtin_amdgcn_mfma_f32_16x16x32_bf16(Bt[n][k], At[m][k], acc[ai][bj][m][n], 0, 0, 0); __builtin_amdgcn_s_setprio(0); } while (0)
#define PG8_WAIT_V(n) asm volatile("s_waitcnt vmcnt(" #n ")" ::: "memory")
#define PG8_WAIT_L(n) asm volatile("s_waitcnt lgkmcnt(" #n ")" ::: "memory")
#define PG8_BAR __builtin_amdgcn_s_barrier()
#define PG8_SCHED __builtin_amdgcn_sched_barrier(0)
    Unit cur, nxt; int ui = 0;
    if (!S.next(0, cur)) return;
    f32x4 acc[2][2][4][2];
#pragma unroll
    for (int a = 0; a < 2; ++a)
#pragma unroll
        for (int b = 0; b < 2; ++b)
#pragma unroll
            for (int m = 0; m < 4; ++m)
#pragma unroll
                for (int n = 0; n < 2; ++n) acc[a][b][m][n] = (f32x4){0.f, 0.f, 0.f, 0.f};
    bf16x8 At[4][2], B0[2][2], B1[2][2];
    const char* cA = cur.a; const char* cB = cur.b;
    PG8_STAGE(PG8_SB(0, 0), cB, voffB); PG8_STAGE(PG8_SA(0, 0), cA, voffA); PG8_STAGE(PG8_SB(0, 1), cB + hstepB, voffB); PG8_STAGE(PG8_SA(0, 1), cA + hstepA, voffA);
    if (wr == 1) PG8_BAR;
    PG8_WAIT_V(4); PG8_BAR;
    PG8_STAGE(PG8_SB(1, 0), cB + kstep, voffB); PG8_STAGE(PG8_SA(1, 0), cA + kstep, voffA); PG8_STAGE(PG8_SB(1, 1), cB + hstepB + kstep, voffB);
    PG8_WAIT_V(6); PG8_BAR;
    for (;;) {
        const bool has_next = S.next(ui + 1, nxt);
        const char* nA = has_next ? nxt.a : cA; const char* nB = has_next ? nxt.b : cB;
        for (int t = 0; t < nt; t += 2) {
            const bool last = (t == nt - 2);
            const char* a1 = cA + (size_t)(t + 1) * kstep;
            const char* a2 = last ? nA : cA + (size_t)(t + 2) * kstep; const char* b2 = last ? nB : cB + (size_t)(t + 2) * kstep;
            const char* a3 = a2 + kstep; const char* b3 = b2 + kstep;
            PG8_LDB(B0, 0, 0); PG8_SCHED; PG8_LDA(At, 0, 0); PG8_STAGE(PG8_SA(1, 1), a1 + hstepA, voffA);
            PG8_WAIT_L(8); PG8_BAR; PG8_WAIT_L(0); PG8_MMA(0, 0, At, B0); PG8_BAR; PG8_SCHED;
            PG8_LDB(B1, 0, 1); PG8_STAGE(PG8_SB(0, 0), b2, voffB);
            PG8_BAR; PG8_WAIT_L(0); PG8_MMA(0, 1, At, B1); PG8_BAR;
            PG8_LDA(At, 0, 1); PG8_STAGE(PG8_SA(0, 0), a2, voffA);
            PG8_BAR; PG8_WAIT_L(0); PG8_MMA(1, 0, At, B0); PG8_BAR; PG8_SCHED;
            PG8_STAGE(PG8_SB(0, 1), b2 + hstepB, voffB);
            PG8_WAIT_V(6); PG8_BAR; PG8_MMA(1, 1, At, B1); PG8_BAR;
            PG8_LDB(B0, 1, 0); PG8_SCHED; PG8_LDA(At, 1, 0); PG8_STAGE(PG8_SA(0, 1), a2 + hstepA, voffA);
            PG8_WAIT_L(8); PG8_BAR; PG8_WAIT_L(0); PG8_MMA(0, 0, At, B0); PG8_BAR; PG8_SCHED;
            PG8_LDB(B1, 1, 1); PG8_STAGE(PG8_SB(1, 0), b3, voffB);
            PG8_BAR; PG8_WAIT_L(0); PG8_MMA(0, 1, At, B1); PG8_BAR;
            PG8_LDA(At, 1, 1); PG8_STAGE(PG8_SA(1, 0), a3, voffA);
            PG8_BAR; PG8_WAIT_L(0); PG8_MMA(1, 0, At, B0); PG8_BAR; PG8_SCHED;
            PG8_STAGE(PG8_SB(1, 1), b3 + hstepB, voffB);
            PG8_WAIT_V(6); PG8_BAR; PG8_MMA(1, 1, At, B1); PG8_BAR;
        }
        E(acc, cur, wr, wc, fr, fq);
        if (!has_next) break;
#pragma unroll
        for (int a = 0; a < 2; ++a)
#pragma unroll
            for (int b = 0; b < 2; ++b)
#pragma unroll
                for (int m = 0; m < 4; ++m)
#pragma unroll
                    for (int n = 0; n < 2; ++n) acc[a][b][m][n] = (f32x4){0.f, 0.f, 0.f, 0.f};
        cur = nxt; cA = nA; cB = nB; ++ui;
    }
    PG8_WAIT_V(0);
    if (wr == 0) PG8_BAR;
    PG8_BAR;
#undef PG8_SA
#undef PG8_SB
#undef PG8_STAGE
#undef PG8_LDA
#undef PG8_LDB
#undef PG8_MMA
#undef PG8_WAIT_V
#undef PG8_WAIT_L
#undef PG8_BAR
#undef PG8_SCHED
}
}
typedef pg8::f32x4 f32x4; typedef pg8::u32x4 u32x4;
#define LAS __attribute__((address_space(3)))

#define LAS __attribute__((address_space(3)))

__device__ __forceinline__ void ph_norm1(const Params& p, float* smem) {
    rmsnorm_rows_bf16(p.in[I_X], p.in[I_NORM_MIX], (bf16_t*)(p.ws + WS_HB), T_, D_);
}
__device__ __forceinline__ void ph_memnorm(const Params& p, float* smem) {
    rmsnorm_rows_bf16(p.in[I_MEM], p.in[I_NORM_MEM], (bf16_t*)(p.ws + WS_MEMN), B_ * MEM, D_);
}
__device__ __forceinline__ void ph_s5mat(const Params& p, float* smem) {
    const int THR = ltid();
    bf16_t* Mm = (bf16_t*)((unsigned char*)p.out + OUT_MMAT); bf16_t* Em = (bf16_t*)((unsigned char*)p.out + OUT_EMAT);
    float* lp = smem;
    float* cf = smem + 640;
    float* Bb = smem + 896;
    float* kk = smem + 896 + 4096;
    __syncthreads();
    for (int item = blockIdx.x; item < NG * S5L; item += gridDim.x) {
        const int g = item >> 4, j = item & 15;
        if (THR < 320) {
            const int which = THR >> 6, pp = THR & 63; const int dir = (which == 1 || which == 4) ? 1 : 0;
            const int o = dir ? (I_LAM_RE_B - I_LAM_RE_F) : 0;
            const float lre = p.in[I_LAM_RE_F + o][g * NP + pp], lim = p.in[I_LAM_IM_F + o][g * NP + pp], step = __expf(p.in[I_LOG_STEP_F + o][g]);
            const float pw = (float)(which == 0 ? j : which == 1 ? j : which == 2 ? (15 - j) : which == 3 ? (j + 1) : (16 - j));
            const float er = expf(lre * step * pw); float sn, cs; sincosf(lim * step * pw, &sn, &cs);
            lp[(which * 64 + pp) * 2] = er * cs; lp[(which * 64 + pp) * 2 + 1] = er * sn;
            if (which < 2) {
                const float e1 = expf(lre * step); float s1, c1; sincosf(lim * step, &s1, &c1);
                const float nr = e1 * c1 - 1.f, ni = e1 * s1, den = lre * lre + lim * lim;
                cf[(dir * 64 + pp) * 2] = (nr * lre + ni * lim) / den; cf[(dir * 64 + pp) * 2 + 1] = (ni * lre - nr * lim) / den;
            }
        }
        __syncthreads();
        for (int e = THR; e < 2048; e += NT) {
            const int dir = e >> 10, pp = (e >> 4) & 63, ci = e & 15; const int o = dir ? (I_LAM_RE_B - I_LAM_RE_F) : 0;
            const float br = p.in[I_B_RE_F + o][(g * NP + pp) * 16 + ci], bi = p.in[I_B_IM_F + o][(g * NP + pp) * 16 + ci];
            const float cr = cf[(dir * 64 + pp) * 2], ci_ = cf[(dir * 64 + pp) * 2 + 1];
            Bb[e * 2] = cr * br - ci_ * bi; Bb[e * 2 + 1] = cr * bi + ci_ * br;
        }
        __syncthreads();
        {
            const int dir = THR >> 8, co = (THR >> 4) & 15, ci = THR & 15; const int o = dir ? (I_LAM_RE_B - I_LAM_RE_F) : 0;
            const float* cre = p.in[I_C_RE_F + o] + (g * 16 + co) * NP; const float* cim = p.in[I_C_IM_F + o] + (g * 16 + co) * NP;
            float acc = 0.f;
            for (int pp = 0; pp < 64; ++pp) {
                const float lr = lp[(dir * 64 + pp) * 2], li = lp[(dir * 64 + pp) * 2 + 1], c_r = cre[pp], c_i = cim[pp];
                const float clr = c_r * lr - c_i * li, cli = c_r * li + c_i * lr;
                acc += clr * Bb[((dir * 64 + pp) * 16 + ci) * 2] - cli * Bb[((dir * 64 + pp) * 16 + ci) * 2 + 1];
            }
            kk[THR] = acc;
        }
        __syncthreads();
        {
            const int dir = THR >> 8, co = (THR >> 4) & 15, ci = THR & 15; bf16_t* Mg = Mm + (size_t)g * 256 * 512;
            if (j == 0) { if (dir == 0) { const bf16_t v = f2bf(kk[THR] + kk[256 + THR] + (co == ci ? p.in[I_S5_D][g * 16 + co] : 0.f));
                    for (int jj = 0; jj < 16; ++jj) Mg[(size_t)(jj * 16 + co) * 512 + jj * 16 + ci] = v; } }
            else { const bf16_t v = f2bf(kk[THR]);
                if (dir == 0) { for (int jj = j; jj < 16; ++jj) Mg[(size_t)(jj * 16 + co) * 512 + (jj - j) * 16 + ci] = v; }
                else { for (int jj = 0; jj + j < 16; ++jj) Mg[(size_t)(jj * 16 + co) * 512 + (jj + j) * 16 + ci] = v; } }
        }
        for (int e = THR; e < 2048; e += NT) {
            const int dir = e >> 10, co = (e >> 6) & 15, pp = e & 63; const int o = dir ? (I_LAM_RE_B - I_LAM_RE_F) : 0;
            const float c_r = p.in[I_C_RE_F + o][(g * 16 + co) * NP + pp], c_i = p.in[I_C_IM_F + o][(g * 16 + co) * NP + pp];
            const int w = dir ? 4 : 3; const float lr = lp[(w * 64 + pp) * 2], li = lp[(w * 64 + pp) * 2 + 1];
            bf16_t* row = Mm + ((size_t)g * 256 + j * 16 + co) * 512 + 256 + dir * 128;
            row[pp] = f2bf(c_r * lr - c_i * li); row[64 + pp] = f2bf(-(c_r * li + c_i * lr));
        }
        for (int e = THR; e < 2048; e += NT) {
            const int dir = e >> 10, pp = (e >> 4) & 63, ci = e & 15;
            const int w = dir ? 1 : 2; const float lr = lp[(w * 64 + pp) * 2], li = lp[(w * 64 + pp) * 2 + 1];
            const float br = Bb[e * 2], bi = Bb[e * 2 + 1];
            bf16_t* Eg = Em + (size_t)g * 256 * 256;
            Eg[(size_t)(dir * 128 + pp) * 256 + j * 16 + ci] = f2bf(lr * br - li * bi);
            Eg[(size_t)(dir * 128 + 64 + pp) * 256 + j * 16 + ci] = f2bf(lr * bi + li * br);
        }
        __syncthreads();
    }
}
__device__ __forceinline__ void s5carry_unit(const Params& p, int g, int pm) {
    const int THR = ltid();
    if (THR < 256) {
        const float* Hl = (const float*)(p.ws + WS_HLOC); bf16_t* Ax = (bf16_t*)(p.ws + WS_AEXT);
        const int pp = THR & 63, dir = (THR >> 6) & 1, b = 2 * pm + (THR >> 7); const int o = dir ? (I_LAM_RE_B - I_LAM_RE_F) : 0;
        const float lre = p.in[I_LAM_RE_F + o][g * NP + pp], lim = p.in[I_LAM_IM_F + o][g * NP + pp], step = __expf(p.in[I_LOG_STEP_F + o][g]);
        const float er = expf(lre * step * (float)S5L); float sn, cs; sincosf(lim * step * (float)S5L, &sn, &cs);
        const float lr = er * cs, li = er * sn;
        float hr = 0.f, hi = 0.f;
        const size_t rowbase = (size_t)g * 1024 + (size_t)b * S5NC;
        for (int s0 = 0; s0 < S5NC; s0 += 16) {
            float lr_[16], li_[16];
#pragma unroll
            for (int k = 0; k < 16; ++k) { const int c = dir ? (S5NC - 1 - (s0 + k)) : (s0 + k); const float* hl = Hl + (rowbase + c) * 256 + dir * 128; lr_[k] = hl[pp]; li_[k] = hl[64 + pp]; }
#pragma unroll
            for (int k = 0; k < 16; ++k) { const int c = dir ? (S5NC - 1 - (s0 + k)) : (s0 + k);
                bf16_t* ar = Ax + (rowbase + c) * 512 + 256 + dir * 128; ar[pp] = f2bf(hr); ar[64 + pp] = f2bf(hi);
                const float nr = lr * hr - li * hi + lr_[k], ni = lr * hi + li * hr + li_[k]; hr = nr; hi = ni; }
        }
    }
    asm volatile("s_waitcnt vmcnt(0)" ::: "memory");
    __syncthreads();
}
constexpr size_t WS_GW   = 16 * MiB;
constexpr size_t WS_GUT  = 64 * MiB;
constexpr size_t WS_GQK  = 128 * MiB;
constexpr size_t WS_GKT  = 144 * MiB;
constexpr size_t WS_GQN  = 112 * MiB;
constexpr size_t OUT_GSC = 24 * MiB;
constexpr size_t OUT_GO  = 26 * MiB;
typedef short bf16x4 __attribute__((ext_vector_type(4)));
typedef pg8::bf16x8 bf16x8;
__device__ __forceinline__ bf16x8 cat44(bf16x4 lo, bf16x4 hi) { return __builtin_shufflevector(lo, hi, 0, 1, 2, 3, 4, 5, 6, 7); }
__device__ __forceinline__ bf16x4 pack4(float a, float b, float c, float d) { union { unsigned u[2]; bf16x4 v; } x; x.u[0] = pg8::cvt_pk_bf16(a, b); x.u[1] = pg8::cvt_pk_bf16(c, d); return x.v; }

__host__ __device__ constexpr int gdna_pieces_before(int i) { return i <= 16 ? i - 1 : i <= 32 ? 16 + 2 * (i - 17) : i <= 48 ? 48 + 3 * (i - 33) : 96 + 4 * (i - 49); }
__device__ __forceinline__ void ph_gdna(const Params& p, float* smem) {
    LAS unsigned char* L = (LAS unsigned char*)smem;
    constexpr int KS = 0, QS = 17408, VS = 34816, KT = 52224, VT = 70656, KK = 89088, QKR = 105728, SC = 122368, TB = 124416;
    constexpr int AF = KS, AB = QS, TF = KK;
    LAS float* sc = (LAS float*)(L + SC);
    const bf16_t* proj = (const bf16_t*)(p.ws + WS_QKVR); const float* ba = (const float*)((unsigned char*)p.out + OUT_BA); const float* cw = p.in[I_CONV]; bf16_t* GQN = (bf16_t*)(p.ws + WS_GQN);
    bf16_t* GW = (bf16_t*)(p.ws + WS_GW); bf16_t* GUT = (bf16_t*)(p.ws + WS_GUT); bf16_t* GQK = (bf16_t*)(p.ws + WS_GQK); bf16_t* GKT = (bf16_t*)(p.ws + WS_GKT);
    float* GSC = (float*)((unsigned char*)p.out + OUT_GSC);
    auto loadraw = [&](unsigned (&rw)[3][12], float& bav, int it) {
        const int THR = ltid(); const int lane = THR & 63, wid = THR >> 6;
        const int n = it & 31, h = (it >> 5) & 3, b = it >> 7, t0 = b * S_ + n * 64, s0 = n * 64 + wid * 8;
#pragma unroll
        for (int mat = 0; mat < 3; ++mat)
#pragma unroll
            for (int r = 0; r < 12; ++r) { const int sq = s0 - 2 + r; unsigned raw = 0u;
                if (sq >= 0 && sq < S_) raw = *(const unsigned*)(proj + (size_t)(b * S_ + sq) * QKV_LD + mat * 512 + h * 128 + lane * 2);
                rw[mat][r] = raw; }
        bav = 0.f;
        if (THR < 256) { const int i = THR & 63, w = THR >> 6; bav = ba[(size_t)(t0 + i) * 16 + (w == 0 ? 8 + h : w == 1 ? 12 + h : w == 2 ? h : 4 + h)]; }
    };
    const bool fixed_h = (gridDim.x % 128u) == 0u;
    float cwa[3][5], cwb[3][5];
    auto loadtaps = [&](int h) {
        const int lane = ltid() & 63;
#pragma unroll
        for (int mat = 0; mat < 3; ++mat)
#pragma unroll
            for (int k = 0; k < 5; ++k) { const int col = mat * 512 + h * 128 + lane * 2; cwa[mat][k] = cw[k * 1536 + col]; cwb[mat][k] = cw[k * 1536 + col + 1]; }
    };
    loadtaps((blockIdx.x >> 5) & 3);
    unsigned rawc[3][12]; float bac = 0.f;
    if ((int)blockIdx.x < B_ * NH * 32) loadraw(rawc, bac, blockIdx.x);
    for (int item = blockIdx.x; item < B_ * NH * 32; item += gridDim.x) {
        const int THR = ltid();
        const int lane = THR & 63, wid = THR >> 6, l15 = lane & 15, q4 = lane >> 4;
        const int n = item & 31, h = (item >> 5) & 3, b = item >> 7, t0 = b * S_ + n * 64;
        if (!fixed_h) loadtaps(h);
        if (THR < 256) { const int i = THR & 63, w = THR >> 6; const float r = bac;
            sc[w * 64 + i] = (w < 2) ? -__expf(p.in[w ? I_ALOG_B : I_ALOG_F][h]) * softplusf_(r + p.in[w ? I_DTB_B : I_DTB_F][h]) : sigmoidf_(r); }
        {
#pragma unroll
            for (int mat = 0; mat < 3; ++mat) {
                float w0[5], w1[5], x0[12], x1[12];
#pragma unroll
                for (int k = 0; k < 5; ++k) { w0[k] = cwa[mat][k]; w1[k] = cwb[mat][k]; }
#pragma unroll
                for (int r = 0; r < 12; ++r) { const unsigned raw = rawc[mat][r]; x0[r] = __uint_as_float(raw << 16); x1[r] = __uint_as_float(raw & 0xffff0000u); }
#pragma unroll
                for (int tk = 0; tk < 8; ++tk) { float a0 = 0.f, a1 = 0.f;
#pragma unroll
                    for (int k = 0; k < 5; ++k) { a0 = fmaf(w0[k], x0[tk + k], a0); a1 = fmaf(w1[k], x1[tk + k], a1); }
                    float y0 = siluf_(a0), y1 = siluf_(a1);
                    if (mat < 2) { float scl = rsqrtf(wave_sum(y0 * y0 + y1 * y1) + L2_EPS); if (mat == 0) scl *= 0.08838834764831845f; y0 *= scl; y1 *= scl; }
                    *(LAS unsigned*)(L + (mat == 0 ? QS : mat == 1 ? KS : VS) + (wid * 8 + tk) * 272 + lane * 4) = pg8::cvt_pk_bf16(y0, y1); }
            }
        }
        unsigned rawn[3][12]; float ban = 0.f;
        if (item + (int)gridDim.x < B_ * NH * 32) loadraw(rawn, ban, item + gridDim.x);
        __syncthreads();
        if (wid < 2) { float v = sc[wid * 64 + (wid ? 63 - lane : lane)];
#pragma unroll
            for (int o = 1; o < 64; o <<= 1) { const float t = __shfl_up(v, o); if (lane >= o) v += t; }
            sc[256 + wid * 64 + (wid ? 63 - lane : lane)] = v; }
        {
#pragma unroll
            for (int i = 0; i < 2; ++i) { const int e = THR + i * NT, row = e >> 4, ch = e & 15; *(u32x4*)(GQN + (size_t)item * 8192 + row * 128 + ch * 8) = *(const LAS u32x4*)(L + QS + row * 272 + ch * 16); }
            const int tok0 = 4 * (THR & 15), c0 = 4 * (THR >> 4);
#pragma unroll
            for (int mat = 0; mat < 2; ++mat) { const int src = mat ? VS : KS, dst = mat ? VT : KT; bf16x4 r[4];
#pragma unroll
                for (int i = 0; i < 4; ++i) r[i] = *(const LAS bf16x4*)(L + src + (tok0 + i) * 272 + c0 * 2);
#pragma unroll
                for (int c = 0; c < 4; ++c) { bf16x4 o; o[0] = r[0][c]; o[1] = r[1][c]; o[2] = r[2][c]; o[3] = r[3][c]; *(LAS bf16x4*)(L + dst + (c0 + c) * 144 + tok0 * 2) = o; } }
        }
#pragma unroll
        for (int ti = 0; ti < 4; ++ti) { const int id = wid * 4 + ti, mat = id >> 4, it = (id >> 2) & 3, jt = id & 3; f32x4 acc = {0.f, 0.f, 0.f, 0.f};
#pragma unroll
            for (int s4 = 0; s4 < 4; ++s4) { const bf16x8 a = *(const LAS bf16x8*)(L + (mat ? QS : KS) + (16 * it + l15) * 272 + (32 * s4 + 8 * q4) * 2);
                const bf16x8 bb = *(const LAS bf16x8*)(L + KS + (16 * jt + l15) * 272 + (32 * s4 + 8 * q4) * 2);
                acc = __builtin_amdgcn_mfma_f32_16x16x32_bf16(a, bb, acc, 0, 0, 0); }
            LAS float* dst = (LAS float*)(L + (mat ? QKR : KK));
#pragma unroll
            for (int r = 0; r < 4; ++r) dst[(16 * it + 4 * q4 + r) * 65 + 16 * jt + l15] = acc[r]; }
        __syncthreads();
        {
            LAS float* kk = (LAS float*)(L + KK); LAS float* qr = (LAS float*)(L + QKR); LAS float* af = (LAS float*)(L + AF); LAS float* ab = (LAS float*)(L + AB);
            bf16_t* qkf = GQK + (size_t)(item * 2) * 4096; bf16_t* qkb = qkf + 4096;
            const int i = THR >> 3, j0 = (THR & 7) * 8;
            const float gfi = sc[256 + i], gbi = sc[320 + i], bfi = sc[128 + i], bbi = sc[192 + i];
            float vf[8], vb[8], qf[8], qb[8];
#pragma unroll
            for (int e = 0; e < 8; ++e) { const int j = j0 + e; const float kv = kk[i * 65 + j], qv = qr[i * 65 + j];
                const float df = __expf(fminf(gfi - sc[256 + j], 0.f)), db = __expf(fminf(gbi - sc[320 + j], 0.f));
                vf[e] = (j < i) ? bfi * kv * df : 0.f; vb[e] = (j > i) ? bbi * kv * db : 0.f; qf[e] = (j <= i) ? qv * df : 0.f; qb[e] = (j >= i) ? qv * db : 0.f; }
            *(LAS f32x4*)(af + i * 64 + j0) = (f32x4){vf[0], vf[1], vf[2], vf[3]}; *(LAS f32x4*)(af + i * 64 + j0 + 4) = (f32x4){vf[4], vf[5], vf[6], vf[7]};
            *(LAS f32x4*)(ab + (63 - i) * 64 + 56 - j0) = (f32x4){vb[7], vb[6], vb[5], vb[4]}; *(LAS f32x4*)(ab + (63 - i) * 64 + 60 - j0) = (f32x4){vb[3], vb[2], vb[1], vb[0]};
            u32x4 w1, w2; w1.x = pkbf(qf[0], qf[1]); w1.y = pkbf(qf[2], qf[3]); w1.z = pkbf(qf[4], qf[5]); w1.w = pkbf(qf[6], qf[7]);
            w2.x = pkbf(qb[0], qb[1]); w2.y = pkbf(qb[2], qb[3]); w2.z = pkbf(qb[4], qb[5]); w2.w = pkbf(qb[6], qb[7]);
            *(u32x4*)(qkf + i * 64 + j0) = w1; *(u32x4*)(qkb + i * 64 + j0) = w2;
        }
        __syncthreads();
        {
            const int sd = wid >> 2, r4 = lane & 3, c = 16 * (wid & 3) + (lane >> 2);
            const LAS float* A = (const LAS float*)(L + (sd ? AB : AF)) + r4;
            float to[16];
#pragma unroll
            for (int m = 0; m < 16; ++m) to[m] = 0.f;
            float ar3[3][16];
            ar3[1][0] = A[1 * 64];
            ar3[2][0] = A[2 * 64];
            if (r4 == 0) to[0] = (c == 0) ? 1.f : 0.f;
#define GDNA_ROW(i) { constexpr int NM = ((i) + 3) / 4, NP2 = ((i) + 5) / 4; \
                if ((i) + 2 < 64) { _Pragma("unroll") for (int m = 0; m < NP2; ++m) ar3[((i) + 2) % 3][m] = A[((i) + 2) * 64 + 4 * m]; } \
                float p0 = 0.f, p1 = 0.f; \
                _Pragma("unroll") for (int m = 0; m < NM; ++m) { if (m & 1) p1 = fmaf(ar3[(i) % 3][m], to[m], p1); else p0 = fmaf(ar3[(i) % 3][m], to[m], p0); } \
                float ps = p0 + p1; \
                ps += __int_as_float(__builtin_amdgcn_update_dpp(0, __float_as_int(ps), 0xB1, 0xF, 0xF, true));     \
                ps += __int_as_float(__builtin_amdgcn_update_dpp(0, __float_as_int(ps), 0x4E, 0xF, 0xF, true));     \
                const float val = ((c == (i)) ? 1.f : 0.f) - ps; \
                to[(i) >> 2] = (r4 == ((i) & 3)) ? val : to[(i) >> 2]; asm volatile("" ::: "memory"); }
#define GDNA_ROWS8(b) GDNA_ROW(b) GDNA_ROW(b + 1) GDNA_ROW(b + 2) GDNA_ROW(b + 3) GDNA_ROW(b + 4) GDNA_ROW(b + 5) GDNA_ROW(b + 6) GDNA_ROW(b + 7)
            GDNA_ROW(1) GDNA_ROW(2) GDNA_ROW(3) GDNA_ROW(4) GDNA_ROW(5) GDNA_ROW(6) GDNA_ROW(7)
            GDNA_ROWS8(8) GDNA_ROWS8(16) GDNA_ROWS8(24) GDNA_ROWS8(32) GDNA_ROWS8(40) GDNA_ROWS8(48) GDNA_ROWS8(56)
#undef GDNA_ROWS8
#undef GDNA_ROW
            const int cc = sd ? 63 - c : c; const float be = sc[128 + sd * 64 + cc], s1 = be * __expf(sc[256 + sd * 64 + cc]);
            LAS bf16_t* T1 = (LAS bf16_t*)(L + (sd ? TB : TF)); LAS bf16_t* T2 = T1 + 64 * 72;
#pragma unroll
            for (int m = 0; m < 16; ++m) { const int j = 4 * m + r4, ii = sd ? 63 - j : j; T1[ii * 72 + cc] = f2bf(to[m] * s1); T2[ii * 72 + cc] = f2bf(to[m] * be); }
        }
        {
            bf16_t* kt = GKT + (size_t)item * 8192;
#pragma unroll
            for (int i = 0; i < 2; ++i) { const int e = THR + i * NT, row = e >> 3, ch = e & 7; *(u32x4*)(kt + row * 64 + ch * 8) = *(const LAS u32x4*)(L + KT + row * 144 + ch * 16); }
            if (THR < 128) { const int dir = THR >> 6, i = THR & 63; const float gc = sc[256 + dir * 64 + i], gl = sc[256 + dir * 64 + (dir ? 0 : 63)];
                float* o = GSC + (size_t)(item * 2 + dir) * 132; o[i] = __expf(gc); o[64 + i] = __expf(gl - gc); if (i == 0) o[128] = __expf(gl); }
        }
        __syncthreads();
#pragma unroll 4
        for (int ti = 0; ti < 16; ++ti) { const int id = wid * 16 + ti, dir = id >> 6, isU = (id >> 5) & 1, x = (id >> 2) & 7, y = id & 3;
            const int t1 = dir ? TB : TF; f32x4 acc = {0.f, 0.f, 0.f, 0.f};
#pragma unroll
            for (int s2 = 0; s2 < 2; ++s2) {
                bf16x8 a, bb;
                if (!isU) { a = *(const LAS bf16x8*)(L + KT + (16 * x + l15) * 144 + (32 * s2 + 8 * q4) * 2); bb = *(const LAS bf16x8*)(L + t1 + (16 * y + l15) * 144 + (32 * s2 + 8 * q4) * 2); }
                else { a = *(const LAS bf16x8*)(L + t1 + 64 * 144 + (16 * y + l15) * 144 + (32 * s2 + 8 * q4) * 2); bb = *(const LAS bf16x8*)(L + VT + (16 * x + l15) * 144 + (32 * s2 + 8 * q4) * 2); }
                acc = __builtin_amdgcn_mfma_f32_16x16x32_bf16(a, bb, acc, 0, 0, 0); }
            const bf16x4 o = pack4(acc[0], acc[1], acc[2], acc[3]);
            if (!isU) *(bf16x4*)(GW + (size_t)(item * 2 + dir) * 8192 + (16 * y + l15) * 128 + 16 * x + 4 * q4) = o;
            else *(bf16x4*)(GUT + (size_t)(item * 2 + dir) * 8192 + (16 * x + l15) * 64 + 16 * y + 4 * q4) = o; }
#pragma unroll
        for (int mat = 0; mat < 3; ++mat)
#pragma unroll
            for (int r = 0; r < 12; ++r) rawc[mat][r] = rawn[mat][r];
        bac = ban;
        __syncthreads();
    }
}

__device__ __forceinline__ void ph_gdnb(const Params& p, float* smem) {
    if (blockIdx.x >= B_ * NH * 2 * 2) return;
    LAS unsigned char* L = (LAS unsigned char*)smem;
    constexpr int BUF = 62464 + 1024, OW = 0, OQ = 17408, OK_ = 34816, OQK = 53248, OSC = 62464;
    const int half = (blockIdx.x >> 3) & 1, seq = (blockIdx.x & 7) | ((blockIdx.x >> 4) << 3), dir = seq & 1, h = (seq >> 1) & 3, b = seq >> 3;
    const bf16_t* GQN = (const bf16_t*)(p.ws + WS_GQN);
    const bf16_t* GW = (const bf16_t*)(p.ws + WS_GW); const bf16_t* GUT = (const bf16_t*)(p.ws + WS_GUT); const bf16_t* GQK = (const bf16_t*)(p.ws + WS_GQK); const bf16_t* GKT = (const bf16_t*)(p.ws + WS_GKT);
    const float* GSC = (const float*)((unsigned char*)p.out + OUT_GSC);
    bf16_t* GO = (bf16_t*)((unsigned char*)p.out + OUT_GO) + (size_t)dir * T_ * GDW;
    auto stage = [&](int n, int buf, int tt, auto nth_tag) {
        constexpr int NTH = decltype(nth_tag)::value, NCH = 3584 / NTH;
        const int item = (b * 4 + h) * 32 + n;
        u32x4 d[NCH];
#pragma unroll
        for (int i = 0; i < NCH; ++i) { const int e = tt + i * NTH; const u32x4* src;
            if (e < 1024) src = (const u32x4*)(GW + (size_t)(item * 2 + dir) * 8192) + e;
            else if (e < 2048) src = (const u32x4*)(GQN + (size_t)item * 8192) + (e - 1024);
            else if (e < 3072) src = (const u32x4*)(GKT + (size_t)item * 8192) + (e - 2048);
            else src = (const u32x4*)(GQK + (size_t)(item * 2 + dir) * 4096) + (e - 3072);
            d[i] = *src; }
        const float scv = (tt < 132) ? GSC[(size_t)(item * 2 + dir) * 132 + tt] : 0.f;
#pragma unroll
        for (int i = 0; i < NCH; ++i) { const int e = tt + i * NTH; int off;
            if (e < 1024) off = OW + (e >> 4) * 272 + (e & 15) * 16;
            else if (e < 2048) off = OQ + ((e - 1024) >> 4) * 272 + (e & 15) * 16;
            else if (e < 3072) off = OK_ + ((e - 2048) >> 3) * 144 + (e & 7) * 16;
            else off = OQK + ((e - 3072) >> 3) * 144 + (e & 7) * 16;
            *(LAS u32x4*)(L + buf * BUF + off) = d[i]; }
        if (tt < 132) *(LAS float*)(L + buf * BUF + OSC + tt * 4) = scv;
    };
    auto loadu = [&](bf16x4 (&u)[4], int n) {
        const int THR = ltid(); const int lane = THR & 63, wid = THR >> 6, l15 = lane & 15, q4 = lane >> 4, dv0 = half * 64 + (wid & 3) * 16;
        const bf16_t* ut = GUT + (size_t)(((b * 4 + h) * 32 + n) * 2 + dir) * 8192 + (size_t)(dv0 + l15) * 64 + 4 * q4;
#pragma unroll
        for (int mt = 0; mt < 4; ++mt) u[mt] = *(const bf16x4*)(ut + 16 * mt);
    };
    f32x4 S[8]; bf16x8 Sb[4];
#pragma unroll
    for (int i = 0; i < 8; ++i) S[i] = (f32x4){0.f, 0.f, 0.f, 0.f};
#pragma unroll
    for (int i = 0; i < 4; ++i) Sb[i] = (bf16x8){0, 0, 0, 0, 0, 0, 0, 0};
    auto compute = [&](int n, int buf, const bf16x4 (&uraw)[4]) {
        const int THR = ltid(); const int lane = THR & 63, wid = THR >> 6, l15 = lane & 15, q4 = lane >> 4, dv0 = half * 64 + (wid & 3) * 16;
        const LAS unsigned char* Bf = L + buf * BUF; const LAS float* scl = (const LAS float*)(Bf + OSC);
        f32x4 ws[4], qs[4];
        {
            bf16x8 fa[4][4];
#pragma unroll
            for (int mt = 0; mt < 4; ++mt)
#pragma unroll
                for (int s4 = 0; s4 < 4; ++s4) { const LAS unsigned char* r = Bf + OW + (16 * mt + l15) * 272 + (32 * s4 + 4 * q4) * 2; fa[mt][s4] = cat44(*(const LAS bf16x4*)r, *(const LAS bf16x4*)(r + 32)); }
#pragma unroll
            for (int mt = 0; mt < 4; ++mt) { ws[mt] = (f32x4){0.f, 0.f, 0.f, 0.f};
#pragma unroll
                for (int s4 = 0; s4 < 4; ++s4) ws[mt] = __builtin_amdgcn_mfma_f32_16x16x32_bf16(fa[mt][s4], Sb[s4], ws[mt], 0, 0, 0); }
        }
        {
            bf16x8 fa[4][4];
#pragma unroll
            for (int mt = 0; mt < 4; ++mt)
#pragma unroll
                for (int s4 = 0; s4 < 4; ++s4) { const LAS unsigned char* r = Bf + OQ + (16 * mt + l15) * 272 + (32 * s4 + 4 * q4) * 2; fa[mt][s4] = cat44(*(const LAS bf16x4*)r, *(const LAS bf16x4*)(r + 32)); }
#pragma unroll
            for (int mt = 0; mt < 4; ++mt) { qs[mt] = (f32x4){0.f, 0.f, 0.f, 0.f};
#pragma unroll
                for (int s4 = 0; s4 < 4; ++s4) qs[mt] = __builtin_amdgcn_mfma_f32_16x16x32_bf16(fa[mt][s4], Sb[s4], qs[mt], 0, 0, 0); }
        }
        f32x4 vn[4], vs[4];
#pragma unroll
        for (int mt = 0; mt < 4; ++mt) { const f32x4 es = *(const LAS f32x4*)(scl + 64 + 16 * mt + 4 * q4);
#pragma unroll
            for (int r = 0; r < 4; ++r) { const float u = __uint_as_float(((unsigned)(unsigned short)uraw[mt][r]) << 16); vn[mt][r] = u - ws[mt][r]; vs[mt][r] = vn[mt][r] * es[r]; } }
        bf16x8 vb[2], vsb[2];
#pragma unroll
        for (int s2 = 0; s2 < 2; ++s2) { vb[s2] = cat44(pack4(vn[2 * s2][0], vn[2 * s2][1], vn[2 * s2][2], vn[2 * s2][3]), pack4(vn[2 * s2 + 1][0], vn[2 * s2 + 1][1], vn[2 * s2 + 1][2], vn[2 * s2 + 1][3]));
            vsb[s2] = cat44(pack4(vs[2 * s2][0], vs[2 * s2][1], vs[2 * s2][2], vs[2 * s2][3]), pack4(vs[2 * s2 + 1][0], vs[2 * s2 + 1][1], vs[2 * s2 + 1][2], vs[2 * s2 + 1][3])); }
        bf16x8 fk[8][2];
        {
            bf16x8 fq[4][2];
#pragma unroll
            for (int it = 0; it < 4; ++it)
#pragma unroll
                for (int s2 = 0; s2 < 2; ++s2) { const LAS unsigned char* r = Bf + OQK + (16 * it + l15) * 144 + (32 * s2 + 4 * q4) * 2; fq[it][s2] = cat44(*(const LAS bf16x4*)r, *(const LAS bf16x4*)(r + 32)); }
#pragma unroll
            for (int t8 = 0; t8 < 8; ++t8)
#pragma unroll
                for (int s2 = 0; s2 < 2; ++s2) { const LAS unsigned char* r = Bf + OK_ + (16 * t8 + l15) * 144 + (32 * s2 + 4 * q4) * 2; fk[t8][s2] = cat44(*(const LAS bf16x4*)r, *(const LAS bf16x4*)(r + 32)); }
#pragma unroll
            for (int it = 0; it < 4; ++it) { f32x4 o2 = {0.f, 0.f, 0.f, 0.f};
#pragma unroll
                for (int s2 = 0; s2 < 2; ++s2) o2 = __builtin_amdgcn_mfma_f32_16x16x32_bf16(fq[it][s2], vb[s2], o2, 0, 0, 0);
                const f32x4 eg4 = *(const LAS f32x4*)(scl + 16 * it + 4 * q4);
#pragma unroll
                for (int r = 0; r < 4; ++r) { const int tok = 16 * it + 4 * q4 + r; const float o = eg4[r] * qs[it][r] + o2[r];
                    GO[((size_t)b * S_ + n * 64 + tok) * GDW + h * 128 + dv0 + l15] = f2bf(o); } }
        }
        const float eg = scl[128];
#pragma unroll
        for (int t8 = 0; t8 < 8; ++t8) { f32x4 c = S[t8] * eg;
#pragma unroll
            for (int s2 = 0; s2 < 2; ++s2) c = __builtin_amdgcn_mfma_f32_16x16x32_bf16(fk[t8][s2], vsb[s2], c, 0, 0, 0);
            S[t8] = c; }
#pragma unroll
        for (int s4 = 0; s4 < 4; ++s4) Sb[s4] = cat44(pack4(S[2 * s4][0], S[2 * s4][1], S[2 * s4][2], S[2 * s4][3]), pack4(S[2 * s4 + 1][0], S[2 * s4 + 1][1], S[2 * s4 + 1][2], S[2 * s4 + 1][3]));
    };
    const int n0 = dir ? 31 : 0, dn = dir ? -1 : 1;
    const int wid0 = __builtin_amdgcn_readfirstlane(ltid() >> 6);
    { const int THR = ltid(); stage(n0, 0, THR, std::integral_constant<int, 512>()); }
    __syncthreads();
    if (wid0 >= 4) {
        const int tt = ltid() - 256;
        constexpr int NCH = 14;
        auto ld = [&](u32x4 (&d)[NCH], float& scv, int n) {
            const int item = (b * 4 + h) * 32 + n;
#pragma unroll
            for (int i = 0; i < NCH; ++i) { const int e = tt + i * 256; const u32x4* src;
                if (e < 1024) src = (const u32x4*)(GW + (size_t)(item * 2 + dir) * 8192) + e;
                else if (e < 2048) src = (const u32x4*)(GQN + (size_t)item * 8192) + (e - 1024);
                else if (e < 3072) src = (const u32x4*)(GKT + (size_t)item * 8192) + (e - 2048);
                else src = (const u32x4*)(GQK + (size_t)(item * 2 + dir) * 4096) + (e - 3072);
                d[i] = *src; }
            scv = (tt < 132) ? GSC[(size_t)(item * 2 + dir) * 132 + tt] : 0.f;
        };
        auto st_ = [&](const u32x4 (&d)[NCH], float scv, int buf) {
#pragma unroll
            for (int i = 0; i < NCH; ++i) { const int e = tt + i * 256; int off;
                if (e < 1024) off = OW + (e >> 4) * 272 + (e & 15) * 16;
                else if (e < 2048) off = OQ + ((e - 1024) >> 4) * 272 + (e & 15) * 16;
                else if (e < 3072) off = OK_ + ((e - 2048) >> 3) * 144 + (e & 7) * 16;
                else off = OQK + ((e - 3072) >> 3) * 144 + (e & 7) * 16;
                *(LAS u32x4*)(L + buf * BUF + off) = d[i]; }
            if (tt < 132) *(LAS float*)(L + buf * BUF + OSC + tt * 4) = scv;
        };
        u32x4 r0[NCH], r1[NCH]; float c0 = 0.f, c1 = 0.f;
        ld(r0, c0, n0 + dn);
        for (int st = 0; st < 32; st += 2) {
            if (st + 2 < 32) ld(r1, c1, n0 + dn * (st + 2));
            st_(r0, c0, 1);
            __syncthreads();
            if (st + 3 < 32) ld(r0, c0, n0 + dn * (st + 3));
            if (st + 2 < 32) st_(r1, c1, 0);
            __syncthreads();
        }
    } else {
        bf16x4 uA[4], uB[4];
        loadu(uA, n0); loadu(uB, n0 + dn);
        for (int st = 0; st < 32; st += 2) {
            { bf16x4 uc[4];
#pragma unroll
              for (int mt = 0; mt < 4; ++mt) uc[mt] = uA[mt];
              if (st + 2 < 32) loadu(uA, n0 + dn * (st + 2));
              compute(n0 + dn * st, 0, uc);
              __syncthreads(); }
            { bf16x4 uc[4];
#pragma unroll
              for (int mt = 0; mt < 4; ++mt) uc[mt] = uB[mt];
              if (st + 3 < 32) loadu(uB, n0 + dn * (st + 3));
              compute(n0 + dn * (st + 1), 1, uc);
              __syncthreads(); }
        }
    }
}
__device__ __forceinline__ void ph_gdncomb(const Params& p, float* smem) {
    const int THR = ltid();
    const bf16_t* O = (const bf16_t*)((unsigned char*)p.out + OUT_GO); const bf16_t* zb = (const bf16_t*)(p.ws + WS_ZB); bf16_t* cat = (bf16_t*)(p.ws + WS_CAT); const float* gn = p.in[I_GDN_NORM];
    const int lane = THR & 63, gw = blockIdx.x * NW + (THR >> 6), nw = gridDim.x * NW;
    const f4_t g0 = ((const f4_t*)gn)[(lane & 15) * 2], g1 = ((const f4_t*)gn)[(lane & 15) * 2 + 1];
    const float gg[8] = {g0.x, g0.y, g0.z, g0.w, g1.x, g1.y, g1.z, g1.w};
    const float* ssq5 = (const float*)(p.ws + WS_SSQ); const f4_t n0 = ((const f4_t*)p.in[I_S5_NORM])[lane * 2], n1 = ((const f4_t*)p.in[I_S5_NORM])[lane * 2 + 1];
    const float nn[8] = {n0.x, n0.y, n0.z, n0.w, n1.x, n1.y, n1.z, n1.w};
    for (int t0 = gw * 4; t0 < T_; t0 += nw * 4) {
        u4_t of[4], ob[4], zz[4], s5[4]; float r5[4];
#pragma unroll
        for (int r = 0; r < 4; ++r) { const size_t t = t0 + r; s5[r] = ((const u4_t*)(cat + t * D_))[lane]; r5[r] = rsqrtf(ssq5[t] * (1.f / (float)S5W) + RMS_EPS); of[r] = ((const u4_t*)(O + t * GDW))[lane]; ob[r] = ((const u4_t*)(O + (size_t)T_ * GDW + t * GDW))[lane]; zz[r] = ((const u4_t*)(zb + t * GDW))[lane]; }
#pragma unroll
        for (int r = 0; r < 4; ++r) {
            float a[8]; float ss = 0.f;
#pragma unroll
            for (int k = 0; k < 4; ++k) { a[2 * k] = bflo(of[r][k]) + bflo(ob[r][k]); a[2 * k + 1] = bfhi(of[r][k]) + bfhi(ob[r][k]); ss += a[2 * k] * a[2 * k] + a[2 * k + 1] * a[2 * k + 1]; }
            ss = dpp_sum16(ss);
            const float rs = rsqrtf(ss * (1.f / 128.f) + RMS_EPS);
            float o[8];
#pragma unroll
            for (int k = 0; k < 4; ++k) { o[2 * k] = a[2 * k] * rs * gg[2 * k] * siluf_(bflo(zz[r][k])); o[2 * k + 1] = a[2 * k + 1] * rs * gg[2 * k + 1] * siluf_(bfhi(zz[r][k])); }
            u4_t w; w.x = pkbf(o[0], o[1]); w.y = pkbf(o[2], o[3]); w.z = pkbf(o[4], o[5]); w.w = pkbf(o[6], o[7]);
            ((u4_t*)(cat + (size_t)(t0 + r) * D_ + 512))[lane] = w;
            u4_t v5;
#pragma unroll
            for (int k = 0; k < 4; ++k) v5[k] = pkbf(bflo(s5[r][k]) * r5[r] * nn[2 * k], bfhi(s5[r][k]) * r5[r] * nn[2 * k + 1]);
            ((u4_t*)(cat + (size_t)(t0 + r) * D_))[lane] = v5; }
    }
}
struct XcdBarrier; __device__ __forceinline__ void xcd_barrier(const XcdBarrier& b);
typedef int i4_t __attribute__((ext_vector_type(4)));
constexpr int RT_GN_OFF = 73728, RT_LG_OFF = 77824, RT_LG_STRIDE = 2688, RT_H_OFF = 90112;
__device__ __forceinline__ void router_stage(const u4_t* src, LAS unsigned char* L, int half, int THR) {
#pragma unroll 3
    for (int i = THR; i < 72 * 64; i += NT) { const int R = i >> 6, ch = i & 63, o = R >= 36 ? R - 36 : R, key = (o < 4 ? o : o - 4) & 15;
        *(LAS u4_t*)(L + (size_t)((R * 64 + (ch ^ key)) * 16)) = src[R * 128 + half * 64 + ch]; }
}
__device__ __forceinline__ void ph_router(const Params& p, float* smem, const XcdBarrier& bar) {
    const int THR = ltid();
    const bf16_t* x2 = (const bf16_t*)(p.ws + WS_XB); bf16_t* xs = (bf16_t*)(p.ws + WS_XS); int* route = (int*)(p.ws + WS_ROUTE); int* mc = (int*)(p.ws + WS_CNT);
    const float* gn = p.in[I_NORM_MOE]; const float* bg = p.in[I_RG_B]; const float* be = p.in[I_RE_B]; const u4_t* WrHL = (const u4_t*)(p.ws + WS_WRT);
    LAS unsigned char* L = (LAS unsigned char*)smem;
    for (int i = THR; i < D_ / 4; i += NT) *(LAS f4_t*)(L + RT_GN_OFF + i * 16) = ((const f4_t*)gn)[i];
    LAS int* lh = (LAS int*)(L + RT_H_OFF);
    if (THR < NE) lh[THR] = 0;
    {
        const int TH2 = ltid(); const int lane = TH2 & 63, wid = TH2 >> 6, c = lane & 15, q = lane >> 4;
        LAS float* lgs = (LAS float*)(L + RT_LG_OFF + (wid & 3) * RT_LG_STRIDE); LAS float* lrs = lgs + 640;
        const int tg = (int)blockIdx.x * 4 + wid; const bool act = (wid < 4) && (tg < T_ / 16);
        const int t0 = act ? tg * 16 : 0;
        u4_t A[32];
        if (act) { const u4_t* xr = (const u4_t*)(x2 + (size_t)(t0 + c) * D_) + q;
#pragma unroll
          for (int s = 0; s < 32; ++s) A[s] = xr[4 * s]; }
        f32x4 acc0 = {0.f, 0.f, 0.f, 0.f}, acc1 = acc0, acc2 = acc0;
#pragma unroll
        for (int half = 0; half < 2; ++half) {
            if (half) __syncthreads();
            router_stage(WrHL, L, half, THR);
            __syncthreads();
            if (act) {
#pragma unroll
                for (int ls = 0; ls < 16; ++ls) {
                    const bf16x8 a = __builtin_bit_cast(bf16x8, A[half * 16 + ls]);
                    const int swe = ((4 * ls + q) ^ c) * 16, swg = ((4 * ls + q) ^ (c & 3)) * 16;
#pragma unroll
                    for (int hl = 0; hl < 2; ++hl) {
                        const bf16x8 b0 = *(const LAS bf16x8*)(L + (hl * 36 + 4 + c) * 1024 + swe);
                        const bf16x8 b1 = *(const LAS bf16x8*)(L + (hl * 36 + 20 + c) * 1024 + swe);
                        const bf16x8 b2 = *(const LAS bf16x8*)(L + (hl * 36 + (c & 3)) * 1024 + swg);
                        acc0 = __builtin_amdgcn_mfma_f32_16x16x32_bf16(a, b0, acc0, 0, 0, 0);
                        acc1 = __builtin_amdgcn_mfma_f32_16x16x32_bf16(a, b1, acc1, 0, 0, 0);
                        acc2 = __builtin_amdgcn_mfma_f32_16x16x32_bf16(a, b2, acc2, 0, 0, 0);
                    }
                    if (ls & 1) asm volatile("" ::: "memory");
                }
            }
        }
        int eav = 0, ebv = 0, rka = 0, rkb = 0; float w0v = 0.f, w1v = 0.f, rs = 0.f;
        if (act) {
            float ss = 0.f;
#pragma unroll
            for (int s = 0; s < 32; ++s)
#pragma unroll
                for (int k = 0; k < 4; ++k) { const float lo = bflo(A[s][k]), hi = bfhi(A[s][k]); ss += lo * lo + hi * hi; }
            ss += __shfl_xor(ss, 16); ss += __shfl_xor(ss, 32);
            rs = rsqrtf(ss * (1.f / (float)D_) + RMS_EPS);
#pragma unroll
            for (int r = 0; r < 4; ++r) { LAS float* row = lgs + (4 * q + r) * 40; row[4 + c] = acc0[r]; row[20 + c] = acc1[r]; if (c < 4) row[c] = acc2[r]; }
            if (q == 0) lrs[c] = rs;
            asm volatile("s_waitcnt lgkmcnt(0)" ::: "memory");
            float mine[36];
            if (lane < 16) {
                const float rt = lrs[lane];
#pragma unroll
                for (int o = 0; o < 36; ++o) mine[o] = lgs[lane * 40 + o] * rt + (o < 4 ? bg[o] : be[o - 4]);
            }
            if (lane < 16) {
                int gi = 0; float gm = mine[0];
#pragma unroll
                for (int g = 1; g < 4; ++g) if (mine[g] > gm) { gm = mine[g]; gi = g; }
                float gs = 0.f;
#pragma unroll
                for (int g = 0; g < 4; ++g) gs += __expf(mine[g] - gm);
                const float ptop = 1.f / gs;
                float el[8];
#pragma unroll
                for (int e = 0; e < 8; ++e) { float v = mine[4 + e];
#pragma unroll
                    for (int g = 1; g < 4; ++g) v = (gi == g) ? mine[4 + g * 8 + e] : v;
                    el[e] = v; }
                int i0 = 0; float v0 = el[0];
#pragma unroll
                for (int e = 1; e < 8; ++e) if (el[e] > v0) { v0 = el[e]; i0 = e; }
                int i1 = -1; float v1 = -1e30f;
#pragma unroll
                for (int e = 0; e < 8; ++e) if (e != i0 && el[e] > v1) { v1 = el[e]; i1 = e; }
                const float e1 = __expf(v1 - v0), w0 = ptop / (1.f + e1), w1 = ptop * e1 / (1.f + e1);
                const int ea = gi * 8 + i0, eb = gi * 8 + i1;
                eav = ea; ebv = eb; w0v = w0; w1v = w1;
                rka = __hip_atomic_fetch_add(lh + ea, 1, __ATOMIC_RELAXED, __HIP_MEMORY_SCOPE_WORKGROUP); rkb = __hip_atomic_fetch_add(lh + eb, 1, __ATOMIC_RELAXED, __HIP_MEMORY_SCOPE_WORKGROUP);
            }
        }
        __syncthreads();
        if (TH2 < NE) mc[MC_HIST + TH2 * 256 + (int)blockIdx.x] = lh[TH2];
        xcd_barrier(bar);
        {   const int e = TH2 >> 4, part = TH2 & 15, pb = (int)blockIdx.x >> 4, myb = (int)blockIdx.x & 15;
            const i4_t* hp = (const i4_t*)(mc + MC_HIST + e * 256 + part * 16);
            int sf = 0, spre = 0;
#pragma unroll
            for (int i = 0; i < 4; ++i) { const i4_t v = hp[i];
#pragma unroll
                for (int k = 0; k < 4; ++k) { sf += v[k]; spre += (4 * i + k < myb) ? v[k] : 0; } }
            int con = part < pb ? sf : (part == pb ? spre : 0);
            con += __shfl_xor(con, 1); con += __shfl_xor(con, 2); con += __shfl_xor(con, 4); con += __shfl_xor(con, 8);
            sf += __shfl_xor(sf, 1); sf += __shfl_xor(sf, 2); sf += __shfl_xor(sf, 4); sf += __shfl_xor(sf, 8);
            if (part == 0) { lh[32 + e] = con; lh[64 + e] = sf; if (blockIdx.x == 0) mc[MC_TOT + e] = sf; }
        }
        __syncthreads();
        if (TH2 == 0) { int acc = 0; for (int e = 0; e < NE; ++e) { lh[96 + e] = acc; acc += (lh[64 + e] + 255) >> 8; } }
        __syncthreads();
        if (act) {
            int r0v = 0, r1v = 0;
            if (lane < 16) {
                r0v = lh[96 + eav] * 256 + lh[32 + eav] + rka; r1v = lh[96 + ebv] * 256 + lh[32 + ebv] + rkb;
                int* rr = route + (size_t)(t0 + lane) * 8; rr[0] = eav; rr[1] = ebv; ((float*)rr)[2] = w0v; ((float*)rr)[3] = w1v; rr[6] = r0v; rr[7] = r1v;
            }
            const int d0 = __shfl(r0v, c), d1 = __shfl(r1v, c);
            u4_t* q0 = (u4_t*)(xs + (size_t)d0 * D_) + q; u4_t* q1 = (u4_t*)(xs + (size_t)d1 * D_) + q;
#pragma unroll
            for (int s = 0; s < 32; ++s) {
                const f4_t g0 = *(const LAS f4_t*)(L + RT_GN_OFF + (32 * s + 8 * q) * 4), g1 = *(const LAS f4_t*)(L + RT_GN_OFF + (32 * s + 8 * q) * 4 + 16);
                u4_t w; asm volatile("" : "+v"(A[s]));
                w.x = pkbf(bflo(A[s].x) * rs * g0.x, bfhi(A[s].x) * rs * g0.y); w.y = pkbf(bflo(A[s].y) * rs * g0.z, bfhi(A[s].y) * rs * g0.w);
                w.z = pkbf(bflo(A[s].z) * rs * g1.x, bfhi(A[s].z) * rs * g1.y); w.w = pkbf(bflo(A[s].w) * rs * g1.z, bfhi(A[s].w) * rs * g1.w);
                q0[4 * s] = w; q1[4 * s] = w;
                if ((s & 3) == 3) asm volatile("" ::: "memory");
            }
        }
    }
}
__device__ __forceinline__ void moe_build_table(const Params& p, int* tab) {
    const int THR = ltid();
    if (THR == 0) {
        const int* cnt = (const int*)(p.ws + WS_CNT) + MC_TOT; int acc = 0;
        for (int e = 0; e < NE; ++e) { tab[1 + e] = acc; const int nt = (cnt[e] + 255) >> 8; for (int i = 0; i < nt; ++i) tab[40 + acc + i] = e; acc += nt; }
        tab[1 + NE] = acc; tab[0] = acc;
    }
    __syncthreads();
}
__device__ __forceinline__ void ph_final(const Params& p, float* smem) {
    const int THR = ltid();
    float* out = p.out; const bf16_t* x2 = (const bf16_t*)(p.ws + WS_XB); const float* gn = p.in[I_NORM_FINAL]; const bf16_t* Y = (const bf16_t*)(p.ws + WS_XS); const int* route = (const int*)(p.ws + WS_ROUTE);
    const int lane = THR & 63, gw = blockIdx.x * NW + (THR >> 6), nw = gridDim.x * NW;
    f4_t g[4];
#pragma unroll
    for (int j = 0; j < 4; ++j) g[j] = ((const f4_t*)gn)[lane + 64 * j];
    for (int t0 = gw * 2; t0 < T_; t0 += nw * 2) {
        f4_t xv[2][4]; u2_t xr[2][4], ya[2][4], yb[2][4]; float w0[2], w1[2];
#pragma unroll
        for (int r = 0; r < 2; ++r) { const int* rr = route + (size_t)(t0 + r) * 8; w0[r] = ((const float*)rr)[2]; w1[r] = ((const float*)rr)[3];
            const u2_t* y0 = (const u2_t*)(Y + (size_t)rr[6] * D_); const u2_t* y1 = (const u2_t*)(Y + (size_t)rr[7] * D_);
#pragma unroll
            for (int j = 0; j < 4; ++j) { xr[r][j] = ((const u2_t*)(x2 + (size_t)(t0 + r) * D_))[lane + 64 * j]; ya[r][j] = y0[lane + 64 * j]; yb[r][j] = y1[lane + 64 * j]; } }
#pragma unroll
        for (int r = 0; r < 2; ++r) { float ss = 0.f;
#pragma unroll
            for (int j = 0; j < 4; ++j) { f4_t v = (f4_t){bflo(xr[r][j].x), bfhi(xr[r][j].x), bflo(xr[r][j].y), bfhi(xr[r][j].y)};
                v.x += w0[r] * bflo(ya[r][j].x) + w1[r] * bflo(yb[r][j].x); v.y += w0[r] * bfhi(ya[r][j].x) + w1[r] * bfhi(yb[r][j].x);
                v.z += w0[r] * bflo(ya[r][j].y) + w1[r] * bflo(yb[r][j].y); v.w += w0[r] * bfhi(ya[r][j].y) + w1[r] * bfhi(yb[r][j].y);
                xv[r][j] = v; ss += v.x * v.x + v.y * v.y + v.z * v.z + v.w * v.w; }
            const float rs = rsqrtf(wave_sum(ss) * (1.f / (float)D_) + RMS_EPS);
#pragma unroll
            for (int j = 0; j < 4; ++j) ((f4_t*)(out + (size_t)(t0 + r) * D_))[lane + 64 * j] = xv[r][j] * rs * g[j]; }
    }
}


typedef pg8::f32x4 f32x4; typedef pg8::u32x4 u32x4;

__device__ __forceinline__ void transpose_item(const float* W, int K, int N, bf16_t* WT, int ldt, int dst_row0, int k0, int n0, const float* rowscale, LAS float* scr, int lane) {
    f4_t v[8];
#pragma unroll
    for (int i = 0; i < 8; ++i) v[i] = *(const f4_t*)(W + (size_t)(k0 + (lane >> 3) + 8 * i) * N + n0 + 4 * (lane & 7));
#pragma unroll
    for (int i = 0; i < 8; ++i) { const int kk = (lane >> 3) + 8 * i; f4_t x = v[i]; if (rowscale) x = x * rowscale[k0 + kk];
        LAS float* d = scr + kk * 33 + 4 * (lane & 7); d[0] = x.x; d[1] = x.y; d[2] = x.z; d[3] = x.w; }
    asm volatile("s_waitcnt lgkmcnt(0)" ::: "memory");
    const int c = lane & 7;
#pragma unroll
    for (int j = 0; j < 4; ++j) { const int n = (lane >> 3) + 8 * j; const LAS float* sp = scr + (8 * c) * 33 + n;
        u32x4 o; o.x = pg8::cvt_pk_bf16(sp[0 * 33], sp[1 * 33]); o.y = pg8::cvt_pk_bf16(sp[2 * 33], sp[3 * 33]); o.z = pg8::cvt_pk_bf16(sp[4 * 33], sp[5 * 33]); o.w = pg8::cvt_pk_bf16(sp[6 * 33], sp[7 * 33]);
        *(u32x4*)(WT + (size_t)(dst_row0 + n) * ldt + k0 + 8 * c) = o; }
    asm volatile("s_waitcnt lgkmcnt(0)" ::: "memory");
}
__device__ __forceinline__ void transpose_matrix(const float* W, int K, int N, bf16_t* WT, const float* rowscale, float* smem) {
    const int THR = ltid();
    const int lane = THR & 63, wv = THR >> 6; LAS float* scr = (LAS float*)smem + wv * (64 * 33);
    const int gw = blockIdx.x * NW + wv, nw = gridDim.x * NW, nblk = N / 32, items = (K / 64) * nblk;
    for (int it = gw; it < items; it += nw) { const int kb = it / nblk, nb = it % nblk; transpose_item(W, K, N, WT, K, nb * 32, kb * 64, nb * 32, rowscale, scr, lane); }
}
__device__ __forceinline__ void ph_prep0(const Params& p, float* smem) {
    const int THR = ltid();
    bf16_t* WinT = (bf16_t*)((unsigned char*)p.out + OUT_WINT);
    {
        const int lane = THR & 63, wv = THR >> 6; LAS float* scr = (LAS float*)smem + wv * (64 * 33);
        const int gw = blockIdx.x * NW + wv, nw = gridDim.x * NW, nblk = 2560 / 32, items = 16 * nblk;
        for (int it = gw; it < items; it += nw) { const int kb = it / nblk, nb = it % nblk; transpose_item(p.in[I_W_IN], D_, DIN, WinT, D_, nb * 32, kb * 64, nb * 32, nullptr, scr, lane); }
        for (size_t i = (size_t)blockIdx.x * NT + THR; i < (size_t)256 * D_; i += (size_t)gridDim.x * NT) {
            const int n = (int)(i / D_), k = (int)(i % D_);
            WinT[(size_t)(2560 + n) * D_ + k] = n < 16 ? f2bf(p.in[I_W_IN][(size_t)k * DIN + 2560 + n]) : (bf16_t)0;
        }
    }
    transpose_matrix(p.in[I_W_GLU], S5W, S5W, (bf16_t*)((unsigned char*)p.out + OUT_WGLUT), nullptr, smem);
    transpose_matrix(p.in[I_WK], D_, D_, (bf16_t*)((unsigned char*)p.out + OUT_WKT), nullptr, smem);
    transpose_matrix(p.in[I_WV], D_, D_, (bf16_t*)((unsigned char*)p.out + OUT_WVT), nullptr, smem);
    { float* ssq = (float*)(p.ws + WS_SSQ); for (int i = blockIdx.x * NT + THR; i < 2 * T_; i += gridDim.x * NT) ssq[i] = 0.f; }
}
__device__ __forceinline__ void ph_prep1(const Params& p, float* smem) {
    transpose_matrix(p.in[I_W_OUT], D_, D_, (bf16_t*)(p.ws + WS_WOUTT), nullptr, smem);
}
__device__ __forceinline__ void ph_prepa(const Params& p, float* smem) {
    const int THR = ltid();
    bf16_t* WqB = (bf16_t*)(p.ws + WS_WQB); const float* wq = p.in[I_WQ]; const float* gx = p.in[I_NORM_XA];
    for (int i = blockIdx.x * NT + THR; i < D_ * D_ / 4; i += gridDim.x * NT) { const f4_t v = ((const f4_t*)wq)[i] * gx[i >> 8]; u2_t w; w.x = pkbf(v.x, v.y); w.y = pkbf(v.z, v.w); ((u2_t*)WqB)[i] = w; }
    transpose_matrix(p.in[I_WO], D_, D_, (bf16_t*)(p.ws + WS_WOT), nullptr, smem);
}
__device__ __forceinline__ void ph_prep2(const Params& p, float* smem) {
    const int THR = ltid();
    const int lane = THR & 63, wv = THR >> 6; LAS float* scr = (LAS float*)smem + wv * (64 * 33);
    const int gw = blockIdx.x * NW + wv, nw = gridDim.x * NW;
    bf16_t* WguT = (bf16_t*)(p.ws + WS_WGUT); bf16_t* WdT = (bf16_t*)(p.ws + WS_WDT);
    { bf16_t* WrHL = (bf16_t*)(p.ws + WS_WRT); const float* gnm = p.in[I_NORM_MOE];
      for (int i = blockIdx.x * NT + THR; i < 36 * D_; i += gridDim.x * NT) { const int o = i >> 10, k = i & 1023; const float w = gnm[k] * (o < 4 ? p.in[I_RG_W][k * 4 + o] : p.in[I_RE_W][k * NE + (o - 4)]);
          const bf16_t hi = f2bf(w); WrHL[i] = hi; WrHL[36 * D_ + i] = f2bf(w - bf2f(hi)); } }
    for (int it = gw; it < NE * 2 * 128; it += nw) {
        const int e = it >> 8, which = (it >> 7) & 1, r = it & 127, kb = r >> 3, nb = r & 7, f0 = nb * 32;
        const float* W = p.in[which ? I_WUP : I_WGATE] + (size_t)e * D_ * DE;
        transpose_item(W, D_, DE, WguT, D_, e * 512 + (f0 >> 7) * 256 + which * 128 + (f0 & 127), kb * 64, f0, nullptr, scr, lane);
    }
    for (int it = gw; it < NE * 128; it += nw) {
        const int e = it >> 7, r = it & 127, kb = r >> 5, nb = r & 31;
        transpose_item(p.in[I_WDOWN] + (size_t)e * DE * D_, DE, D_, WdT, DE, e * D_ + nb * 32, kb * 64, nb * 32, nullptr, scr, lane);
    }
}

struct EpiInproj {
    static constexpr bool PERM = true;
    bf16_t* qkvr; bf16_t* zb; float* ba; bf16_t* aext;
    __device__ __forceinline__ void operator()(const f32x4 (&acc)[2][2][4][2], const pg8::Unit& u, int wr, int wc, int fr, int fq) const {
        const int row0 = u.orow + wr * 64 + fr;
        if (u.aux < 2) {
            const int col0 = u.ocol + wc * 32 + 8 * fq;
#pragma unroll
            for (int ai = 0; ai < 2; ++ai)
#pragma unroll
                for (int m = 0; m < 4; ++m) { const int t = row0 + ai * 128 + m * 16, n = t >> 4, j = t & 15;
#pragma unroll
                    for (int bj = 0; bj < 2; ++bj) { const int c = col0 + bj * 128, g = c >> 4, ci = c & 15; const f32x4 v0 = acc[ai][bj][m][0], v1 = acc[ai][bj][m][1];
                        u32x4 w; w.x = pg8::cvt_pk_bf16(v0[0], v0[1]); w.y = pg8::cvt_pk_bf16(v0[2], v0[3]); w.z = pg8::cvt_pk_bf16(v1[0], v1[1]); w.w = pg8::cvt_pk_bf16(v1[2], v1[3]);
                        *(u32x4*)(aext + ((size_t)g * 1024 + n) * 512 + j * 16 + ci) = w; } }
        } else if (u.aux < 10) {
            const int col0 = u.ocol + wc * 32 + 8 * fq;
#pragma unroll
            for (int ai = 0; ai < 2; ++ai)
#pragma unroll
                for (int m = 0; m < 4; ++m) { const int rr = row0 + ai * 128 + m * 16; bf16_t* rowp = (u.aux < 8) ? qkvr + (size_t)rr * QKV_LD + col0 - 512 : zb + (size_t)rr * GDW + col0 - 2048;
#pragma unroll
                    for (int bj = 0; bj < 2; ++bj) { const f32x4 v0 = acc[ai][bj][m][0], v1 = acc[ai][bj][m][1];
                        u32x4 w; w.x = pg8::cvt_pk_bf16(v0[0], v0[1]); w.y = pg8::cvt_pk_bf16(v0[2], v0[3]); w.z = pg8::cvt_pk_bf16(v1[0], v1[1]); w.w = pg8::cvt_pk_bf16(v1[2], v1[3]);
                        *(u32x4*)(rowp + bj * 128) = w; } }
        } else if (wc == 0 && fq < 2) {
#pragma unroll
            for (int ai = 0; ai < 2; ++ai)
#pragma unroll
                for (int m = 0; m < 4; ++m) { float* rowp = ba + (size_t)(row0 + ai * 128 + m * 16) * 16 + 8 * fq;
                    *(f32x4*)(rowp) = acc[ai][0][m][0]; *(f32x4*)(rowp + 4) = acc[ai][0][m][1]; }
        }
    }
};
struct EpiBf16Out {
    static constexpr bool PERM = true;
    bf16_t* O; int ldc; float scale; size_t aux_stride;
    __device__ __forceinline__ void operator()(const f32x4 (&acc)[2][2][4][2], const pg8::Unit& u, int wr, int wc, int fr, int fq) const {
        const int row0 = u.orow + wr * 64 + fr, col0 = u.ocol + wc * 32 + 8 * fq; bf16_t* base = O + (size_t)u.aux * aux_stride;
#pragma unroll
        for (int ai = 0; ai < 2; ++ai)
#pragma unroll
            for (int m = 0; m < 4; ++m) { bf16_t* rowp = base + (size_t)(row0 + ai * 128 + m * 16) * ldc + col0;
#pragma unroll
                for (int bj = 0; bj < 2; ++bj) { const f32x4 v0 = acc[ai][bj][m][0] * scale, v1 = acc[ai][bj][m][1] * scale;
                    u32x4 w; w.x = pg8::cvt_pk_bf16(v0[0], v0[1]); w.y = pg8::cvt_pk_bf16(v0[2], v0[3]); w.z = pg8::cvt_pk_bf16(v1[0], v1[1]); w.w = pg8::cvt_pk_bf16(v1[2], v1[3]);
                    *(u32x4*)(rowp + bj * 128) = w; } }
    }
};
struct EpiResid {
    static constexpr bool PERM = false;
    const float* base; const bf16_t* baseb; float* out; int ldc; bf16_t* xb; float* ssq;
    __device__ __forceinline__ void operator()(const f32x4 (&acc)[2][2][4][2], const pg8::Unit& u, int wr, int wc, int fr, int fq) const {
        const int row0 = u.orow + wr * 64 + fr, col0 = u.ocol + wc * 32 + 4 * fq;
#pragma unroll
        for (int ai = 0; ai < 2; ++ai)
#pragma unroll
            for (int m = 0; m < 4; ++m) { const size_t off = (size_t)(row0 + ai * 128 + m * 16) * ldc + col0; float ss = 0.f;
#pragma unroll
                for (int bj = 0; bj < 2; ++bj)
#pragma unroll
                    for (int n = 0; n < 2; ++n) { f32x4 b;
                        if (base) b = *(const f32x4*)(base + off + bj * 128 + n * 16);
                        else { const u2_t rb = *(const u2_t*)(baseb + off + bj * 128 + n * 16); b = (f32x4){bflo(rb.x), bfhi(rb.x), bflo(rb.y), bfhi(rb.y)}; }
                        const f32x4 o = b + acc[ai][bj][m][n]; if (out) *(f32x4*)(out + off + bj * 128 + n * 16) = o;
                        if (xb) { u2_t w; w.x = pkbf(o[0], o[1]); w.y = pkbf(o[2], o[3]); *(u2_t*)(xb + off + bj * 128 + n * 16) = w; ss += o[0] * o[0] + o[1] * o[1] + o[2] * o[2] + o[3] * o[3]; } }
                if (ssq) { ss += __shfl_xor(ss, 16); ss += __shfl_xor(ss, 32); if (fq == 0) atomicAdd(ssq + row0 + ai * 128 + m * 16, ss); }
                asm volatile("" ::: "memory"); }
    }
};
struct EpiGlu {
    static constexpr bool PERM = true;
    const bf16_t* gl; const float* bias; bf16_t* cat; float* ssq;
    __device__ __forceinline__ void operator()(const f32x4 (&acc)[2][2][4][2], const pg8::Unit& u, int wr, int wc, int fr, int fq) const {
        const int row0 = u.orow + wr * 64 + fr, col0 = u.ocol + wc * 32 + 8 * fq;
#pragma unroll
        for (int ai = 0; ai < 2; ++ai)
#pragma unroll
            for (int m = 0; m < 4; ++m) { const int r = row0 + ai * 128 + m * 16; float ss = 0.f;
#pragma unroll
                for (int bj = 0; bj < 2; ++bj) { const int c = col0 + bj * 128; const u4_t graw = *(const u4_t*)(gl + (size_t)r * S5W + c);
                    const f32x4 b0 = *(const f32x4*)(bias + c), b1 = *(const f32x4*)(bias + c + 4); const f32x4 a0 = acc[ai][bj][m][0] + b0, a1 = acc[ai][bj][m][1] + b1;
                    float o[8];
                    o[0] = bflo(graw.x) * sigmoidf_(a0[0]); o[1] = bfhi(graw.x) * sigmoidf_(a0[1]); o[2] = bflo(graw.y) * sigmoidf_(a0[2]); o[3] = bfhi(graw.y) * sigmoidf_(a0[3]);
                    o[4] = bflo(graw.z) * sigmoidf_(a1[0]); o[5] = bfhi(graw.z) * sigmoidf_(a1[1]); o[6] = bflo(graw.w) * sigmoidf_(a1[2]); o[7] = bfhi(graw.w) * sigmoidf_(a1[3]);
#pragma unroll
                    for (int e = 0; e < 8; ++e) ss += o[e] * o[e];
                    u4_t w; w.x = pkbf(o[0], o[1]); w.y = pkbf(o[2], o[3]); w.z = pkbf(o[4], o[5]); w.w = pkbf(o[6], o[7]);
                    *(u4_t*)(cat + (size_t)r * D_ + c) = w; }
                ss += __shfl_xor(ss, 16); ss += __shfl_xor(ss, 32); if (fq == 0) atomicAdd(ssq + r, ss);
                asm volatile("" ::: "memory"); }
    }
};
struct EpiBf16RowScale {
    static constexpr bool PERM = true;
    bf16_t* O; int ldc; float scale; const float* ssq;
    __device__ __forceinline__ void operator()(const f32x4 (&acc)[2][2][4][2], const pg8::Unit& u, int wr, int wc, int fr, int fq) const {
        const int row0 = u.orow + wr * 64 + fr, col0 = u.ocol + wc * 32 + 8 * fq;
#pragma unroll
        for (int ai = 0; ai < 2; ++ai)
#pragma unroll
            for (int m = 0; m < 4; ++m) { const int r = row0 + ai * 128 + m * 16; const float sc = rsqrtf(ssq[r] * (1.f / (float)D_) + RMS_EPS) * scale; bf16_t* rowp = O + (size_t)r * ldc + col0;
#pragma unroll
                for (int bj = 0; bj < 2; ++bj) { const f32x4 v0 = acc[ai][bj][m][0] * sc, v1 = acc[ai][bj][m][1] * sc;
                    u32x4 w; w.x = pg8::cvt_pk_bf16(v0[0], v0[1]); w.y = pg8::cvt_pk_bf16(v0[2], v0[3]); w.z = pg8::cvt_pk_bf16(v1[0], v1[1]); w.w = pg8::cvt_pk_bf16(v1[2], v1[3]);
                    *(u32x4*)(rowp + bj * 128) = w; } }
    }
};
struct EpiMoeUp {
    static constexpr bool PERM = true;
    bf16_t* hm;
    __device__ __forceinline__ void operator()(const f32x4 (&acc)[2][2][4][2], const pg8::Unit& u, int wr, int wc, int fr, int fq) const {
        const int row0 = u.orow + wr * 64 + fr, col0 = u.ocol + wc * 32 + 8 * fq;
#pragma unroll
        for (int ai = 0; ai < 2; ++ai)
#pragma unroll
            for (int m = 0; m < 4; ++m) { bf16_t* rowp = hm + (size_t)(row0 + ai * 128 + m * 16) * DE + col0;
                float h[8];
#pragma unroll
                for (int n = 0; n < 2; ++n)
#pragma unroll
                    for (int e = 0; e < 4; ++e) h[n * 4 + e] = siluf_(acc[ai][0][m][n][e]) * acc[ai][1][m][n][e];
                u32x4 w; w.x = pg8::cvt_pk_bf16(h[0], h[1]); w.y = pg8::cvt_pk_bf16(h[2], h[3]); w.z = pg8::cvt_pk_bf16(h[4], h[5]); w.w = pg8::cvt_pk_bf16(h[6], h[7]);
                *(u32x4*)rowp = w; }
    }
};

template <int NCOL> struct MoeOrder {
    const char* A; const char* W; const int* tab; int lda, wrows_per_expert, ldb, ocol_step, G, c;
    __device__ bool next(int i, pg8::Unit& u) const {
        const int L = i * G + c; if (L >= tab[0] * NCOL) return false;
        const int rt = L / NCOL, j = L % NCOL, e = tab[40 + rt];
        u.a = A + (size_t)rt * 256 * lda * 2; u.b = W + ((size_t)e * wrows_per_expert + j * 256) * ldb * 2; u.orow = rt * 256; u.ocol = j * ocol_step; u.aux = 0; return true;
    }
};

struct EpiF32Out {
    static constexpr bool PERM = false;
    float* O; int ldc; size_t aux_stride;
    __device__ __forceinline__ void operator()(const f32x4 (&acc)[2][2][4][2], const pg8::Unit& u, int wr, int wc, int fr, int fq) const {
        const int row0 = u.orow + wr * 64 + fr, col0 = u.ocol + wc * 32 + 4 * fq; float* base = O + (size_t)u.aux * aux_stride;
#pragma unroll
        for (int ai = 0; ai < 2; ++ai)
#pragma unroll
            for (int m = 0; m < 4; ++m) { float* rowp = base + (size_t)(row0 + ai * 128 + m * 16) * ldc + col0;
#pragma unroll
                for (int bj = 0; bj < 2; ++bj)
#pragma unroll
                    for (int n = 0; n < 2; ++n) *(f32x4*)(rowp + bj * 128 + n * 16) = acc[ai][bj][m][n]; }
    }
};
typedef float f32x2 __attribute__((ext_vector_type(2)));
__device__ __forceinline__ f32x2 gelu_pk(f32x2 v) {
    const f32x2 av = __builtin_elementwise_abs(v), d = av * 0.2316418882f + 1.0f;
    f32x2 t; t.x = __builtin_amdgcn_rcpf(d.x); t.y = __builtin_amdgcn_rcpf(d.y);
    f32x2 q = t * 0.5307027145f + (-0.7265760135f); q = q * t + 0.7107068705f; q = q * t + (-0.142248368f); q = q * t + 0.127414796f; q = q * t;
    const f32x2 s = (v * v) * (-0.72134752044f);
    f32x2 e; e.x = __builtin_amdgcn_exp2f(s.x); e.y = __builtin_amdgcn_exp2f(s.y);
    const f32x2 m = v * (q * e), r = v - m;
    f32x2 o; o.x = v.x < 0.f ? m.x : r.x; o.y = v.y < 0.f ? m.y : r.y; return o;
}
struct EpiS5Main {
    static constexpr bool PERM = true;
    bf16_t* gl;
    __device__ __forceinline__ void operator()(const f32x4 (&acc)[2][2][4][2], const pg8::Unit& u, int wr, int wc, int fr, int fq) const {
        const int row0 = u.orow + wr * 64 + fr, col0 = wc * 32 + 8 * fq, g = u.aux;
#pragma unroll
        for (int ai = 0; ai < 2; ++ai)
#pragma unroll
            for (int m = 0; m < 4; ++m) { const int n = row0 + ai * 128 + m * 16;
#pragma unroll
                for (int bj = 0; bj < 2; ++bj) { const int c = col0 + bj * 128, j = c >> 4, co = c & 15; const f32x4 v0 = acc[ai][bj][m][0], v1 = acc[ai][bj][m][1];
                    const f32x2 a = gelu_pk((f32x2){v0[0], v0[1]}), b = gelu_pk((f32x2){v0[2], v0[3]}), c2 = gelu_pk((f32x2){v1[0], v1[1]}), d2 = gelu_pk((f32x2){v1[2], v1[3]});
                    u32x4 w; w.x = pg8::cvt_pk_bf16(a.x, a.y); w.y = pg8::cvt_pk_bf16(b.x, b.y); w.z = pg8::cvt_pk_bf16(c2.x, c2.y); w.w = pg8::cvt_pk_bf16(d2.x, d2.y);
                    *(u32x4*)(gl + ((size_t)n * 16 + j) * S5W + g * 16 + co) = w; } }
    }
};
struct S5Order {
    const char* A; const char* Bm; int ldb, G, c;
    __device__ bool next(int i, pg8::Unit& u) const {
        const int L = i * G + c; if (L >= NG * 4) return false;
        const int g = L >> 2, pm = L & 3;
        u.a = A + ((size_t)g * 1024 + pm * 256) * 512 * 2; u.b = Bm + (size_t)g * 256 * ldb * 2; u.orow = pm * 256; u.ocol = 0; u.aux = g; return true;
    }
};
__device__ __forceinline__ void fp_s5estep(const Params& p, LAS unsigned char* lds, int G, int c) {
    S5Order S{(const char*)(p.ws + WS_AEXT), (const char*)p.out + OUT_EMAT, 256, G, c};
    EpiF32Out E{(float*)(p.ws + WS_HLOC), 256, (size_t)1024 * 256};
    pg8::gemm_phase(lds, 256, 512, 256, S, E);
}
__device__ __forceinline__ void fp_s5main(const Params& p, LAS unsigned char* lds, int G, int c) {
    S5Order S{(const char*)(p.ws + WS_AEXT), (const char*)p.out + OUT_MMAT, 512, G, c};
    EpiS5Main E{(bf16_t*)(p.ws + WS_GL)};
    pg8::gemm_phase(lds, 512, 512, 512, S, E);
}

__device__ __forceinline__ void fp_inproj(const Params& p, LAS unsigned char* lds) {
    pg8::DenseOrder S; S.init((const bf16_t*)(p.ws + WS_HB), D_, (const bf16_t*)((unsigned char*)p.out + OUT_WINT), D_, T_, NINP, gridDim.x, blockIdx.x);
    EpiInproj E{(bf16_t*)(p.ws + WS_QKVR), (bf16_t*)(p.ws + WS_ZB), (float*)((unsigned char*)p.out + OUT_BA), (bf16_t*)(p.ws + WS_AEXT)};
    pg8::gemm_phase(lds, D_, D_, D_, S, E);
}
__device__ __forceinline__ void fp_glu(const Params& p, LAS unsigned char* lds, int G, int c) {
    pg8::DenseOrder S; S.init((const bf16_t*)(p.ws + WS_GL), S5W, (const bf16_t*)((unsigned char*)p.out + OUT_WGLUT), S5W, T_, S5W, G, c);
    EpiGlu E{(const bf16_t*)(p.ws + WS_GL), p.in[I_B_GLU], (bf16_t*)(p.ws + WS_CAT), (float*)(p.ws + WS_SSQ)};
    pg8::gemm_phase(lds, S5W, S5W, S5W, S, E);
}
__device__ __forceinline__ void fp_outproj(const Params& p, LAS unsigned char* lds) {
    pg8::DenseOrder S; S.init((const bf16_t*)(p.ws + WS_CAT), D_, (const bf16_t*)(p.ws + WS_WOUTT), D_, T_, D_, gridDim.x, blockIdx.x);
    EpiResid E{p.in[I_X], nullptr, nullptr, D_, (bf16_t*)(p.ws + WS_XB), (float*)(p.ws + WS_SSQ) + T_};
    pg8::gemm_phase(lds, D_, D_, D_, S, E);
}
__device__ __forceinline__ void fp_kv(const Params& p, LAS unsigned char* lds) {
    {
        pg8::DenseOrder S; S.init((const bf16_t*)(p.ws + WS_MEMN), D_, (const bf16_t*)((unsigned char*)p.out + OUT_WKT), D_, B_ * MEM, D_, gridDim.x, (blockIdx.x + gridDim.x - 192) % gridDim.x);
        EpiBf16Out E{(bf16_t*)(p.ws + WS_KMEM), D_, 1.f, 0};
        pg8::gemm_phase(lds, D_, D_, D_, S, E);
    }
    {
        pg8::DenseOrder S; S.init((const bf16_t*)(p.ws + WS_MEMN), D_, (const bf16_t*)((unsigned char*)p.out + OUT_WVT), D_, B_ * MEM, D_, gridDim.x, (blockIdx.x + gridDim.x - 224) % gridDim.x);
        EpiBf16Out E{(bf16_t*)(p.ws + WS_VMEM), D_, 1.f, 0};
        pg8::gemm_phase(lds, D_, D_, D_, S, E);
    }
}
struct AttnPreOrder {
    const char* Kmem; const char* Vmem; const char* WqB; const char* WoT; int G, c;
    __device__ bool next(int i, pg8::Unit& u) const {
        const int L = i * G + c; if (L >= 256) return false;
        const int x = L & 3, h = (L >> 2) & 3, b = (L >> 4) & 7;
        if (L < 128) { u.a = Kmem + ((size_t)(b * MEM) * D_ + h * XD) * 2; u.b = WqB + ((size_t)(x * 256) * D_ + h * XD) * 2; u.orow = 0; u.ocol = x * 256; u.aux = b * 4 + h; }
        else { u.a = WoT + ((size_t)(x * 256) * D_ + h * XD) * 2; u.b = Vmem + ((size_t)(b * MEM) * D_ + h * XD) * 2; u.orow = x * 256; u.ocol = h * XD; u.aux = 64 + b; }
        return true;
    }
};
struct EpiAttnPre {
    static constexpr bool PERM = true;
    bf16_t* Mq; bf16_t* VWT;
    __device__ __forceinline__ void operator()(const f32x4 (&acc)[2][2][4][2], const pg8::Unit& u, int wr, int wc, int fr, int fq) const {
        bf16_t* base = (u.aux < 64) ? Mq + (size_t)u.aux * MEM * D_ : VWT + (size_t)(u.aux - 64) * D_ * D_;
        const int row0 = u.orow + wr * 64 + fr, col0 = u.ocol + wc * 32 + 8 * fq;
#pragma unroll
        for (int ai = 0; ai < 2; ++ai)
#pragma unroll
            for (int m = 0; m < 4; ++m) { bf16_t* rowp = base + (size_t)(row0 + ai * 128 + m * 16) * D_ + col0;
#pragma unroll
                for (int bj = 0; bj < 2; ++bj) { const f32x4 v0 = acc[ai][bj][m][0], v1 = acc[ai][bj][m][1];
                    u32x4 w; w.x = pg8::cvt_pk_bf16(v0[0], v0[1]); w.y = pg8::cvt_pk_bf16(v0[2], v0[3]); w.z = pg8::cvt_pk_bf16(v1[0], v1[1]); w.w = pg8::cvt_pk_bf16(v1[2], v1[3]);
                    *(u32x4*)(rowp + bj * 128) = w; } }
    }
};
__device__ __forceinline__ void fp_attn_pre(const Params& p, LAS unsigned char* lds) {
    AttnPreOrder S{(const char*)(p.ws + WS_KMEM), (const char*)(p.ws + WS_VMEM), (const char*)(p.ws + WS_WQB), (const char*)(p.ws + WS_WOT), (int)gridDim.x, (int)blockIdx.x};
    EpiAttnPre E{(bf16_t*)(p.ws + WS_MQ), (bf16_t*)(p.ws + WS_VWT)};
    pg8::gemm_phase(lds, XD, D_, D_, S, E);
}
struct AttnSOrder {
    const char* Xb; const char* Mq; int G, c;
    __device__ bool next(int i, pg8::Unit& u) const {
        const int L = i * G + c; if (L >= B_ * XH * 8) return false;
        const int pm = L & 7, h = (L >> 3) & 3, b = L >> 5;
        u.a = Xb + (size_t)(b * S_ + pm * 256) * D_ * 2; u.b = Mq + (size_t)((b * 4 + h) * MEM) * D_ * 2; u.orow = b * S_ + pm * 256; u.ocol = h * XD; u.aux = 0; return true;
    }
};
struct AttnWoOrder {
    const char* Pm; const char* VWT; int G, c;
    __device__ bool next(int i, pg8::Unit& u) const {
        const int L = i * G + c; if (L >= 256) return false;
        const int pn = L & 3, pm = (L >> 2) & 7, b = L >> 5;
        u.a = Pm + (size_t)(b * S_ + pm * 256) * D_ * 2; u.b = VWT + ((size_t)b * D_ + pn * 256) * D_ * 2; u.orow = b * S_ + pm * 256; u.ocol = pn * 256; u.aux = 0; return true;
    }
};
__device__ __forceinline__ void fp_attn_fused(const Params& p, LAS unsigned char* lds) {
    const int L = blockIdx.x; if (L >= B_ * XH * 8) return;
    {
        AttnSOrder S{(const char*)(p.ws + WS_XB), (const char*)(p.ws + WS_MQ), (int)gridDim.x, L};
        EpiBf16RowScale E{(bf16_t*)(p.ws + WS_PB), D_, 0.0625f, (const float*)(p.ws + WS_SSQ) + T_};
        pg8::gemm_phase(lds, D_, D_, D_, S, E);
    }
    {
        const int THR = ltid(); const int lane = THR & 63, wid = THR >> 6;
        const int pm = L & 7, h = (L >> 3) & 3, b = L >> 5;
        bf16_t* base = (bf16_t*)(p.ws + WS_PB) + (size_t)(b * S_ + pm * 256 + wid * 32 + (lane >> 4)) * D_ + h * XD + (lane & 15) * 16;
        u4_t ra[8], rb[8];
#pragma unroll
        for (int i = 0; i < 8; ++i) { ra[i] = *(const u4_t*)(base + (size_t)(4 * i) * D_); rb[i] = *(const u4_t*)(base + (size_t)(4 * i) * D_ + 8); }
#pragma unroll
        for (int i = 0; i < 8; ++i) {
            float v[16];
#pragma unroll
            for (int k = 0; k < 4; ++k) { v[2 * k] = bflo(ra[i][k]); v[2 * k + 1] = bfhi(ra[i][k]); v[8 + 2 * k] = bflo(rb[i][k]); v[9 + 2 * k] = bfhi(rb[i][k]); }
            float mx = v[0];
#pragma unroll
            for (int k = 1; k < 16; ++k) mx = fmaxf(mx, v[k]);
            mx = dpp_max16(mx);
            float sum = 0.f;
#pragma unroll
            for (int k = 0; k < 16; ++k) { v[k] = __expf(v[k] - mx); sum += v[k]; }
            const float inv = 1.f / dpp_sum16(sum);
            u4_t wa, wb;
#pragma unroll
            for (int k = 0; k < 4; ++k) { wa[k] = pkbf(v[2 * k] * inv, v[2 * k + 1] * inv); wb[k] = pkbf(v[8 + 2 * k] * inv, v[9 + 2 * k] * inv); }
            *(u4_t*)(base + (size_t)(4 * i) * D_) = wa; *(u4_t*)(base + (size_t)(4 * i) * D_ + 8) = wb; }
    }
}
__device__ __forceinline__ void fp_woproj(const Params& p, LAS unsigned char* lds) {
    AttnWoOrder S{(const char*)(p.ws + WS_PB), (const char*)(p.ws + WS_VWT), (int)gridDim.x, (int)blockIdx.x};
    EpiResid E{nullptr, (const bf16_t*)(p.ws + WS_XB), nullptr, D_, (bf16_t*)(p.ws + WS_XB), nullptr};
    pg8::gemm_phase(lds, D_, D_, D_, S, E);
}
constexpr int LDS_TAB_OFF = pg8::STAGE_BYTES;
__device__ __forceinline__ void fp_moeup(const Params& p, LAS unsigned char* lds, float* smem) {
    int* tab = (int*)((unsigned char*)smem + LDS_TAB_OFF); moe_build_table(p, tab);
    MoeOrder<2> S{(const char*)(p.ws + WS_XS), (const char*)(p.ws + WS_WGUT), tab, D_, 512, D_, 128, (int)gridDim.x, (int)blockIdx.x};
    EpiMoeUp E{(bf16_t*)(p.ws + WS_HM)};
    pg8::gemm_phase(lds, D_, D_, D_, S, E);
}
__device__ __forceinline__ void fp_moedown(const Params& p, LAS unsigned char* lds, float* smem) {
    int* tab = (int*)((unsigned char*)smem + LDS_TAB_OFF); moe_build_table(p, tab);
    MoeOrder<4> S{(const char*)(p.ws + WS_HM), (const char*)(p.ws + WS_WDT), tab, DE, D_, DE, 256, (int)gridDim.x, (int)blockIdx.x};
    EpiBf16Out E{(bf16_t*)(p.ws + WS_XS), D_, 1.f, 0};
    pg8::gemm_phase(lds, DE, DE, DE, S, E);
}


#define XB_TMO      128
#define XB_XCNT(j)  (256  + 64 * (j))
#define XB_XSUB(j)  (1280 + 64 * (j))
#define XB_XGEN(j)  (2304 + 64 * (j))
#define XB_TOP      3328
#define XB_TOPGEN   3392
#define XCD_BAR_WORDS 3456
#define XB_SPIN_CAP (1u << 18)
__device__ __forceinline__ unsigned xb_ld(unsigned* p)              { return __hip_atomic_load(p, __ATOMIC_RELAXED, __HIP_MEMORY_SCOPE_AGENT); }
__device__ __forceinline__ unsigned xb_add(unsigned* p, unsigned v) { return __hip_atomic_fetch_add(p, v, __ATOMIC_RELAXED, __HIP_MEMORY_SCOPE_AGENT); }
__device__ __forceinline__ unsigned xb_xcc_id() { return (unsigned)__builtin_amdgcn_s_getreg((3 << 11) | 20) & 0xFu; }
#define XB_SPIN(cond, bar) do { unsigned _sp = 0; while (cond) { __builtin_amdgcn_s_sleep(1); \
    if ((++_sp & 255u) == 0u) { if (xb_ld(&(bar)[XB_TMO])) break; if (_sp > XB_SPIN_CAP) { atomicAdd(&(bar)[XB_TMO], 1u); break; } } } } while (0)
struct XcdBarrier { unsigned* bar; unsigned x; volatile LAS unsigned* st; unsigned G; };
__device__ __forceinline__ XcdBarrier xcd_barrier_post(unsigned* bar, volatile LAS unsigned* st, unsigned G) {
    XcdBarrier b; b.bar = bar; b.x = xb_xcc_id(); b.st = st; b.G = G;
    if (threadIdx.x == 0) (void)xb_add(&bar[XB_XCNT(b.x)], 1u);
    return b;
}
__device__ __forceinline__ void xcd_barrier_complete(unsigned* bar, unsigned x, const unsigned G, unsigned& nloc, unsigned& nx) {
    unsigned sum, cnt, mine, sp = 0u;
    for (;;) {
        sum = 0u; cnt = 0u; mine = 0u;
#pragma unroll
        for (unsigned j = 0; j < 16; ++j) { const unsigned c = xb_ld(&bar[XB_XCNT(j)]); sum += c; cnt += (c > 0u) ? 1u : 0u; mine = (j == x) ? c : mine; }
        if (sum == G) break;
        __builtin_amdgcn_s_sleep(1);
        if ((++sp & 255u) == 0u) { if (xb_ld(&bar[XB_TMO])) break; if (sp > XB_SPIN_CAP) { atomicAdd(&bar[XB_TMO], 1u); break; } }
    }
    nloc = mine > 0u ? mine : 1u; nx = cnt > 0u ? cnt : 1u;
}
__device__ __forceinline__ void xcd_barrier(const XcdBarrier& b) {
    asm volatile("s_waitcnt vmcnt(0)" ::: "memory");
    __syncthreads();
    if (threadIdx.x == 0) {
        unsigned* bar = b.bar;
        __builtin_amdgcn_s_waitcnt(0);
        unsigned nloc = b.st[0], nx = b.st[1];
        if (nloc == 0u) { xcd_barrier_complete(bar, b.x, b.G, nloc, nx); b.st[0] = nloc; b.st[1] = nx; }
        const unsigned old = xb_add(&bar[XB_XSUB(b.x)], 1u);
        const unsigned gen = old / nloc;
        if (old + 1u == (gen + 1u) * nloc) {
            __builtin_amdgcn_fence(__ATOMIC_RELEASE, "agent");
            asm volatile("s_waitcnt vmcnt(0)" ::: "memory");
            const unsigned og = xb_add(&bar[XB_TOP], 1u);
            const unsigned tg = og / nx;
            if (og + 1u == (tg + 1u) * nx) xb_add(&bar[XB_TOPGEN], 1u);
            else XB_SPIN(xb_ld(&bar[XB_TOPGEN]) == tg, bar);
            __builtin_amdgcn_fence(__ATOMIC_ACQUIRE, "agent");
            xb_add(&bar[XB_XGEN(b.x)], 1u);
            asm volatile("s_waitcnt vmcnt(0)" ::: "memory");
        } else {
            XB_SPIN(xb_ld(&bar[XB_XGEN(b.x)]) == gen, bar);
            __builtin_amdgcn_fence(__ATOMIC_ACQUIRE, "agent");
            asm volatile("s_waitcnt vmcnt(0)" ::: "memory");
        }
    }
    __syncthreads();
}

constexpr int LDS_BYTES = 147456;
constexpr int LDS_BARST_OFF = LDS_BYTES - 16;

__global__ void __launch_bounds__(NT, 2) mega_fwd(Params p) {
    __shared__ __attribute__((aligned(16))) unsigned char lds_raw[LDS_BYTES];
    float* smem = (float*)lds_raw; LAS unsigned char* lds = (LAS unsigned char*)lds_raw;
    cg::grid_group grid = cg::this_grid();
    if (threadIdx.x < 4) ((LAS unsigned*)(lds + LDS_BARST_OFF))[threadIdx.x] = 0u;
    __syncthreads();
    const XcdBarrier bar = xcd_barrier_post((unsigned*)(p.ws + WS_BAR), (volatile LAS unsigned*)(lds + LDS_BARST_OFF), gridDim.x);
#define GSYNC() xcd_barrier(bar)
    constexpr int GDNB_BLOCKS = B_ * NH * 2 * 2; const int s5G = (int)gridDim.x - GDNB_BLOCKS, s5c = (int)blockIdx.x - GDNB_BLOCKS;
    XcdBarrier bar2 = bar;
    if (s5c >= 0) bar2 = xcd_barrier_post((unsigned*)(p.ws + WS_BAR) + 4096, (volatile LAS unsigned*)(lds + LDS_BARST_OFF) + 2, (unsigned)s5G);
    if (p.ws == nullptr) grid.sync();
    ph_norm1(p, smem); ph_memnorm(p, smem); ph_prep0(p, smem); ph_s5mat(p, smem);  GSYNC();
    fp_inproj(p, lds); fp_kv(p, lds);  GSYNC();
    ph_prepa(p, smem); __syncthreads(); ph_gdna(p, smem);    GSYNC();
    if (s5c < 0) ph_gdnb(p, smem);
    else {
        for (int L = s5c; L < NG * 4; L += s5G) { fp_s5estep(p, lds, NG * 4, L); s5carry_unit(p, L >> 2, L & 3); fp_s5main(p, lds, NG * 4, L); }
        xcd_barrier(bar2); fp_glu(p, lds, s5G, s5c); }
    GSYNC();
    ph_gdncomb(p, smem); ph_prep1(p, smem); __syncthreads(); fp_attn_pre(p, lds); GSYNC();
    fp_outproj(p, lds); ph_prep2(p, smem); GSYNC();
    fp_attn_fused(p, lds); GSYNC();
    fp_woproj(p, lds);   GSYNC();
    ph_router(p, smem, bar);  GSYNC();
    fp_moeup(p, lds, smem);   GSYNC();
    fp_moedown(p, lds, smem); GSYNC();
    ph_final(p, smem);
}

extern "C" void kernel_launch(void* const* d_in, const int* in_sizes, int n_in, void* d_out, int out_size, void* d_ws, size_t ws_size, hipStream_t stream) {
    if (n_in != N_IN || out_size != T_ * D_ || ws_size < 256 * MiB) { fprintf(stderr, "kernel_launch: unexpected shapes n_in=%d out=%d ws=%zu\n", n_in, out_size, ws_size); return; }
    static int grid_blocks = 0;
    if (!grid_blocks) {
        int dev = 0, cus = 0, per_cu = 0;
        (void)hipGetDevice(&dev);
        (void)hipDeviceGetAttribute(&cus, hipDeviceAttributeMultiprocessorCount, dev);
        (void)hipOccupancyMaxActiveBlocksPerMultiprocessor(&per_cu, mega_fwd, NT, 0);
        if (per_cu < 1) { fprintf(stderr, "kernel_launch: occupancy query says %d blocks/CU\n", per_cu); per_cu = 1; }
        grid_blocks = cus;
    }
    Params p{};
    for (int i = 0; i < N_IN; ++i) p.in[i] = (const float*)d_in[i];
    p.out = (float*)d_out; p.ws = (unsigned char*)d_ws;
    (void)hipMemsetAsync((unsigned char*)d_ws + WS_BAR, 0, (4096 + XCD_BAR_WORDS) * 4, stream);
    void* args[] = {&p};
    hipError_t e = hipLaunchCooperativeKernel((void*)mega_fwd, dim3(grid_blocks), dim3(NT), args, 0, stream);
    if (e != hipSuccess) fprintf(stderr, "cooperative launch failed: %s (grid %d)\n", hipGetErrorString(e), grid_blocks);
}
```

```cpp
#include <hip/hip_runtime.h>
#include <hip/hip_cooperative_groups.h>
namespace cg = cooperative_groups;
#include <cstdio>
#include <cstdint>
#include <type_traits>

typedef unsigned short bf16_t;
__device__ __forceinline__ float bf2f(bf16_t v) { return __uint_as_float(((unsigned)v) << 16); }
typedef __bf16 bf16v2e_t __attribute__((ext_vector_type(2)));
typedef float f32v2e_t __attribute__((ext_vector_type(2)));
__device__ __forceinline__ bf16_t f2bf(float f) { const f32v2e_t v = {f, 0.f}; const bf16v2e_t h = __builtin_convertvector(v, bf16v2e_t); return (bf16_t)(__builtin_bit_cast(unsigned, h) & 0xffffu); }

constexpr int B_ = 8, S_ = 2048, T_ = B_ * S_, D_ = 1024, DIN = 2576;
constexpr int S5W = 512, NG = 32, NP = 64, GDW = 512, NH = 4, HD = 128, MEM = 256;
constexpr int XH = 4, XD = 256, NE = 32, DE = 256;
constexpr float RMS_EPS = 1e-6f, L2_EPS = 1e-6f;
constexpr int NT = 512, NW = NT / 64;

struct Params {
    const float* in[48];
    float* out;
    unsigned char* ws;
};
enum { I_X = 0, I_MEM, I_NORM_MIX, I_W_IN, I_W_OUT,
       I_LAM_RE_F, I_LAM_IM_F, I_LOG_STEP_F, I_B_RE_F, I_B_IM_F, I_C_RE_F, I_C_IM_F,
       I_LAM_RE_B, I_LAM_IM_B, I_LOG_STEP_B, I_B_RE_B, I_B_IM_B, I_C_RE_B, I_C_IM_B,
       I_S5_D, I_W_GLU, I_B_GLU, I_S5_NORM,
       I_CONV, I_ALOG_F, I_DTB_F, I_ALOG_B, I_DTB_B, I_GDN_NORM,
       I_NORM_XA, I_NORM_MEM, I_WQ, I_WK, I_WV, I_WO,
       I_NORM_MOE, I_RG_W, I_RG_B, I_RE_W, I_RE_B, I_WGATE, I_WUP, I_WDOWN, I_NORM_FINAL, N_IN };

constexpr size_t MiB = 1u << 20;
constexpr size_t WS_HB   = 16 * MiB;
constexpr size_t WS_GL   = 0;
constexpr size_t WS_QKVR = 192 * MiB;
constexpr size_t WS_ZB   = 48 * MiB;
constexpr size_t WS_QKVC = 112 * MiB;
constexpr size_t WS_YF   = 160 * MiB;
constexpr size_t WS_CAT  = 224 * MiB;
constexpr size_t OUT_BA = 0;
constexpr size_t OUT_GB = 1 * MiB;
constexpr size_t OUT_WINT = 4 * MiB;
constexpr size_t OUT_WGLUT = 10 * MiB;
constexpr int QKV_LD = 1536, NINP = 2816;
constexpr size_t WS_BAR  = 111 * MiB + 768 * 1024;
constexpr size_t WS_AEXT = 160 * MiB;
constexpr size_t WS_HLOC = 192 * MiB;
constexpr size_t OUT_MMAT = 12 * MiB;
constexpr size_t OUT_EMAT = 20 * MiB;
constexpr int S5L = 16, S5NC = S_ / S5L;
constexpr size_t WS_XB   = 0;
constexpr size_t WS_QB   = 32 * MiB;
constexpr size_t WS_PB   = 64 * MiB;
constexpr size_t WS_OB   = 112 * MiB;
constexpr size_t WS_ROUTE = 154 * MiB;
constexpr size_t WS_WRT  = 156 * MiB;
constexpr size_t WS_CNT  = 155 * MiB;
constexpr size_t WS_WOUTT = 144 * MiB;
constexpr size_t WS_WQB  = 104 * MiB;
constexpr size_t WS_WOT  = 106 * MiB;
constexpr size_t WS_MQ   = 160 * MiB;
constexpr size_t WS_VWT  = 128 * MiB;
constexpr size_t WS_KMEM = 96 * MiB;
constexpr size_t WS_VMEM = 100 * MiB;
constexpr size_t WS_MEMN = 104 * MiB;
constexpr size_t WS_SSQ  = 108 * MiB;
constexpr size_t OUT_WKT = 58 * MiB, OUT_WVT = 60 * MiB;
constexpr size_t WS_WGUT = 176 * MiB;
constexpr size_t WS_WDT  = 208 * MiB;
constexpr size_t WS_XS   = 32 * MiB;
constexpr size_t WS_HM   = 112 * MiB;
constexpr int MC_TOT = 0, MC_HIST = 8192;
constexpr int MAXRT = 159;

__device__ __forceinline__ int ltid() { int t = threadIdx.x; asm volatile("" : "+v"(t)); return t; }
__device__ __forceinline__ float dpp_max16(float v) {
    v = fmaxf(v, __int_as_float(__builtin_amdgcn_update_dpp(0, __float_as_int(v), 0xB1, 0xF, 0xF, true)));
    v = fmaxf(v, __int_as_float(__builtin_amdgcn_update_dpp(0, __float_as_int(v), 0x4E, 0xF, 0xF, true)));
    v = fmaxf(v, __int_as_float(__builtin_amdgcn_update_dpp(0, __float_as_int(v), 0x141, 0xF, 0xF, true)));
    v = fmaxf(v, __int_as_float(__builtin_amdgcn_update_dpp(0, __float_as_int(v), 0x140, 0xF, 0xF, true)));
    return v;
}
__device__ __forceinline__ float dpp_sum16(float v) {
    v += __int_as_float(__builtin_amdgcn_update_dpp(0, __float_as_int(v), 0xB1, 0xF, 0xF, true));
    v += __int_as_float(__builtin_amdgcn_update_dpp(0, __float_as_int(v), 0x4E, 0xF, 0xF, true));
    v += __int_as_float(__builtin_amdgcn_update_dpp(0, __float_as_int(v), 0x141, 0xF, 0xF, true));
    v += __int_as_float(__builtin_amdgcn_update_dpp(0, __float_as_int(v), 0x140, 0xF, 0xF, true));
    return v;
}
__device__ __forceinline__ float wave_sum(float v) {
    v += __int_as_float(__builtin_amdgcn_update_dpp(0, __float_as_int(v), 0xB1, 0xF, 0xF, true));
    v += __int_as_float(__builtin_amdgcn_update_dpp(0, __float_as_int(v), 0x4E, 0xF, 0xF, true));
    v += __int_as_float(__builtin_amdgcn_update_dpp(0, __float_as_int(v), 0x141, 0xF, 0xF, true));
    v += __int_as_float(__builtin_amdgcn_update_dpp(0, __float_as_int(v), 0x140, 0xF, 0xF, true));
    v += __int_as_float(__builtin_amdgcn_update_dpp(0, __float_as_int(v), 0x142, 0xA, 0xF, false));
    v += __int_as_float(__builtin_amdgcn_update_dpp(0, __float_as_int(v), 0x143, 0xC, 0xF, false));
    return __int_as_float(__builtin_amdgcn_readlane(__float_as_int(v), 63));
}
__device__ __forceinline__ float sigmoidf_(float x) { return __builtin_amdgcn_rcpf(1.f + __expf(-x)); }
__device__ __forceinline__ float siluf_(float x) { return x * sigmoidf_(x); }
__device__ __forceinline__ float softplusf_(float x) { return x > 20.f ? x : log1pf(__expf(x)); }
__device__ __forceinline__ float geluf_(float x) { return 0.5f * x * (1.f + erff(x * 0.70710678118654752f)); }

template <class TA> __device__ __forceinline__ float ldA(const TA* p);
template <> __device__ __forceinline__ float ldA<float>(const float* p) { return *p; }
template <> __device__ __forceinline__ float ldA<bf16_t>(const bf16_t* p) { return bf2f(*p); }

typedef float f4_t __attribute__((ext_vector_type(4)));
typedef unsigned u2_t __attribute__((ext_vector_type(2)));
typedef unsigned u4_t __attribute__((ext_vector_type(4)));
__device__ __forceinline__ unsigned pkbf(float lo, float hi);
__device__ __forceinline__ float bflo(unsigned u) { return __uint_as_float(u << 16); }
__device__ __forceinline__ float bfhi(unsigned u) { return __uint_as_float(u & 0xffff0000u); }
__device__ __forceinline__ void rmsnorm_rows_bf16(const float* X, const float* gain, bf16_t* Y, int rows, int width) {
    const int THR = ltid();
    const int lane = THR & 63, gw = blockIdx.x * NW + (THR >> 6), nw = gridDim.x * NW;
    f4_t g[4];
#pragma unroll
    for (int j = 0; j < 4; ++j) g[j] = ((const f4_t*)gain)[lane + 64 * j];
    for (int r0 = gw * 4; r0 < rows; r0 += nw * 4) {
        f4_t v[4][4];
#pragma unroll
        for (int r = 0; r < 4; ++r)
#pragma unroll
            for (int j = 0; j < 4; ++j) v[r][j] = ((const f4_t*)(X + (size_t)(r0 + r) * 1024))[lane + 64 * j];
#pragma unroll
        for (int r = 0; r < 4; ++r) { float ss = 0.f;
#pragma unroll
            for (int j = 0; j < 4; ++j) ss += v[r][j].x * v[r][j].x + v[r][j].y * v[r][j].y + v[r][j].z * v[r][j].z + v[r][j].w * v[r][j].w;
            const float rs = rsqrtf(wave_sum(ss) * (1.f / 1024.f) + RMS_EPS);
#pragma unroll
            for (int j = 0; j < 4; ++j) { const f4_t o = v[r][j] * rs * g[j]; u2_t w; w.x = pkbf(o.x, o.y); w.y = pkbf(o.z, o.w); ((u2_t*)(Y + (size_t)(r0 + r) * 1024))[lane + 64 * j] = w; } }
    }
}

namespace pg8 {
#define PG8_LAS __attribute__((address_space(3)))
typedef short bf16x8 __attribute__((ext_vector_type(8)));
typedef float f32x4 __attribute__((ext_vector_type(4)));
typedef unsigned u32x4 __attribute__((ext_vector_type(4)));
typedef unsigned u32x2 __attribute__((ext_vector_type(2)));
constexpr int BM = 256, BK = 64, HALF = 128, HTB = HALF * BK * 2, STAGE_BYTES = 8 * HTB;
__device__ __forceinline__ int lds_byte(int r, int c) { const int st = (r >> 4) * 2 + (c >> 5), rr = r & 15, cc = c & 31, ob = rr * 64 + cc * 2; return st * 1024 + (ob ^ (((ob >> 9) & 1) << 5)); }
__device__ __forceinline__ void stage_rc(int b, int& R, int& C) { const int st = b / 1024, sb = b % 1024, swz = sb ^ (((sb >> 9) & 1) << 5); R = (st >> 1) * 16 + swz / 64; C = (st & 1) * 32 + (swz % 64) / 2; }
__device__ __forceinline__ int perm32(int rho) { const int n = rho >> 4, i = rho & 15; return 8 * (i >> 2) + 4 * n + (i & 3); }
typedef __bf16 bf16v2_t __attribute__((ext_vector_type(2)));
typedef float f32v2_t __attribute__((ext_vector_type(2)));
__device__ __forceinline__ unsigned cvt_pk_bf16(float lo, float hi) { const f32v2_t f = {lo, hi}; const bf16v2_t h = __builtin_convertvector(f, bf16v2_t); return __builtin_bit_cast(unsigned, h); }
}
__device__ __forceinline__ unsigned pkbf(float lo, float hi) { return pg8::cvt_pk_bf16(lo, hi); }
namespace pg8 {

struct Unit { const char* a; const char* b; int orow, ocol, aux; };
struct DenseOrder {
    const char* A; const char* Bt; int lda, ldb, nM, nN, nwg, G, c;
    __device__ void init(const bf16_t* A_, int lda_, const bf16_t* Bt_, int ldb_, int M, int N, int G_, int c_) { A = (const char*)A_; Bt = (const char*)Bt_; lda = lda_; ldb = ldb_; nM = M / BM; nN = N / BM; nwg = nM * nN; G = G_; c = c_; }
    __device__ bool next(int i, Unit& u) const {
        const long L = (long)i * G + c; if (L >= nwg) return false;
        int wgid = (int)L; { const int q = nwg / 8, r = nwg % 8, xcd = wgid % 8, off = wgid / 8; wgid = (xcd < r ? xcd * (q + 1) : r * (q + 1) + (xcd - r) * q) + off; }
        const int nig = 8 * nN, gid = wgid / nig, fm = gid * 8, gsz = (nM - fm) < 8 ? (nM - fm) : 8;
        const int pm = fm + ((wgid % nig) % gsz), pn = (wgid % nig) / gsz;
        u.a = A + (size_t)pm * BM * lda * 2; u.b = Bt + (size_t)pn * BM * ldb * 2; u.orow = pm * BM; u.ocol = pn * BM; u.aux = pn; return true;
    }
};

template <class Epi, class Sched>
__device__ __forceinline__ void gemm_phase(PG8_LAS unsigned char* lds, const int K, const int lda, const int ldb, const Sched& S, const Epi& E) {
    int tid_ = threadIdx.x; asm volatile("" : "+v"(tid_));
    const int tid = tid_, wid = __builtin_amdgcn_readfirstlane(tid >> 6), lane = tid & 63, wr = wid >> 2, wc = wid & 3, fr = lane & 15, fq = lane >> 4;
    const int nt = K / BK;
    unsigned voffA[2], voffB[2];
#pragma unroll
    for (int i = 0; i < 2; ++i) { int R, C; stage_rc(tid * 16 + i * 8192, R, C); const int Rb = Epi::PERM ? ((R & ~31) + perm32(R & 31)) : R;
        voffA[i] = (unsigned)(R * lda + C) * 2u; voffB[i] = (unsigned)(Rb * ldb + C) * 2u; }
    const size_t kstep = (size_t)(BK * 2);
    const size_t hstepA = (size_t)HALF * lda * 2, hstepB = (size_t)HALF * ldb * 2;
    const unsigned ldsw = (unsigned)wid * 1024u;
    const int aoff = lds_byte(wr * 64 + fr, fq * 8), boff = lds_byte(wc * 32 + fr, fq * 8);
#define PG8_SA(b, h) (((b) * 2 + (h)) * HTB)
#define PG8_SB(b, h) ((4 + (b) * 2 + (h)) * HTB)
#define PG8_STAGE(bufoff, gbase, voff) do { _Pragma("unroll") for (int _i = 0; _i < 2; ++_i) \
        __builtin_amdgcn_global_load_lds((const unsigned*)((const char*)(gbase) + (voff)[_i]), (PG8_LAS unsigned*)(lds + (bufoff) + ldsw + _i * 8192), 16, 0, 0); } while (0)
#define PG8_LDA(dst, b, h) do { _Pragma("unroll") for (int m = 0; m < 4; ++m) _Pragma("unroll") for (int k = 0; k < 2; ++k) dst[m][k] = *(const PG8_LAS bf16x8*)(lds + PG8_SA(b, h) + aoff + m * 2048 + k * 1024); } while (0)
#define PG8_LDB(dst, b, h) do { _Pragma("unroll") for (int n = 0; n < 2; ++n) _Pragma("unroll") for (int k = 0; k < 2; ++k) dst[n][k] = *(const PG8_LAS bf16x8*)(lds + PG8_SB(b, h) + boff + n * 2048 + k * 1024); } while (0)
#define PG8_MMA(ai, bj, At, Bt) do { __builtin_amdgcn_s_setprio(1); _Pragma("unroll") for (int m = 0; m < 4; ++m) _Pragma("unroll") for (int n = 0; n < 2; ++n) _Pragma("unroll") for (int k = 0; k < 2; ++k) \
        acc[ai][bj][m][n] = __builtin_amdgcn_mfma_f32_16x16x32_bf16(Bt[n][k], At[m][k], acc[ai][bj][m][n], 0, 0, 0); __builtin_amdgcn_s_setprio(0); } while (0)
#define PG8_WAIT_V(n) asm volatile("s_waitcnt vmcnt(" #n ")" ::: "memory")
#define PG8_WAIT_L(n) asm volatile("s_waitcnt lgkmcnt(" #n ")" ::: "memory")
#define PG8_BAR __builtin_amdgcn_s_barrier()
#define PG8_SCHED __builtin_amdgcn_sched_barrier(0)
    Unit cur, nxt; int ui = 0;
    if (!S.next(0, cur)) return;
    f32x4 acc[2][2][4][2];
#pragma unroll
    for (int a = 0; a < 2; ++a)
#pragma unroll
        for (int b = 0; b < 2; ++b)
#pragma unroll
            for (int m = 0; m < 4; ++m)
#pragma unroll
                for (int n = 0; n < 2; ++n) acc[a][b][m][n] = (f32x4){0.f, 0.f, 0.f, 0.f};
    bf16x8 At[4][2], B0[2][2], B1[2][2];
    const char* cA = cur.a; const char* cB = cur.b;
    PG8_STAGE(PG8_SB(0, 0), cB, voffB); PG8_STAGE(PG8_SA(0, 0), cA, voffA); PG8_STAGE(PG8_SB(0, 1), cB + hstepB, voffB); PG8_STAGE(PG8_SA(0, 1), cA + hstepA, voffA);
    if (wr == 1) PG8_BAR;
    PG8_WAIT_V(4); PG8_BAR;
    PG8_STAGE(PG8_SB(1, 0), cB + kstep, voffB); PG8_STAGE(PG8_SA(1, 0), cA + kstep, voffA); PG8_STAGE(PG8_SB(1, 1), cB + hstepB + kstep, voffB);
    PG8_WAIT_V(6); PG8_BAR;
    for (;;) {
        const bool has_next = S.next(ui + 1, nxt);
        const char* nA = has_next ? nxt.a : cA; const char* nB = has_next ? nxt.b : cB;
        for (int t = 0; t < nt; t += 2) {
            const bool last = (t == nt - 2);
            const char* a1 = cA + (size_t)(t + 1) * kstep;
            const char* a2 = last ? nA : cA + (size_t)(t + 2) * kstep; const char* b2 = last ? nB : cB + (size_t)(t + 2) * kstep;
            const char* a3 = a2 + kstep; const char* b3 = b2 + kstep;
            PG8_LDB(B0, 0, 0); PG8_SCHED; PG8_LDA(At, 0, 0); PG8_STAGE(PG8_SA(1, 1), a1 + hstepA, voffA);
            PG8_WAIT_L(8); PG8_BAR; PG8_WAIT_L(0); PG8_MMA(0, 0, At, B0); PG8_BAR; PG8_SCHED;
            PG8_LDB(B1, 0, 1); PG8_STAGE(PG8_SB(0, 0), b2, voffB);
            PG8_BAR; PG8_WAIT_L(0); PG8_MMA(0, 1, At, B1); PG8_BAR;
            PG8_LDA(At, 0, 1); PG8_STAGE(PG8_SA(0, 0), a2, voffA);
            PG8_BAR; PG8_WAIT_L(0); PG8_MMA(1, 0, At, B0); PG8_BAR; PG8_SCHED;
            PG8_STAGE(PG8_SB(0, 1), b2 + hstepB, voffB);
            PG8_WAIT_V(6); PG8_BAR; PG8_MMA(1, 1, At, B1); PG8_BAR;
            PG8_LDB(B0, 1, 0); PG8_SCHED; PG8_LDA(At, 1, 0); PG8_STAGE(PG8_SA(0, 1), a2 + hstepA, voffA);
            PG8_WAIT_L(8); PG8_BAR; PG8_WAIT_L(0); PG8_MMA(0, 0, At, B0); PG8_BAR; PG8_SCHED;
            PG8_LDB(B1, 1, 1); PG8_STAGE(PG8_SB(1, 0), b3, voffB);
            PG8_BAR; PG8_WAIT_L(0); PG8_MMA(0, 1, At, B1); PG8_BAR;
            PG8_LDA(At, 1, 1); PG8_STAGE(PG8_SA(1, 0), a3, voffA);
            PG8_BAR; PG8_WAIT_L(0); PG8_MMA(1, 0, At, B0); PG8_BAR; PG8_SCHED;
            PG8_STAGE(PG8_SB(1, 1), b3 + hstepB, voffB);
            PG8_WAIT_V(6); PG8_BAR; PG8_MMA(1, 1, At, B1); PG8_BAR;
        }
        E(acc, cur, wr, wc, fr, fq);
        if (!has_next) break;
#pragma unroll
        for (int a = 0; a < 2; ++a)
#pragma unroll
            for (int b = 0; b < 2; ++b)
#pragma unroll
                for (int m = 0; m < 4; ++m)
#pragma unroll
                    for (int n = 0; n < 2; ++n) acc[a][b][m][n] = (f32x4){0.f, 0.f, 0.f, 0.f};
        cur = nxt; cA = nA; cB = nB; ++ui;
    }
    PG8_WAIT_V(0);
    if (wr == 0) PG8_BAR;
    PG8_BAR;
#undef PG8_SA
#undef PG8_SB
#undef PG8_STAGE
#undef PG8_LDA
#undef PG8_LDB
#undef PG8_MMA
#undef PG8_WAIT_V
#undef PG8_WAIT_L
#undef PG8_BAR
#undef PG8_SCHED
}
}
typedef pg8::f32x4 f32x4; typedef pg8::u32x4 u32x4;
#define LAS __attribute__((address_space(3)))

#define LAS __attribute__((address_space(3)))

__device__ __forceinline__ void ph_norm1(const Params& p, float* smem) {
    rmsnorm_rows_bf16(p.in[I_X], p.in[I_NORM_MIX], (bf16_t*)(p.ws + WS_HB), T_, D_);
}
__device__ __forceinline__ void ph_memnorm(const Params& p, float* smem) {
    rmsnorm_rows_bf16(p.in[I_MEM], p.in[I_NORM_MEM], (bf16_t*)(p.ws + WS_MEMN), B_ * MEM, D_);
}
__device__ __forceinline__ void ph_s5mat(const Params& p, float* smem) {
    const int THR = ltid();
    bf16_t* Mm = (bf16_t*)((unsigned char*)p.out + OUT_MMAT); bf16_t* Em = (bf16_t*)((unsigned char*)p.out + OUT_EMAT);
    float* lp = smem;
    float* cf = smem + 640;
    float* Bb = smem + 896;
    float* kk = smem + 896 + 4096;
    __syncthreads();
    for (int item = blockIdx.x; item < NG * S5L; item += gridDim.x) {
        const int g = item >> 4, j = item & 15;
        if (THR < 320) {
            const int which = THR >> 6, pp = THR & 63; const int dir = (which == 1 || which == 4) ? 1 : 0;
            const int o = dir ? (I_LAM_RE_B - I_LAM_RE_F) : 0;
            const float lre = p.in[I_LAM_RE_F + o][g * NP + pp], lim = p.in[I_LAM_IM_F + o][g * NP + pp], step = __expf(p.in[I_LOG_STEP_F + o][g]);
            const float pw = (float)(which == 0 ? j : which == 1 ? j : which == 2 ? (15 - j) : which == 3 ? (j + 1) : (16 - j));
            const float er = expf(lre * step * pw); float sn, cs; sincosf(lim * step * pw, &sn, &cs);
            lp[(which * 64 + pp) * 2] = er * cs; lp[(which * 64 + pp) * 2 + 1] = er * sn;
            if (which < 2) {
                const float e1 = expf(lre * step); float s1, c1; sincosf(lim * step, &s1, &c1);
                const float nr = e1 * c1 - 1.f, ni = e1 * s1, den = lre * lre + lim * lim;
                cf[(dir * 64 + pp) * 2] = (nr * lre + ni * lim) / den; cf[(dir * 64 + pp) * 2 + 1] = (ni * lre - nr * lim) / den;
            }
        }
        __syncthreads();
        for (int e = THR; e < 2048; e += NT) {
            const int dir = e >> 10, pp = (e >> 4) & 63, ci = e & 15; const int o = dir ? (I_LAM_RE_B - I_LAM_RE_F) : 0;
            const float br = p.in[I_B_RE_F + o][(g * NP + pp) * 16 + ci], bi = p.in[I_B_IM_F + o][(g * NP + pp) * 16 + ci];
            const float cr = cf[(dir * 64 + pp) * 2], ci_ = cf[(dir * 64 + pp) * 2 + 1];
            Bb[e * 2] = cr * br - ci_ * bi; Bb[e * 2 + 1] = cr * bi + ci_ * br;
        }
        __syncthreads();
        {
            const int dir = THR >> 8, co = (THR >> 4) & 15, ci = THR & 15; const int o = dir ? (I_LAM_RE_B - I_LAM_RE_F) : 0;
            const float* cre = p.in[I_C_RE_F + o] + (g * 16 + co) * NP; const float* cim = p.in[I_C_IM_F + o] + (g * 16 + co) * NP;
            float acc = 0.f;
            for (int pp = 0; pp < 64; ++pp) {
                const float lr = lp[(dir * 64 + pp) * 2], li = lp[(dir * 64 + pp) * 2 + 1], c_r = cre[pp], c_i = cim[pp];
                const float clr = c_r * lr - c_i * li, cli = c_r * li + c_i * lr;
                acc += clr * Bb[((dir * 64 + pp) * 16 + ci) * 2] - cli * Bb[((dir * 64 + pp) * 16 + ci) * 2 + 1];
            }
            kk[THR] = acc;
        }
        __syncthreads();
        {
            const int dir = THR >> 8, co = (THR >> 4) & 15, ci = THR & 15; bf16_t* Mg = Mm + (size_t)g * 256 * 512;
            if (j == 0) { if (dir == 0) { const bf16_t v = f2bf(kk[THR] + kk[256 + THR] + (co == ci ? p.in[I_S5_D][g * 16 + co] : 0.f));
                    for (int jj = 0; jj < 16; ++jj) Mg[(size_t)(jj * 16 + co) * 512 + jj * 16 + ci] = v; } }
            else { const bf16_t v = f2bf(kk[THR]);
                if (dir == 0) { for (int jj = j; jj < 16; ++jj) Mg[(size_t)(jj * 16 + co) * 512 + (jj - j) * 16 + ci] = v; }
                else { for (int jj = 0; jj + j < 16; ++jj) Mg[(size_t)(jj * 16 + co) * 512 + (jj + j) * 16 + ci] = v; } }
        }
        for (int e = THR; e < 2048; e += NT) {
            const int dir = e >> 10, co = (e >> 6) & 15, pp = e & 63; const int o = dir ? (I_LAM_RE_B - I_LAM_RE_F) : 0;
            const float c_r = p.in[I_C_RE_F + o][(g * 16 + co) * NP + pp], c_i = p.in[I_C_IM_F + o][(g * 16 + co) * NP + pp];
            const int w = dir ? 4 : 3; const float lr = lp[(w * 64 + pp) * 2], li = lp[(w * 64 + pp) * 2 + 1];
            bf16_t* row = Mm + ((size_t)g * 256 + j * 16 + co) * 512 + 256 + dir * 128;
            row[pp] = f2bf(c_r * lr - c_i * li); row[64 + pp] = f2bf(-(c_r * li + c_i * lr));
        }
        for (int e = THR; e < 2048; e += NT) {
            const int dir = e >> 10, pp = (e >> 4) & 63, ci = e & 15;
            const int w = dir ? 1 : 2; const float lr = lp[(w * 64 + pp) * 2], li = lp[(w * 64 + pp) * 2 + 1];
            const float br = Bb[e * 2], bi = Bb[e * 2 + 1];
            bf16_t* Eg = Em + (size_t)g * 256 * 256;
            Eg[(size_t)(dir * 128 + pp) * 256 + j * 16 + ci] = f2bf(lr * br - li * bi);
            Eg[(size_t)(dir * 128 + 64 + pp) * 256 + j * 16 + ci] = f2bf(lr * bi + li * br);
        }
        __syncthreads();
    }
}
__device__ __forceinline__ void s5carry_unit(const Params& p, int g, int pm) {
    const int THR = ltid();
    if (THR < 256) {
        const float* Hl = (const float*)(p.ws + WS_HLOC); bf16_t* Ax = (bf16_t*)(p.ws + WS_AEXT);
        const int pp = THR & 63, dir = (THR >> 6) & 1, b = 2 * pm + (THR >> 7); const int o = dir ? (I_LAM_RE_B - I_LAM_RE_F) : 0;
        const float lre = p.in[I_LAM_RE_F + o][g * NP + pp], lim = p.in[I_LAM_IM_F + o][g * NP + pp], step = __expf(p.in[I_LOG_STEP_F + o][g]);
        const float er = expf(lre * step * (float)S5L); float sn, cs; sincosf(lim * step * (float)S5L, &sn, &cs);
        const float lr = er * cs, li = er * sn;
        float hr = 0.f, hi = 0.f;
        const size_t rowbase = (size_t)g * 1024 + (size_t)b * S5NC;
        for (int s0 = 0; s0 < S5NC; s0 += 16) {
            float lr_[16], li_[16];
#pragma unroll
            for (int k = 0; k < 16; ++k) { const int c = dir ? (S5NC - 1 - (s0 + k)) : (s0 + k); const float* hl = Hl + (rowbase + c) * 256 + dir * 128; lr_[k] = hl[pp]; li_[k] = hl[64 + pp]; }
#pragma unroll
            for (int k = 0; k < 16; ++k) { const int c = dir ? (S5NC - 1 - (s0 + k)) : (s0 + k);
                bf16_t* ar = Ax + (rowbase + c) * 512 + 256 + dir * 128; ar[pp] = f2bf(hr); ar[64 + pp] = f2bf(hi);
                const float nr = lr * hr - li * hi + lr_[k], ni = lr * hi + li * hr + li_[k]; hr = nr; hi = ni; }
        }
    }
    asm volatile("s_waitcnt vmcnt(0)" ::: "memory");
    __syncthreads();
}
constexpr size_t WS_GW   = 16 * MiB;
constexpr size_t WS_GUT  = 64 * MiB;
constexpr size_t WS_GQK  = 128 * MiB;
constexpr size_t WS_GKT  = 144 * MiB;
constexpr size_t WS_GQN  = 112 * MiB;
constexpr size_t OUT_GSC = 24 * MiB;
constexpr size_t OUT_GO  = 26 * MiB;
typedef short bf16x4 __attribute__((ext_vector_type(4)));
typedef pg8::bf16x8 bf16x8;
__device__ __forceinline__ bf16x8 cat44(bf16x4 lo, bf16x4 hi) { return __builtin_shufflevector(lo, hi, 0, 1, 2, 3, 4, 5, 6, 7); }
__device__ __forceinline__ bf16x4 pack4(float a, float b, float c, float d) { union { unsigned u[2]; bf16x4 v; } x; x.u[0] = pg8::cvt_pk_bf16(a, b); x.u[1] = pg8::cvt_pk_bf16(c, d); return x.v; }

__host__ __device__ constexpr int gdna_pieces_before(int i) { return i <= 16 ? i - 1 : i <= 32 ? 16 + 2 * (i - 17) : i <= 48 ? 48 + 3 * (i - 33) : 96 + 4 * (i - 49); }
__device__ __forceinline__ void ph_gdna(const Params& p, float* smem) {
    LAS unsigned char* L = (LAS unsigned char*)smem;
    constexpr int KS = 0, QS = 17408, VS = 34816, KT = 52224, VT = 70656, KK = 89088, QKR = 105728, SC = 122368, TB = 124416;
    constexpr int AF = KS, AB = QS, TF = KK;
    LAS float* sc = (LAS float*)(L + SC);
    const bf16_t* proj = (const bf16_t*)(p.ws + WS_QKVR); const float* ba = (const float*)((unsigned char*)p.out + OUT_BA); const float* cw = p.in[I_CONV]; bf16_t* GQN = (bf16_t*)(p.ws + WS_GQN);
    bf16_t* GW = (bf16_t*)(p.ws + WS_GW); bf16_t* GUT = (bf16_t*)(p.ws + WS_GUT); bf16_t* GQK = (bf16_t*)(p.ws + WS_GQK); bf16_t* GKT = (bf16_t*)(p.ws + WS_GKT);
    float* GSC = (float*)((unsigned char*)p.out + OUT_GSC);
    auto loadraw = [&](unsigned (&rw)[3][12], float& bav, int it) {
        const int THR = ltid(); const int lane = THR & 63, wid = THR >> 6;
        const int n = it & 31, h = (it >> 5) & 3, b = it >> 7, t0 = b * S_ + n * 64, s0 = n * 64 + wid * 8;
#pragma unroll
        for (int mat = 0; mat < 3; ++mat)
#pragma unroll
            for (int r = 0; r < 12; ++r) { const int sq = s0 - 2 + r; unsigned raw = 0u;
                if (sq >= 0 && sq < S_) raw = *(const unsigned*)(proj + (size_t)(b * S_ + sq) * QKV_LD + mat * 512 + h * 128 + lane * 2);
                rw[mat][r] = raw; }
        bav = 0.f;
        if (THR < 256) { const int i = THR & 63, w = THR >> 6; bav = ba[(size_t)(t0 + i) * 16 + (w == 0 ? 8 + h : w == 1 ? 12 + h : w == 2 ? h : 4 + h)]; }
    };
    const bool fixed_h = (gridDim.x % 128u) == 0u;
    float cwa[3][5], cwb[3][5];
    auto loadtaps = [&](int h) {
        const int lane = ltid() & 63;
#pragma unroll
        for (int mat = 0; mat < 3; ++mat)
#pragma unroll
            for (int k = 0; k < 5; ++k) { const int col = mat * 512 + h * 128 + lane * 2; cwa[mat][k] = cw[k * 1536 + col]; cwb[mat][k] = cw[k * 1536 + col + 1]; }
    };
    loadtaps((blockIdx.x >> 5) & 3);
    unsigned rawc[3][12]; float bac = 0.f;
    if ((int)blockIdx.x < B_ * NH * 32) loadraw(rawc, bac, blockIdx.x);
    for (int item = blockIdx.x; item < B_ * NH * 32; item += gridDim.x) {
        const int THR = ltid();
        const int lane = THR & 63, wid = THR >> 6, l15 = lane & 15, q4 = lane >> 4;
        const int n = item & 31, h = (item >> 5) & 3, b = item >> 7, t0 = b * S_ + n * 64;
        if (!fixed_h) loadtaps(h);
        if (THR < 256) { const int i = THR & 63, w = THR >> 6; const float r = bac;
            sc[w * 64 + i] = (w < 2) ? -__expf(p.in[w ? I_ALOG_B : I_ALOG_F][h]) * softplusf_(r + p.in[w ? I_DTB_B : I_DTB_F][h]) : sigmoidf_(r); }
        {
#pragma unroll
            for (int mat = 0; mat < 3; ++mat) {
                float w0[5], w1[5], x0[12], x1[12];
#pragma unroll
                for (int k = 0; k < 5; ++k) { w0[k] = cwa[mat][k]; w1[k] = cwb[mat][k]; }
#pragma unroll
                for (int r = 0; r < 12; ++r) { const unsigned raw = rawc[mat][r]; x0[r] = __uint_as_float(raw << 16); x1[r] = __uint_as_float(raw & 0xffff0000u); }
#pragma unroll
                for (int tk = 0; tk < 8; ++tk) { float a0 = 0.f, a1 = 0.f;
#pragma unroll
                    for (int k = 0; k < 5; ++k) { a0 = fmaf(w0[k], x0[tk + k], a0); a1 = fmaf(w1[k], x1[tk + k], a1); }
                    float y0 = siluf_(a0), y1 = siluf_(a1);
                    if (mat < 2) { float scl = rsqrtf(wave_sum(y0 * y0 + y1 * y1) + L2_EPS); if (mat == 0) scl *= 0.08838834764831845f; y0 *= scl; y1 *= scl; }
                    *(LAS unsigned*)(L + (mat == 0 ? QS : mat == 1 ? KS : VS) + (wid * 8 + tk) * 272 + lane * 4) = pg8::cvt_pk_bf16(y0, y1); }
            }
        }
        unsigned rawn[3][12]; float ban = 0.f;
        if (item + (int)gridDim.x < B_ * NH * 32) loadraw(rawn, ban, item + gridDim.x);
        __syncthreads();
        if (wid < 2) { float v = sc[wid * 64 + (wid ? 63 - lane : lane)];
#pragma unroll
            for (int o = 1; o < 64; o <<= 1) { const float t = __shfl_up(v, o); if (lane >= o) v += t; }
            sc[256 + wid * 64 + (wid ? 63 - lane : lane)] = v; }
        {
#pragma unroll
            for (int i = 0; i < 2; ++i) { const int e = THR + i * NT, row = e >> 4, ch = e & 15; *(u32x4*)(GQN + (size_t)item * 8192 + row * 128 + ch * 8) = *(const LAS u32x4*)(L + QS + row * 272 + ch * 16); }
            const int tok0 = 4 * (THR & 15), c0 = 4 * (THR >> 4);
#pragma unroll
            for (int mat = 0; mat < 2; ++mat) { const int src = mat ? VS : KS, dst = mat ? VT : KT; bf16x4 r[4];
#pragma unroll
                for (int i = 0; i < 4; ++i) r[i] = *(const LAS bf16x4*)(L + src + (tok0 + i) * 272 + c0 * 2);
#pragma unroll
                for (int c = 0; c < 4; ++c) { bf16x4 o; o[0] = r[0][c]; o[1] = r[1][c]; o[2] = r[2][c]; o[3] = r[3][c]; *(LAS bf16x4*)(L + dst + (c0 + c) * 144 + tok0 * 2) = o; } }
        }
#pragma unroll
        for (int ti = 0; ti < 4; ++ti) { const int id = wid * 4 + ti, mat = id >> 4, it = (id >> 2) & 3, jt = id & 3; f32x4 acc = {0.f, 0.f, 0.f, 0.f};
#pragma unroll
            for (int s4 = 0; s4 < 4; ++s4) { const bf16x8 a = *(const LAS bf16x8*)(L + (mat ? QS : KS) + (16 * it + l15) * 272 + (32 * s4 + 8 * q4) * 2);
                const bf16x8 bb = *(const LAS bf16x8*)(L + KS + (16 * jt + l15) * 272 + (32 * s4 + 8 * q4) * 2);
                acc = __builtin_amdgcn_mfma_f32_16x16x32_bf16(a, bb, acc, 0, 0, 0); }
            LAS float* dst = (LAS float*)(L + (mat ? QKR : KK));
#pragma unroll
            for (int r = 0; r < 4; ++r) dst[(16 * it + 4 * q4 + r) * 65 + 16 * jt + l15] = acc[r]; }
        __syncthreads();
        {
            LAS float* kk = (LAS float*)(L + KK); LAS float* qr = (LAS float*)(L + QKR); LAS float* af = (LAS float*)(L + AF); LAS float* ab = (LAS float*)(L + AB);
            bf16_t* qkf = GQK + (size_t)(item * 2) * 4096; bf16_t* qkb = qkf + 4096;
            const int i = THR >> 3, j0 = (THR & 7) * 8;
            const float gfi = sc[256 + i], gbi = sc[320 + i], bfi = sc[128 + i], bbi = sc[192 + i];
            float vf[8], vb[8], qf[8], qb[8];
#pragma unroll
            for (int e = 0; e < 8; ++e) { const int j = j0 + e; const float kv = kk[i * 65 + j], qv = qr[i * 65 + j];
                const float df = __expf(fminf(gfi - sc[256 + j], 0.f)), db = __expf(fminf(gbi - sc[320 + j], 0.f));
                vf[e] = (j < i) ? bfi * kv * df : 0.f; vb[e] = (j > i) ? bbi * kv * db : 0.f; qf[e] = (j <= i) ? qv * df : 0.f; qb[e] = (j >= i) ? qv * db : 0.f; }
            *(LAS f32x4*)(af + i * 64 + j0) = (f32x4){vf[0], vf[1], vf[2], vf[3]}; *(LAS f32x4*)(af + i * 64 + j0 + 4) = (f32x4){vf[4], vf[5], vf[6], vf[7]};
            *(LAS f32x4*)(ab + (63 - i) * 64 + 56 - j0) = (f32x4){vb[7], vb[6], vb[5], vb[4]}; *(LAS f32x4*)(ab + (63 - i) * 64 + 60 - j0) = (f32x4){vb[3], vb[2], vb[1], vb[0]};
            u32x4 w1, w2; w1.x = pkbf(qf[0], qf[1]); w1.y = pkbf(qf[2], qf[3]); w1.z = pkbf(qf[4], qf[5]); w1.w = pkbf(qf[6], qf[7]);
            w2.x = pkbf(qb[0], qb[1]); w2.y = pkbf(qb[2], qb[3]); w2.z = pkbf(qb[4], qb[5]); w2.w = pkbf(qb[6], qb[7]);
            *(u32x4*)(qkf + i * 64 + j0) = w1; *(u32x4*)(qkb + i * 64 + j0) = w2;
        }
        __syncthreads();
        {
            const int sd = wid >> 2, r4 = lane & 3, c = 16 * (wid & 3) + (lane >> 2);
            const LAS float* A = (const LAS float*)(L + (sd ? AB : AF)) + r4;
            float to[16];
#pragma unroll
            for (int m = 0; m < 16; ++m) to[m] = 0.f;
            float ar3[3][16];
            ar3[1][0] = A[1 * 64];
            ar3[2][0] = A[2 * 64];
            if (r4 == 0) to[0] = (c == 0) ? 1.f : 0.f;
#define GDNA_ROW(i) { constexpr int NM = ((i) + 3) / 4, NP2 = ((i) + 5) / 4; \
                if ((i) + 2 < 64) { _Pragma("unroll") for (int m = 0; m < NP2; ++m) ar3[((i) + 2) % 3][m] = A[((i) + 2) * 64 + 4 * m]; } \
                float p0 = 0.f, p1 = 0.f; \
                _Pragma("unroll") for (int m = 0; m < NM; ++m) { if (m & 1) p1 = fmaf(ar3[(i) % 3][m], to[m], p1); else p0 = fmaf(ar3[(i) % 3][m], to[m], p0); } \
                float ps = p0 + p1; \
                ps += __int_as_float(__builtin_amdgcn_update_dpp(0, __float_as_int(ps), 0xB1, 0xF, 0xF, true));     \
                ps += __int_as_float(__builtin_amdgcn_update_dpp(0, __float_as_int(ps), 0x4E, 0xF, 0xF, true));     \
                const float val = ((c == (i)) ? 1.f : 0.f) - ps; \
                to[(i) >> 2] = (r4 == ((i) & 3)) ? val : to[(i) >> 2]; asm volatile("" ::: "memory"); }
#define GDNA_ROWS8(b) GDNA_ROW(b) GDNA_ROW(b + 1) GDNA_ROW(b + 2) GDNA_ROW(b + 3) GDNA_ROW(b + 4) GDNA_ROW(b + 5) GDNA_ROW(b + 6) GDNA_ROW(b + 7)
            GDNA_ROW(1) GDNA_ROW(2) GDNA_ROW(3) GDNA_ROW(4) GDNA_ROW(5) GDNA_ROW(6) GDNA_ROW(7)
            GDNA_ROWS8(8) GDNA_ROWS8(16) GDNA_ROWS8(24) GDNA_ROWS8(32) GDNA_ROWS8(40) GDNA_ROWS8(48) GDNA_ROWS8(56)
#undef GDNA_ROWS8
#undef GDNA_ROW
            const int cc = sd ? 63 - c : c; const float be = sc[128 + sd * 64 + cc], s1 = be * __expf(sc[256 + sd * 64 + cc]);
            LAS bf16_t* T1 = (LAS bf16_t*)(L + (sd ? TB : TF)); LAS bf16_t* T2 = T1 + 64 * 72;
#pragma unroll
            for (int m = 0; m < 16; ++m) { const int j = 4 * m + r4, ii = sd ? 63 - j : j; T1[ii * 72 + cc] = f2bf(to[m] * s1); T2[ii * 72 + cc] = f2bf(to[m] * be); }
        }
        {
            bf16_t* kt = GKT + (size_t)item * 8192;
#pragma unroll
            for (int i = 0; i < 2; ++i) { const int e = THR + i * NT, row = e >> 3, ch = e & 7; *(u32x4*)(kt + row * 64 + ch * 8) = *(const LAS u32x4*)(L + KT + row * 144 + ch * 16); }
            if (THR < 128) { const int dir = THR >> 6, i = THR & 63; const float gc = sc[256 + dir * 64 + i], gl = sc[256 + dir * 64 + (dir ? 0 : 63)];
                float* o = GSC + (size_t)(item * 2 + dir) * 132; o[i] = __expf(gc); o[64 + i] = __expf(gl - gc); if (i == 0) o[128] = __expf(gl); }
        }
        __syncthreads();
#pragma unroll 4
        for (int ti = 0; ti < 16; ++ti) { const int id = wid * 16 + ti, dir = id >> 6, isU = (id >> 5) & 1, x = (id >> 2) & 7, y = id & 3;
            const int t1 = dir ? TB : TF; f32x4 acc = {0.f, 0.f, 0.f, 0.f};
#pragma unroll
            for (int s2 = 0; s2 < 2; ++s2) {
                bf16x8 a, bb;
                if (!isU) { a = *(const LAS bf16x8*)(L + KT + (16 * x + l15) * 144 + (32 * s2 + 8 * q4) * 2); bb = *(const LAS bf16x8*)(L + t1 + (16 * y + l15) * 144 + (32 * s2 + 8 * q4) * 2); }
                else { a = *(const LAS bf16x8*)(L + t1 + 64 * 144 + (16 * y + l15) * 144 + (32 * s2 + 8 * q4) * 2); bb = *(const LAS bf16x8*)(L + VT + (16 * x + l15) * 144 + (32 * s2 + 8 * q4) * 2); }
                acc = __builtin_amdgcn_mfma_f32_16x16x32_bf16(a, bb, acc, 0, 0, 0); }
            const bf16x4 o = pack4(acc[0], acc[1], acc[2], acc[3]);
            if (!isU) *(bf16x4*)(GW + (size_t)(item * 2 + dir) * 8192 + (16 * y + l15) * 128 + 16 * x + 4 * q4) = o;
            else *(bf16x4*)(GUT + (size_t)(item * 2 + dir) * 8192 + (16 * x + l15) * 64 + 16 * y + 4 * q4) = o; }
#pragma unroll
        for (int mat = 0; mat < 3; ++mat)
#pragma unroll
            for (int r = 0; r < 12; ++r) rawc[mat][r] = rawn[mat][r];
        bac = ban;
        __syncthreads();
    }
}

__device__ __forceinline__ void ph_gdnb(const Params& p, float* smem) {
    if (blockIdx.x >= B_ * NH * 2 * 2) return;
    LAS unsigned char* L = (LAS unsigned char*)smem;
    constexpr int BUF = 62464 + 1024, OW = 0, OQ = 17408, OK_ = 34816, OQK = 53248, OSC = 62464;
    const int half = (blockIdx.x >> 3) & 1, seq = (blockIdx.x & 7) | ((blockIdx.x >> 4) << 3), dir = seq & 1, h = (seq >> 1) & 3, b = seq >> 3;
    const bf16_t* GQN = (const bf16_t*)(p.ws + WS_GQN);
    const bf16_t* GW = (const bf16_t*)(p.ws + WS_GW); const bf16_t* GUT = (const bf16_t*)(p.ws + WS_GUT); const bf16_t* GQK = (const bf16_t*)(p.ws + WS_GQK); const bf16_t* GKT = (const bf16_t*)(p.ws + WS_GKT);
    const float* GSC = (const float*)((unsigned char*)p.out + OUT_GSC);
    bf16_t* GO = (bf16_t*)((unsigned char*)p.out + OUT_GO) + (size_t)dir * T_ * GDW;
    auto stage = [&](int n, int buf, int tt, auto nth_tag) {
        constexpr int NTH = decltype(nth_tag)::value, NCH = 3584 / NTH;
        const int item = (b * 4 + h) * 32 + n;
        u32x4 d[NCH];
#pragma unroll
        for (int i = 0; i < NCH; ++i) { const int e = tt + i * NTH; const u32x4* src;
            if (e < 1024) src = (const u32x4*)(GW + (size_t)(item * 2 + dir) * 8192) + e;
            else if (e < 2048) src = (const u32x4*)(GQN + (size_t)item * 8192) + (e - 1024);
            else if (e < 3072) src = (const u32x4*)(GKT + (size_t)item * 8192) + (e - 2048);
            else src = (const u32x4*)(GQK + (size_t)(item * 2 + dir) * 4096) + (e - 3072);
            d[i] = *src; }
        const float scv = (tt < 132) ? GSC[(size_t)(item * 2 + dir) * 132 + tt] : 0.f;
#pragma unroll
        for (int i = 0; i < NCH; ++i) { const int e = tt + i * NTH; int off;
            if (e < 1024) off = OW + (e >> 4) * 272 + (e & 15) * 16;
            else if (e < 2048) off = OQ + ((e - 1024) >> 4) * 272 + (e & 15) * 16;
            else if (e < 3072) off = OK_ + ((e - 2048) >> 3) * 144 + (e & 7) * 16;
            else off = OQK + ((e - 3072) >> 3) * 144 + (e & 7) * 16;
            *(LAS u32x4*)(L + buf * BUF + off) = d[i]; }
        if (tt < 132) *(LAS float*)(L + buf * BUF + OSC + tt * 4) = scv;
    };
    auto loadu = [&](bf16x4 (&u)[4], int n) {
        const int THR = ltid(); const int lane = THR & 63, wid = THR >> 6, l15 = lane & 15, q4 = lane >> 4, dv0 = half * 64 + (wid & 3) * 16;
        const bf16_t* ut = GUT + (size_t)(((b * 4 + h) * 32 + n) * 2 + dir) * 8192 + (size_t)(dv0 + l15) * 64 + 4 * q4;
#pragma unroll
        for (int mt = 0; mt < 4; ++mt) u[mt] = *(const bf16x4*)(ut + 16 * mt);
    };
    f32x4 S[8]; bf16x8 Sb[4];
#pragma unroll
    for (int i = 0; i < 8; ++i) S[i] = (f32x4){0.f, 0.f, 0.f, 0.f};
#pragma unroll
    for (int i = 0; i < 4; ++i) Sb[i] = (bf16x8){0, 0, 0, 0, 0, 0, 0, 0};
    auto compute = [&](int n, int buf, const bf16x4 (&uraw)[4]) {
        const int THR = ltid(); const int lane = THR & 63, wid = THR >> 6, l15 = lane & 15, q4 = lane >> 4, dv0 = half * 64 + (wid & 3) * 16;
        const LAS unsigned char* Bf = L + buf * BUF; const LAS float* scl = (const LAS float*)(Bf + OSC);
        f32x4 ws[4], qs[4];
        {
            bf16x8 fa[4][4];
#pragma unroll
            for (int mt = 0; mt < 4; ++mt)
#pragma unroll
                for (int s4 = 0; s4 < 4; ++s4) { const LAS unsigned char* r = Bf + OW + (16 * mt + l15) * 272 + (32 * s4 + 4 * q4) * 2; fa[mt][s4] = cat44(*(const LAS bf16x4*)r, *(const LAS bf16x4*)(r + 32)); }
#pragma unroll
            for (int mt = 0; mt < 4; ++mt) { ws[mt] = (f32x4){0.f, 0.f, 0.f, 0.f};
#pragma unroll
                for (int s4 = 0; s4 < 4; ++s4) ws[mt] = __builtin_amdgcn_mfma_f32_16x16x32_bf16(fa[mt][s4], Sb[s4], ws[mt], 0, 0, 0); }
        }
        {
            bf16x8 fa[4][4];
#pragma unroll
            for (int mt = 0; mt < 4; ++mt)
#pragma unroll
                for (int s4 = 0; s4 < 4; ++s4) { const LAS unsigned char* r = Bf + OQ + (16 * mt + l15) * 272 + (32 * s4 + 4 * q4) * 2; fa[mt][s4] = cat44(*(const LAS bf16x4*)r, *(const LAS bf16x4*)(r + 32)); }
#pragma unroll
            for (int mt = 0; mt < 4; ++mt) { qs[mt] = (f32x4){0.f, 0.f, 0.f, 0.f};
#pragma unroll
                for (int s4 = 0; s4 < 4; ++s4) qs[mt] = __builtin_amdgcn_mfma_f32_16x16x32_bf16(fa[mt][s4], Sb[s4], qs[mt], 0, 0, 0); }
        }
        f32x4 vn[4], vs[4];
#pragma unroll
        for (int mt = 0; mt < 4; ++mt) { const f32x4 es = *(const LAS f32x4*)(scl + 64 + 16 * mt + 4 * q4);
#pragma unroll
            for (int r = 0; r < 4; ++r) { const float u = __uint_as_float(((unsigned)(unsigned short)uraw[mt][r]) << 16); vn[mt][r] = u - ws[mt][r]; vs[mt][r] = vn[mt][r] * es[r]; } }
        bf16x8 vb[2], vsb[2];
#pragma unroll
        for (int s2 = 0; s2 < 2; ++s2) { vb[s2] = cat44(pack4(vn[2 * s2][0], vn[2 * s2][1], vn[2 * s2][2], vn[2 * s2][3]), pack4(vn[2 * s2 + 1][0], vn[2 * s2 + 1][1], vn[2 * s2 + 1][2], vn[2 * s2 + 1][3]));
            vsb[s2] = cat44(pack4(vs[2 * s2][0], vs[2 * s2][1], vs[2 * s2][2], vs[2 * s2][3]), pack4(vs[2 * s2 + 1][0], vs[2 * s2 + 1][1], vs[2 * s2 + 1][2], vs[2 * s2 + 1][3])); }
        bf16x8 fk[8][2];
        {
            bf16x8 fq[4][2];
#pragma unroll
            for (int it = 0; it < 4; ++it)
#pragma unroll
                for (int s2 = 0; s2 < 2; ++s2) { const LAS unsigned char* r = Bf + OQK + (16 * it + l15) * 144 + (32 * s2 + 4 * q4) * 2; fq[it][s2] = cat44(*(const LAS bf16x4*)r, *(const LAS bf16x4*)(r + 32)); }
#pragma unroll
            for (int t8 = 0; t8 < 8; ++t8)
#pragma unroll
                for (int s2 = 0; s2 < 2; ++s2) { const LAS unsigned char* r = Bf + OK_ + (16 * t8 + l15) * 144 + (32 * s2 + 4 * q4) * 2; fk[t8][s2] = cat44(*(const LAS bf16x4*)r, *(const LAS bf16x4*)(r + 32)); }
#pragma unroll
            for (int it = 0; it < 4; ++it) { f32x4 o2 = {0.f, 0.f, 0.f, 0.f};
#pragma unroll
                for (int s2 = 0; s2 < 2; ++s2) o2 = __builtin_amdgcn_mfma_f32_16x16x32_bf16(fq[it][s2], vb[s2], o2, 0, 0, 0);
                const f32x4 eg4 = *(const LAS f32x4*)(scl + 16 * it + 4 * q4);
#pragma unroll
                for (int r = 0; r < 4; ++r) { const int tok = 16 * it + 4 * q4 + r; const float o = eg4[r] * qs[it][r] + o2[r];
                    GO[((size_t)b * S_ + n * 64 + tok) * GDW + h * 128 + dv0 + l15] = f2bf(o); } }
        }
        const float eg = scl[128];
#pragma unroll
        for (int t8 = 0; t8 < 8; ++t8) { f32x4 c = S[t8] * eg;
#pragma unroll
            for (int s2 = 0; s2 < 2; ++s2) c = __builtin_amdgcn_mfma_f32_16x16x32_bf16(fk[t8][s2], vsb[s2], c, 0, 0, 0);
            S[t8] = c; }
#pragma unroll
        for (int s4 = 0; s4 < 4; ++s4) Sb[s4] = cat44(pack4(S[2 * s4][0], S[2 * s4][1], S[2 * s4][2], S[2 * s4][3]), pack4(S[2 * s4 + 1][0], S[2 * s4 + 1][1], S[2 * s4 + 1][2], S[2 * s4 + 1][3]));
    };
    const int n0 = dir ? 31 : 0, dn = dir ? -1 : 1;
    const int wid0 = __builtin_amdgcn_readfirstlane(ltid() >> 6);
    { const int THR = ltid(); stage(n0, 0, THR, std::integral_constant<int, 512>()); }
    __syncthreads();
    if (wid0 >= 4) {
        const int tt = ltid() - 256;
        constexpr int NCH = 14;
        auto ld = [&](u32x4 (&d)[NCH], float& scv, int n) {
            const int item = (b * 4 + h) * 32 + n;
#pragma unroll
            for (int i = 0; i < NCH; ++i) { const int e = tt + i * 256; const u32x4* src;
                if (e < 1024) src = (const u32x4*)(GW + (size_t)(item * 2 + dir) * 8192) + e;
                else if (e < 2048) src = (const u32x4*)(GQN + (size_t)item * 8192) + (e - 1024);
                else if (e < 3072) src = (const u32x4*)(GKT + (size_t)item * 8192) + (e - 2048);
                else src = (const u32x4*)(GQK + (size_t)(item * 2 + dir) * 4096) + (e - 3072);
                d[i] = *src; }
            scv = (tt < 132) ? GSC[(size_t)(item * 2 + dir) * 132 + tt] : 0.f;
        };
        auto st_ = [&](const u32x4 (&d)[NCH], float scv, int buf) {
#pragma unroll
            for (int i = 0; i < NCH; ++i) { const int e = tt + i * 256; int off;
                if (e < 1024) off = OW + (e >> 4) * 272 + (e & 15) * 16;
                else if (e < 2048) off = OQ + ((e - 1024) >> 4) * 272 + (e & 15) * 16;
                else if (e < 3072) off = OK_ + ((e - 2048) >> 3) * 144 + (e & 7) * 16;
                else off = OQK + ((e - 3072) >> 3) * 144 + (e & 7) * 16;
                *(LAS u32x4*)(L + buf * BUF + off) = d[i]; }
            if (tt < 132) *(LAS float*)(L + buf * BUF + OSC + tt * 4) = scv;
        };
        u32x4 r0[NCH], r1[NCH]; float c0 = 0.f, c1 = 0.f;
        ld(r0, c0, n0 + dn);
        for (int st = 0; st < 32; st += 2) {
            if (st + 2 < 32) ld(r1, c1, n0 + dn * (st + 2));
            st_(r0, c0, 1);
            __syncthreads();
            if (st + 3 < 32) ld(r0, c0, n0 + dn * (st + 3));
            if (st + 2 < 32) st_(r1, c1, 0);
            __syncthreads();
        }
    } else {
        bf16x4 uA[4], uB[4];
        loadu(uA, n0); loadu(uB, n0 + dn);
        for (int st = 0; st < 32; st += 2) {
            { bf16x4 uc[4];
#pragma unroll
              for (int mt = 0; mt < 4; ++mt) uc[mt] = uA[mt];
              if (st + 2 < 32) loadu(uA, n0 + dn * (st + 2));
              compute(n0 + dn * st, 0, uc);
              __syncthreads(); }
            { bf16x4 uc[4];
#pragma unroll
              for (int mt = 0; mt < 4; ++mt) uc[mt] = uB[mt];
              if (st + 3 < 32) loadu(uB, n0 + dn * (st + 3));
              compute(n0 + dn * (st + 1), 1, uc);
              __syncthreads(); }
        }
    }
}
__device__ __forceinline__ void ph_gdncomb(const Params& p, float* smem) {
    const int THR = ltid();
    const bf16_t* O = (const bf16_t*)((unsigned char*)p.out + OUT_GO); const bf16_t* zb = (const bf16_t*)(p.ws + WS_ZB); bf16_t* cat = (bf16_t*)(p.ws + WS_CAT); const float* gn = p.in[I_GDN_NORM];
    const int lane = THR & 63, gw = blockIdx.x * NW + (THR >> 6), nw = gridDim.x * NW;
    const f4_t g0 = ((const f4_t*)gn)[(lane & 15) * 2], g1 = ((const f4_t*)gn)[(lane & 15) * 2 + 1];
    const float gg[8] = {g0.x, g0.y, g0.z, g0.w, g1.x, g1.y, g1.z, g1.w};
    const float* ssq5 = (const float*)(p.ws + WS_SSQ); const f4_t n0 = ((const f4_t*)p.in[I_S5_NORM])[lane * 2], n1 = ((const f4_t*)p.in[I_S5_NORM])[lane * 2 + 1];
    const float nn[8] = {n0.x, n0.y, n0.z, n0.w, n1.x, n1.y, n1.z, n1.w};
    for (int t0 = gw * 4; t0 < T_; t0 += nw * 4) {
        u4_t of[4], ob[4], zz[4], s5[4]; float r5[4];
#pragma unroll
        for (int r = 0; r < 4; ++r) { const size_t t = t0 + r; s5[r] = ((const u4_t*)(cat + t * D_))[lane]; r5[r] = rsqrtf(ssq5[t] * (1.f / (float)S5W) + RMS_EPS); of[r] = ((const u4_t*)(O + t * GDW))[lane]; ob[r] = ((const u4_t*)(O + (size_t)T_ * GDW + t * GDW))[lane]; zz[r] = ((const u4_t*)(zb + t * GDW))[lane]; }
#pragma unroll
        for (int r = 0; r < 4; ++r) {
            float a[8]; float ss = 0.f;
#pragma unroll
            for (int k = 0; k < 4; ++k) { a[2 * k] = bflo(of[r][k]) + bflo(ob[r][k]); a[2 * k + 1] = bfhi(of[r][k]) + bfhi(ob[r][k]); ss += a[2 * k] * a[2 * k] + a[2 * k + 1] * a[2 * k + 1]; }
            ss = dpp_sum16(ss);
            const float rs = rsqrtf(ss * (1.f / 128.f) + RMS_EPS);
            float o[8];
#pragma unroll
            for (int k = 0; k < 4; ++k) { o[2 * k] = a[2 * k] * rs * gg[2 * k] * siluf_(bflo(zz[r][k])); o[2 * k + 1] = a[2 * k + 1] * rs * gg[2 * k + 1] * siluf_(bfhi(zz[r][k])); }
            u4_t w; w.x = pkbf(o[0], o[1]); w.y = pkbf(o[2], o[3]); w.z = pkbf(o[4], o[5]); w.w = pkbf(o[6], o[7]);
            ((u4_t*)(cat + (size_t)(t0 + r) * D_ + 512))[lane] = w;
            u4_t v5;
#pragma unroll
            for (int k = 0; k < 4; ++k) v5[k] = pkbf(bflo(s5[r][k]) * r5[r] * nn[2 * k], bfhi(s5[r][k]) * r5[r] * nn[2 * k + 1]);
            ((u4_t*)(cat + (size_t)(t0 + r) * D_))[lane] = v5; }
    }
}
struct XcdBarrier; __device__ __forceinline__ void xcd_barrier(const XcdBarrier& b);
typedef int i4_t __attribute__((ext_vector_type(4)));
constexpr int RT_GN_OFF = 73728, RT_LG_OFF = 77824, RT_LG_STRIDE = 2688, RT_H_OFF = 90112;
__device__ __forceinline__ void router_stage(const u4_t* src, LAS unsigned char* L, int half, int THR) {
#pragma unroll 3
    for (int i = THR; i < 72 * 64; i += NT) { const int R = i >> 6, ch = i & 63, o = R >= 36 ? R - 36 : R, key = (o < 4 ? o : o - 4) & 15;
        *(LAS u4_t*)(L + (size_t)((R * 64 + (ch ^ key)) * 16)) = src[R * 128 + half * 64 + ch]; }
}
__device__ __forceinline__ void ph_router(const Params& p, float* smem, const XcdBarrier& bar) {
    const int THR = ltid();
    const bf16_t* x2 = (const bf16_t*)(p.ws + WS_XB); bf16_t* xs = (bf16_t*)(p.ws + WS_XS); int* route = (int*)(p.ws + WS_ROUTE); int* mc = (int*)(p.ws + WS_CNT);
    const float* gn = p.in[I_NORM_MOE]; const float* bg = p.in[I_RG_B]; const float* be = p.in[I_RE_B]; const u4_t* WrHL = (const u4_t*)(p.ws + WS_WRT);
    LAS unsigned char* L = (LAS unsigned char*)smem;
    for (int i = THR; i < D_ / 4; i += NT) *(LAS f4_t*)(L + RT_GN_OFF + i * 16) = ((const f4_t*)gn)[i];
    LAS int* lh = (LAS int*)(L + RT_H_OFF);
    if (THR < NE) lh[THR] = 0;
    {
        const int TH2 = ltid(); const int lane = TH2 & 63, wid = TH2 >> 6, c = lane & 15, q = lane >> 4;
        LAS float* lgs = (LAS float*)(L + RT_LG_OFF + (wid & 3) * RT_LG_STRIDE); LAS float* lrs = lgs + 640;
        const int tg = (int)blockIdx.x * 4 + wid; const bool act = (wid < 4) && (tg < T_ / 16);
        const int t0 = act ? tg * 16 : 0;
        u4_t A[32];
        if (act) { const u4_t* xr = (const u4_t*)(x2 + (size_t)(t0 + c) * D_) + q;
#pragma unroll
          for (int s = 0; s < 32; ++s) A[s] = xr[4 * s]; }
        f32x4 acc0 = {0.f, 0.f, 0.f, 0.f}, acc1 = acc0, acc2 = acc0;
#pragma unroll
        for (int half = 0; half < 2; ++half) {
            if (half) __syncthreads();
            router_stage(WrHL, L, half, THR);
            __syncthreads();
            if (act) {
#pragma unroll
                for (int ls = 0; ls < 16; ++ls) {
                    const bf16x8 a = __builtin_bit_cast(bf16x8, A[half * 16 + ls]);
                    const int swe = ((4 * ls + q) ^ c) * 16, swg = ((4 * ls + q) ^ (c & 3)) * 16;
#pragma unroll
                    for (int hl = 0; hl < 2; ++hl) {
                        const bf16x8 b0 = *(const LAS bf16x8*)(L + (hl * 36 + 4 + c) * 1024 + swe);
                        const bf16x8 b1 = *(const LAS bf16x8*)(L + (hl * 36 + 20 + c) * 1024 + swe);
                        const bf16x8 b2 = *(const LAS bf16x8*)(L + (hl * 36 + (c & 3)) * 1024 + swg);
                        acc0 = __builtin_amdgcn_mfma_f32_16x16x32_bf16(a, b0, acc0, 0, 0, 0);
                        acc1 = __builtin_amdgcn_mfma_f32_16x16x32_bf16(a, b1, acc1, 0, 0, 0);
                        acc2 = __builtin_amdgcn_mfma_f32_16x16x32_bf16(a, b2, acc2, 0, 0, 0);
                    }
                    if (ls & 1) asm volatile("" ::: "memory");
                }
            }
        }
        int eav = 0, ebv = 0, rka = 0, rkb = 0; float w0v = 0.f, w1v = 0.f, rs = 0.f;
        if (act) {
            float ss = 0.f;
#pragma unroll
            for (int s = 0; s < 32; ++s)
#pragma unroll
                for (int k = 0; k < 4; ++k) { const float lo = bflo(A[s][k]), hi = bfhi(A[s][k]); ss += lo * lo + hi * hi; }
            ss += __shfl_xor(ss, 16); ss += __shfl_xor(ss, 32);
            rs = rsqrtf(ss * (1.f / (float)D_) + RMS_EPS);
#pragma unroll
            for (int r = 0; r < 4; ++r) { LAS float* row = lgs + (4 * q + r) * 40; row[4 + c] = acc0[r]; row[20 + c] = acc1[r]; if (c < 4) row[c] = acc2[r]; }
            if (q == 0) lrs[c] = rs;
            asm volatile("s_waitcnt lgkmcnt(0)" ::: "memory");
            float mine[36];
            if (lane < 16) {
                const float rt = lrs[lane];
#pragma unroll
                for (int o = 0; o < 36; ++o) mine[o] = lgs[lane * 40 + o] * rt + (o < 4 ? bg[o] : be[o - 4]);
            }
            if (lane < 16) {
                int gi = 0; float gm = mine[0];
#pragma unroll
                for (int g = 1; g < 4; ++g) if (mine[g] > gm) { gm = mine[g]; gi = g; }
                float gs = 0.f;
#pragma unroll
                for (int g = 0; g < 4; ++g) gs += __expf(mine[g] - gm);
                const float ptop = 1.f / gs;
                float el[8];
#pragma unroll
                for (int e = 0; e < 8; ++e) { float v = mine[4 + e];
#pragma unroll
                    for (int g = 1; g < 4; ++g) v = (gi == g) ? mine[4 + g * 8 + e] : v;
                    el[e] = v; }
                int i0 = 0; float v0 = el[0];
#pragma unroll
                for (int e = 1; e < 8; ++e) if (el[e] > v0) { v0 = el[e]; i0 = e; }
                int i1 = -1; float v1 = -1e30f;
#pragma unroll
                for (int e = 0; e < 8; ++e) if (e != i0 && el[e] > v1) { v1 = el[e]; i1 = e; }
                const float e1 = __expf(v1 - v0), w0 = ptop / (1.f + e1), w1 = ptop * e1 / (1.f + e1);
                const int ea = gi * 8 + i0, eb = gi * 8 + i1;
                eav = ea; ebv = eb; w0v = w0; w1v = w1;
                rka = __hip_atomic_fetch_add(lh + ea, 1, __ATOMIC_RELAXED, __HIP_MEMORY_SCOPE_WORKGROUP); rkb = __hip_atomic_fetch_add(lh + eb, 1, __ATOMIC_RELAXED, __HIP_MEMORY_SCOPE_WORKGROUP);
            }
        }
        __syncthreads();
        if (TH2 < NE) mc[MC_HIST + TH2 * 256 + (int)blockIdx.x] = lh[TH2];
        xcd_barrier(bar);
        {   const int e = TH2 >> 4, part = TH2 & 15, pb = (int)blockIdx.x >> 4, myb = (int)blockIdx.x & 15;
            const i4_t* hp = (const i4_t*)(mc + MC_HIST + e * 256 + part * 16);
            int sf = 0, spre = 0;
#pragma unroll
            for (int i = 0; i < 4; ++i) { const i4_t v = hp[i];
#pragma unroll
                for (int k = 0; k < 4; ++k) { sf += v[k]; spre += (4 * i + k < myb) ? v[k] : 0; } }
            int con = part < pb ? sf : (part == pb ? spre : 0);
            con += __shfl_xor(con, 1); con += __shfl_xor(con, 2); con += __shfl_xor(con, 4); con += __shfl_xor(con, 8);
            sf += __shfl_xor(sf, 1); sf += __shfl_xor(sf, 2); sf += __shfl_xor(sf, 4); sf += __shfl_xor(sf, 8);
            if (part == 0) { lh[32 + e] = con; lh[64 + e] = sf; if (blockIdx.x == 0) mc[MC_TOT + e] = sf; }
        }
        __syncthreads();
        if (TH2 == 0) { int acc = 0; for (int e = 0; e < NE; ++e) { lh[96 + e] = acc; acc += (lh[64 + e] + 255) >> 8; } }
        __syncthreads();
        if (act) {
            int r0v = 0, r1v = 0;
            if (lane < 16) {
                r0v = lh[96 + eav] * 256 + lh[32 + eav] + rka; r1v = lh[96 + ebv] * 256 + lh[32 + ebv] + rkb;
                int* rr = route + (size_t)(t0 + lane) * 8; rr[0] = eav; rr[1] = ebv; ((float*)rr)[2] = w0v; ((float*)rr)[3] = w1v; rr[6] = r0v; rr[7] = r1v;
            }
            const int d0 = __shfl(r0v, c), d1 = __shfl(r1v, c);
            u4_t* q0 = (u4_t*)(xs + (size_t)d0 * D_) + q; u4_t* q1 = (u4_t*)(xs + (size_t)d1 * D_) + q;
#pragma unroll
            for (int s = 0; s < 32; ++s) {
                const f4_t g0 = *(const LAS f4_t*)(L + RT_GN_OFF + (32 * s + 8 * q) * 4), g1 = *(const LAS f4_t*)(L + RT_GN_OFF + (32 * s + 8 * q) * 4 + 16);
                u4_t w; asm volatile("" : "+v"(A[s]));
                w.x = pkbf(bflo(A[s].x) * rs * g0.x, bfhi(A[s].x) * rs * g0.y); w.y = pkbf(bflo(A[s].y) * rs * g0.z, bfhi(A[s].y) * rs * g0.w);
                w.z = pkbf(bflo(A[s].z) * rs * g1.x, bfhi(A[s].z) * rs * g1.y); w.w = pkbf(bflo(A[s].w) * rs * g1.z, bfhi(A[s].w) * rs * g1.w);
                q0[4 * s] = w; q1[4 * s] = w;
                if ((s & 3) == 3) asm volatile("" ::: "memory");
            }
        }
    }
}
__device__ __forceinline__ void moe_build_table(const Params& p, int* tab) {
    const int THR = ltid();
    if (THR == 0) {
        const int* cnt = (const int*)(p.ws + WS_CNT) + MC_TOT; int acc = 0;
        for (int e = 0; e < NE; ++e) { tab[1 + e] = acc; const int nt = (cnt[e] + 255) >> 8; for (int i = 0; i < nt; ++i) tab[40 + acc + i] = e; acc += nt; }
        tab[1 + NE] = acc; tab[0] = acc;
    }
    __syncthreads();
}
__device__ __forceinline__ void ph_final(const Params& p, float* smem) {
    const int THR = ltid();
    float* out = p.out; const bf16_t* x2 = (const bf16_t*)(p.ws + WS_XB); const float* gn = p.in[I_NORM_FINAL]; const bf16_t* Y = (const bf16_t*)(p.ws + WS_XS); const int* route = (const int*)(p.ws + WS_ROUTE);
    const int lane = THR & 63, gw = blockIdx.x * NW + (THR >> 6), nw = gridDim.x * NW;
    f4_t g[4];
#pragma unroll
    for (int j = 0; j < 4; ++j) g[j] = ((const f4_t*)gn)[lane + 64 * j];
    for (int t0 = gw * 2; t0 < T_; t0 += nw * 2) {
        f4_t xv[2][4]; u2_t xr[2][4], ya[2][4], yb[2][4]; float w0[2], w1[2];
#pragma unroll
        for (int r = 0; r < 2; ++r) { const int* rr = route + (size_t)(t0 + r) * 8; w0[r] = ((const float*)rr)[2]; w1[r] = ((const float*)rr)[3];
            const u2_t* y0 = (const u2_t*)(Y + (size_t)rr[6] * D_); const u2_t* y1 = (const u2_t*)(Y + (size_t)rr[7] * D_);
#pragma unroll
            for (int j = 0; j < 4; ++j) { xr[r][j] = ((const u2_t*)(x2 + (size_t)(t0 + r) * D_))[lane + 64 * j]; ya[r][j] = y0[lane + 64 * j]; yb[r][j] = y1[lane + 64 * j]; } }
#pragma unroll
        for (int r = 0; r < 2; ++r) { float ss = 0.f;
#pragma unroll
            for (int j = 0; j < 4; ++j) { f4_t v = (f4_t){bflo(xr[r][j].x), bfhi(xr[r][j].x), bflo(xr[r][j].y), bfhi(xr[r][j].y)};
                v.x += w0[r] * bflo(ya[r][j].x) + w1[r] * bflo(yb[r][j].x); v.y += w0[r] * bfhi(ya[r][j].x) + w1[r] * bfhi(yb[r][j].x);
                v.z += w0[r] * bflo(ya[r][j].y) + w1[r] * bflo(yb[r][j].y); v.w += w0[r] * bfhi(ya[r][j].y) + w1[r] * bfhi(yb[r][j].y);
                xv[r][j] = v; ss += v.x * v.x + v.y * v.y + v.z * v.z + v.w * v.w; }
            const float rs = rsqrtf(wave_sum(ss) * (1.f / (float)D_) + RMS_EPS);
#pragma unroll
            for (int j = 0; j < 4; ++j) ((f4_t*)(out + (size_t)(t0 + r) * D_))[lane + 64 * j] = xv[r][j] * rs * g[j]; }
    }
}


typedef pg8::f32x4 f32x4; typedef pg8::u32x4 u32x4;

__device__ __forceinline__ void transpose_item(const float* W, int K, int N, bf16_t* WT, int ldt, int dst_row0, int k0, int n0, const float* rowscale, LAS float* scr, int lane) {
    f4_t v[8];
#pragma unroll
    for (int i = 0; i < 8; ++i) v[i] = *(const f4_t*)(W + (size_t)(k0 + (lane >> 3) + 8 * i) * N + n0 + 4 * (lane & 7));
#pragma unroll
    for (int i = 0; i < 8; ++i) { const int kk = (lane >> 3) + 8 * i; f4_t x = v[i]; if (rowscale) x = x * rowscale[k0 + kk];
        LAS float* d = scr + kk * 33 + 4 * (lane & 7); d[0] = x.x; d[1] = x.y; d[2] = x.z; d[3] = x.w; }
    asm volatile("s_waitcnt lgkmcnt(0)" ::: "memory");
    const int c = lane & 7;
#pragma unroll
    for (int j = 0; j < 4; ++j) { const int n = (lane >> 3) + 8 * j; const LAS float* sp = scr + (8 * c) * 33 + n;
        u32x4 o; o.x = pg8::cvt_pk_bf16(sp[0 * 33], sp[1 * 33]); o.y = pg8::cvt_pk_bf16(sp[2 * 33], sp[3 * 33]); o.z = pg8::cvt_pk_bf16(sp[4 * 33], sp[5 * 33]); o.w = pg8::cvt_pk_bf16(sp[6 * 33], sp[7 * 33]);
        *(u32x4*)(WT + (size_t)(dst_row0 + n) * ldt + k0 + 8 * c) = o; }
    asm volatile("s_waitcnt lgkmcnt(0)" ::: "memory");
}
__device__ __forceinline__ void transpose_matrix(const float* W, int K, int N, bf16_t* WT, const float* rowscale, float* smem) {
    const int THR = ltid();
    const int lane = THR & 63, wv = THR >> 6; LAS float* scr = (LAS float*)smem + wv * (64 * 33);
    const int gw = blockIdx.x * NW + wv, nw = gridDim.x * NW, nblk = N / 32, items = (K / 64) * nblk;
    for (int it = gw; it < items; it += nw) { const int kb = it / nblk, nb = it % nblk; transpose_item(W, K, N, WT, K, nb * 32, kb * 64, nb * 32, rowscale, scr, lane); }
}
__device__ __forceinline__ void ph_prep0(const Params& p, float* smem) {
    const int THR = ltid();
    bf16_t* WinT = (bf16_t*)((unsigned char*)p.out + OUT_WINT);
    {
        const int lane = THR & 63, wv = THR >> 6; LAS float* scr = (LAS float*)smem + wv * (64 * 33);
        const int gw = blockIdx.x * NW + wv, nw = gridDim.x * NW, nblk = 2560 / 32, items = 16 * nblk;
        for (int it = gw; it < items; it += nw) { const int kb = it / nblk, nb = it % nblk; transpose_item(p.in[I_W_IN], D_, DIN, WinT, D_, nb * 32, kb * 64, nb * 32, nullptr, scr, lane); }
        for (size_t i = (size_t)blockIdx.x * NT + THR; i < (size_t)256 * D_; i += (size_t)gridDim.x * NT) {
            const int n = (int)(i / D_), k = (int)(i % D_);
            WinT[(size_t)(2560 + n) * D_ + k] = n < 16 ? f2bf(p.in[I_W_IN][(size_t)k * DIN + 2560 + n]) : (bf16_t)0;
        }
    }
    transpose_matrix(p.in[I_W_GLU], S5W, S5W, (bf16_t*)((unsigned char*)p.out + OUT_WGLUT), nullptr, smem);
    transpose_matrix(p.in[I_WK], D_, D_, (bf16_t*)((unsigned char*)p.out + OUT_WKT), nullptr, smem);
    transpose_matrix(p.in[I_WV], D_, D_, (bf16_t*)((unsigned char*)p.out + OUT_WVT), nullptr, smem);
    { float* ssq = (float*)(p.ws + WS_SSQ); for (int i = blockIdx.x * NT + THR; i < 2 * T_; i += gridDim.x * NT) ssq[i] = 0.f; }
}
__device__ __forceinline__ void ph_prep1(const Params& p, float* smem) {
    transpose_matrix(p.in[I_W_OUT], D_, D_, (bf16_t*)(p.ws + WS_WOUTT), nullptr, smem);
}
__device__ __forceinline__ void ph_prepa(const Params& p, float* smem) {
    const int THR = ltid();
    bf16_t* WqB = (bf16_t*)(p.ws + WS_WQB); const float* wq = p.in[I_WQ]; const float* gx = p.in[I_NORM_XA];
    for (int i = blockIdx.x * NT + THR; i < D_ * D_ / 4; i += gridDim.x * NT) { const f4_t v = ((const f4_t*)wq)[i] * gx[i >> 8]; u2_t w; w.x = pkbf(v.x, v.y); w.y = pkbf(v.z, v.w); ((u2_t*)WqB)[i] = w; }
    transpose_matrix(p.in[I_WO], D_, D_, (bf16_t*)(p.ws + WS_WOT), nullptr, smem);
}
__device__ __forceinline__ void ph_prep2(const Params& p, float* smem) {
    const int THR = ltid();
    const int lane = THR & 63, wv = THR >> 6; LAS float* scr = (LAS float*)smem + wv * (64 * 33);
    const int gw = blockIdx.x * NW + wv, nw = gridDim.x * NW;
    bf16_t* WguT = (bf16_t*)(p.ws + WS_WGUT); bf16_t* WdT = (bf16_t*)(p.ws + WS_WDT);
    { bf16_t* WrHL = (bf16_t*)(p.ws + WS_WRT); const float* gnm = p.in[I_NORM_MOE];
      for (int i = blockIdx.x * NT + THR; i < 36 * D_; i += gridDim.x * NT) { const int o = i >> 10, k = i & 1023; const float w = gnm[k] * (o < 4 ? p.in[I_RG_W][k * 4 + o] : p.in[I_RE_W][k * NE + (o - 4)]);
          const bf16_t hi = f2bf(w); WrHL[i] = hi; WrHL[36 * D_ + i] = f2bf(w - bf2f(hi)); } }
    for (int it = gw; it < NE * 2 * 128; it += nw) {
        const int e = it >> 8, which = (it >> 7) & 1, r = it & 127, kb = r >> 3, nb = r & 7, f0 = nb * 32;
        const float* W = p.in[which ? I_WUP : I_WGATE] + (size_t)e * D_ * DE;
        transpose_item(W, D_, DE, WguT, D_, e * 512 + (f0 >> 7) * 256 + which * 128 + (f0 & 127), kb * 64, f0, nullptr, scr, lane);
    }
    for (int it = gw; it < NE * 128; it += nw) {
        const int e = it >> 7, r = it & 127, kb = r >> 5, nb = r & 31;
        transpose_item(p.in[I_WDOWN] + (size_t)e * DE * D_, DE, D_, WdT, DE, e * D_ + nb * 32, kb * 64, nb * 32, nullptr, scr, lane);
    }
}

struct EpiInproj {
    static constexpr bool PERM = true;
    bf16_t* qkvr; bf16_t* zb; float* ba; bf16_t* aext;
    __device__ __forceinline__ void operator()(const f32x4 (&acc)[2][2][4][2], const pg8::Unit& u, int wr, int wc, int fr, int fq) const {
        const int row0 = u.orow + wr * 64 + fr;
        if (u.aux < 2) {
            const int col0 = u.ocol + wc * 32 + 8 * fq;
#pragma unroll
            for (int ai = 0; ai < 2; ++ai)
#pragma unroll
                for (int m = 0; m < 4; ++m) { const int t = row0 + ai * 128 + m * 16, n = t >> 4, j = t & 15;
#pragma unroll
                    for (int bj = 0; bj < 2; ++bj) { const int c = col0 + bj * 128, g = c >> 4, ci = c & 15; const f32x4 v0 = acc[ai][bj][m][0], v1 = acc[ai][bj][m][1];
                        u32x4 w; w.x = pg8::cvt_pk_bf16(v0[0], v0[1]); w.y = pg8::cvt_pk_bf16(v0[2], v0[3]); w.z = pg8::cvt_pk_bf16(v1[0], v1[1]); w.w = pg8::cvt_pk_bf16(v1[2], v1[3]);
                        *(u32x4*)(aext + ((size_t)g * 1024 + n) * 512 + j * 16 + ci) = w; } }
        } else if (u.aux < 10) {
            const int col0 = u.ocol + wc * 32 + 8 * fq;
#pragma unroll
            for (int ai = 0; ai < 2; ++ai)
#pragma unroll
                for (int m = 0; m < 4; ++m) { const int rr = row0 + ai * 128 + m * 16; bf16_t* rowp = (u.aux < 8) ? qkvr + (size_t)rr * QKV_LD + col0 - 512 : zb + (size_t)rr * GDW + col0 - 2048;
#pragma unroll
                    for (int bj = 0; bj < 2; ++bj) { const f32x4 v0 = acc[ai][bj][m][0], v1 = acc[ai][bj][m][1];
                        u32x4 w; w.x = pg8::cvt_pk_bf16(v0[0], v0[1]); w.y = pg8::cvt_pk_bf16(v0[2], v0[3]); w.z = pg8::cvt_pk_bf16(v1[0], v1[1]); w.w = pg8::cvt_pk_bf16(v1[2], v1[3]);
                        *(u32x4*)(rowp + bj * 128) = w; } }
        } else if (wc == 0 && fq < 2) {
#pragma unroll
            for (int ai = 0; ai < 2; ++ai)
#pragma unroll
                for (int m = 0; m < 4; ++m) { float* rowp = ba + (size_t)(row0 + ai * 128 + m * 16) * 16 + 8 * fq;
                    *(f32x4*)(rowp) = acc[ai][0][m][0]; *(f32x4*)(rowp + 4) = acc[ai][0][m][1]; }
        }
    }
};
struct EpiBf16Out {
    static constexpr bool PERM = true;
    bf16_t* O; int ldc; float scale; size_t aux_stride;
    __device__ __forceinline__ void operator()(const f32x4 (&acc)[2][2][4][2], const pg8::Unit& u, int wr, int wc, int fr, int fq) const {
        const int row0 = u.orow + wr * 64 + fr, col0 = u.ocol + wc * 32 + 8 * fq; bf16_t* base = O + (size_t)u.aux * aux_stride;
#pragma unroll
        for (int ai = 0; ai < 2; ++ai)
#pragma unroll
            for (int m = 0; m < 4; ++m) { bf16_t* rowp = base + (size_t)(row0 + ai * 128 + m * 16) * ldc + col0;
#pragma unroll
                for (int bj = 0; bj < 2; ++bj) { const f32x4 v0 = acc[ai][bj][m][0] * scale, v1 = acc[ai][bj][m][1] * scale;
                    u32x4 w; w.x = pg8::cvt_pk_bf16(v0[0], v0[1]); w.y = pg8::cvt_pk_bf16(v0[2], v0[3]); w.z = pg8::cvt_pk_bf16(v1[0], v1[1]); w.w = pg8::cvt_pk_bf16(v1[2], v1[3]);
                    *(u32x4*)(rowp + bj * 128) = w; } }
    }
};
struct EpiResid {
    static constexpr bool PERM = false;
    const float* base; const bf16_t* baseb; float* out; int ldc; bf16_t* xb; float* ssq;
    __device__ __forceinline__ void operator()(const f32x4 (&acc)[2][2][4][2], const pg8::Unit& u, int wr, int wc, int fr, int fq) const {
        const int row0 = u.orow + wr * 64 + fr, col0 = u.ocol + wc * 32 + 4 * fq;
#pragma unroll
        for (int ai = 0; ai < 2; ++ai)
#pragma unroll
            for (int m = 0; m < 4; ++m) { const size_t off = (size_t)(row0 + ai * 128 + m * 16) * ldc + col0; float ss = 0.f;
#pragma unroll
                for (int bj = 0; bj < 2; ++bj)
#pragma unroll
                    for (int n = 0; n < 2; ++n) { f32x4 b;
                        if (base) b = *(const f32x4*)(base + off + bj * 128 + n * 16);
                        else { const u2_t rb = *(const u2_t*)(baseb + off + bj * 128 + n * 16); b = (f32x4){bflo(rb.x), bfhi(rb.x), bflo(rb.y), bfhi(rb.y)}; }
                        const f32x4 o = b + acc[ai][bj][m][n]; if (out) *(f32x4*)(out + off + bj * 128 + n * 16) = o;
                        if (xb) { u2_t w; w.x = pkbf(o[0], o[1]); w.y = pkbf(o[2], o[3]); *(u2_t*)(xb + off + bj * 128 + n * 16) = w; ss += o[0] * o[0] + o[1] * o[1] + o[2] * o[2] + o[3] * o[3]; } }
                if (ssq) { ss += __shfl_xor(ss, 16); ss += __shfl_xor(ss, 32); if (fq == 0) atomicAdd(ssq + row0 + ai * 128 + m * 16, ss); }
                asm volatile("" ::: "memory"); }
    }
};
struct EpiGlu {
    static constexpr bool PERM = true;
    const bf16_t* gl; const float* bias; bf16_t* cat; float* ssq;
    __device__ __forceinline__ void operator()(const f32x4 (&acc)[2][2][4][2], const pg8::Unit& u, int wr, int wc, int fr, int fq) const {
        const int row0 = u.orow + wr * 64 + fr, col0 = u.ocol + wc * 32 + 8 * fq;
#pragma unroll
        for (int ai = 0; ai < 2; ++ai)
#pragma unroll
            for (int m = 0; m < 4; ++m) { const int r = row0 + ai * 128 + m * 16; float ss = 0.f;
#pragma unroll
                for (int bj = 0; bj < 2; ++bj) { const int c = col0 + bj * 128; const u4_t graw = *(const u4_t*)(gl + (size_t)r * S5W + c);
                    const f32x4 b0 = *(const f32x4*)(bias + c), b1 = *(const f32x4*)(bias + c + 4); const f32x4 a0 = acc[ai][bj][m][0] + b0, a1 = acc[ai][bj][m][1] + b1;
                    float o[8];
                    o[0] = bflo(graw.x) * sigmoidf_(a0[0]); o[1] = bfhi(graw.x) * sigmoidf_(a0[1]); o[2] = bflo(graw.y) * sigmoidf_(a0[2]); o[3] = bfhi(graw.y) * sigmoidf_(a0[3]);
                    o[4] = bflo(graw.z) * sigmoidf_(a1[0]); o[5] = bfhi(graw.z) * sigmoidf_(a1[1]); o[6] = bflo(graw.w) * sigmoidf_(a1[2]); o[7] = bfhi(graw.w) * sigmoidf_(a1[3]);
#pragma unroll
                    for (int e = 0; e < 8; ++e) ss += o[e] * o[e];
                    u4_t w; w.x = pkbf(o[0], o[1]); w.y = pkbf(o[2], o[3]); w.z = pkbf(o[4], o[5]); w.w = pkbf(o[6], o[7]);
                    *(u4_t*)(cat + (size_t)r * D_ + c) = w; }
                ss += __shfl_xor(ss, 16); ss += __shfl_xor(ss, 32); if (fq == 0) atomicAdd(ssq + r, ss);
                asm volatile("" ::: "memory"); }
    }
};
struct EpiBf16RowScale {
    static constexpr bool PERM = true;
    bf16_t* O; int ldc; float scale; const float* ssq;
    __device__ __forceinline__ void operator()(const f32x4 (&acc)[2][2][4][2], const pg8::Unit& u, int wr, int wc, int fr, int fq) const {
        const int row0 = u.orow + wr * 64 + fr, col0 = u.ocol + wc * 32 + 8 * fq;
#pragma unroll
        for (int ai = 0; ai < 2; ++ai)
#pragma unroll
            for (int m = 0; m < 4; ++m) { const int r = row0 + ai * 128 + m * 16; const float sc = rsqrtf(ssq[r] * (1.f / (float)D_) + RMS_EPS) * scale; bf16_t* rowp = O + (size_t)r * ldc + col0;
#pragma unroll
                for (int bj = 0; bj < 2; ++bj) { const f32x4 v0 = acc[ai][bj][m][0] * sc, v1 = acc[ai][bj][m][1] * sc;
                    u32x4 w; w.x = pg8::cvt_pk_bf16(v0[0], v0[1]); w.y = pg8::cvt_pk_bf16(v0[2], v0[3]); w.z = pg8::cvt_pk_bf16(v1[0], v1[1]); w.w = pg8::cvt_pk_bf16(v1[2], v1[3]);
                    *(u32x4*)(rowp + bj * 128) = w; } }
    }
};
struct EpiMoeUp {
    static constexpr bool PERM = true;
    bf16_t* hm;
    __device__ __forceinline__ void operator()(const f32x4 (&acc)[2][2][4][2], const pg8::Unit& u, int wr, int wc, int fr, int fq) const {
        const int row0 = u.orow + wr * 64 + fr, col0 = u.ocol + wc * 32 + 8 * fq;
#pragma unroll
        for (int ai = 0; ai < 2; ++ai)
#pragma unroll
            for (int m = 0; m < 4; ++m) { bf16_t* rowp = hm + (size_t)(row0 + ai * 128 + m * 16) * DE + col0;
                float h[8];
#pragma unroll
                for (int n = 0; n < 2; ++n)
#pragma unroll
                    for (int e = 0; e < 4; ++e) h[n * 4 + e] = siluf_(acc[ai][0][m][n][e]) * acc[ai][1][m][n][e];
                u32x4 w; w.x = pg8::cvt_pk_bf16(h[0], h[1]); w.y = pg8::cvt_pk_bf16(h[2], h[3]); w.z = pg8::cvt_pk_bf16(h[4], h[5]); w.w = pg8::cvt_pk_bf16(h[6], h[7]);
                *(u32x4*)rowp = w; }
    }
};

template <int NCOL> struct MoeOrder {
    const char* A; const char* W; const int* tab; int lda, wrows_per_expert, ldb, ocol_step, G, c;
    __device__ bool next(int i, pg8::Unit& u) const {
        const int L = i * G + c; if (L >= tab[0] * NCOL) return false;
        const int rt = L / NCOL, j = L % NCOL, e = tab[40 + rt];
        u.a = A + (size_t)rt * 256 * lda * 2; u.b = W + ((size_t)e * wrows_per_expert + j * 256) * ldb * 2; u.orow = rt * 256; u.ocol = j * ocol_step; u.aux = 0; return true;
    }
};

struct EpiF32Out {
    static constexpr bool PERM = false;
    float* O; int ldc; size_t aux_stride;
    __device__ __forceinline__ void operator()(const f32x4 (&acc)[2][2][4][2], const pg8::Unit& u, int wr, int wc, int fr, int fq) const {
        const int row0 = u.orow + wr * 64 + fr, col0 = u.ocol + wc * 32 + 4 * fq; float* base = O + (size_t)u.aux * aux_stride;
#pragma unroll
        for (int ai = 0; ai < 2; ++ai)
#pragma unroll
            for (int m = 0; m < 4; ++m) { float* rowp = base + (size_t)(row0 + ai * 128 + m * 16) * ldc + col0;
#pragma unroll
                for (int bj = 0; bj < 2; ++bj)
#pragma unroll
                    for (int n = 0; n < 2; ++n) *(f32x4*)(rowp + bj * 128 + n * 16) = acc[ai][bj][m][n]; }
    }
};
typedef float f32x2 __attribute__((ext_vector_type(2)));
__device__ __forceinline__ f32x2 gelu_pk(f32x2 v) {
    const f32x2 av = __builtin_elementwise_abs(v), d = av * 0.2316418882f + 1.0f;
    f32x2 t; t.x = __builtin_amdgcn_rcpf(d.x); t.y = __builtin_amdgcn_rcpf(d.y);
    f32x2 q = t * 0.5307027145f + (-0.7265760135f); q = q * t + 0.7107068705f; q = q * t + (-0.142248368f); q = q * t + 0.127414796f; q = q * t;
    const f32x2 s = (v * v) * (-0.72134752044f);
    f32x2 e; e.x = __builtin_amdgcn_exp2f(s.x); e.y = __builtin_amdgcn_exp2f(s.y);
    const f32x2 m = v * (q * e), r = v - m;
    f32x2 o; o.x = v.x < 0.f ? m.x : r.x; o.y = v.y < 0.f ? m.y : r.y; return o;
}
struct EpiS5Main {
    static constexpr bool PERM = true;
    bf16_t* gl;
    __device__ __forceinline__ void operator()(const f32x4 (&acc)[2][2][4][2], const pg8::Unit& u, int wr, int wc, int fr, int fq) const {
        const int row0 = u.orow + wr * 64 + fr, col0 = wc * 32 + 8 * fq, g = u.aux;
#pragma unroll
        for (int ai = 0; ai < 2; ++ai)
#pragma unroll
            for (int m = 0; m < 4; ++m) { const int n = row0 + ai * 128 + m * 16;
#pragma unroll
                for (int bj = 0; bj < 2; ++bj) { const int c = col0 + bj * 128, j = c >> 4, co = c & 15; const f32x4 v0 = acc[ai][bj][m][0], v1 = acc[ai][bj][m][1];
                    const f32x2 a = gelu_pk((f32x2){v0[0], v0[1]}), b = gelu_pk((f32x2){v0[2], v0[3]}), c2 = gelu_pk((f32x2){v1[0], v1[1]}), d2 = gelu_pk((f32x2){v1[2], v1[3]});
                    u32x4 w; w.x = pg8::cvt_pk_bf16(a.x, a.y); w.y = pg8::cvt_pk_bf16(b.x, b.y); w.z = pg8::cvt_pk_bf16(c2.x, c2.y); w.w = pg8::cvt_pk_bf16(d2.x, d2.y);
                    *(u32x4*)(gl + ((size_t)n * 16 + j) * S5W + g * 16 + co) = w; } }
    }
};
struct S5Order {
    const char* A; const char* Bm; int ldb, G, c;
    __device__ bool next(int i, pg8::Unit& u) const {
        const int L = i * G + c; if (L >= NG * 4) return false;
        const int g = L >> 2, pm = L & 3;
        u.a = A + ((size_t)g * 1024 + pm * 256) * 512 * 2; u.b = Bm + (size_t)g * 256 * ldb * 2; u.orow = pm * 256; u.ocol = 0; u.aux = g; return true;
    }
};
__device__ __forceinline__ void fp_s5estep(const Params& p, LAS unsigned char* lds, int G, int c) {
    S5Order S{(const char*)(p.ws + WS_AEXT), (const char*)p.out + OUT_EMAT, 256, G, c};
    EpiF32Out E{(float*)(p.ws + WS_HLOC), 256, (size_t)1024 * 256};
    pg8::gemm_phase(lds, 256, 512, 256, S, E);
}
__device__ __forceinline__ void fp_s5main(const Params& p, LAS unsigned char* lds, int G, int c) {
    S5Order S{(const char*)(p.ws + WS_AEXT), (const char*)p.out + OUT_MMAT, 512, G, c};
    EpiS5Main E{(bf16_t*)(p.ws + WS_GL)};
    pg8::gemm_phase(lds, 512, 512, 512, S, E);
}

__device__ __forceinline__ void fp_inproj(const Params& p, LAS unsigned char* lds) {
    pg8::DenseOrder S; S.init((const bf16_t*)(p.ws + WS_HB), D_, (const bf16_t*)((unsigned char*)p.out + OUT_WINT), D_, T_, NINP, gridDim.x, blockIdx.x);
    EpiInproj E{(bf16_t*)(p.ws + WS_QKVR), (bf16_t*)(p.ws + WS_ZB), (float*)((unsigned char*)p.out + OUT_BA), (bf16_t*)(p.ws + WS_AEXT)};
    pg8::gemm_phase(lds, D_, D_, D_, S, E);
}
__device__ __forceinline__ void fp_glu(const Params& p, LAS unsigned char* lds, int G, int c) {
    pg8::DenseOrder S; S.init((const bf16_t*)(p.ws + WS_GL), S5W, (const bf16_t*)((unsigned char*)p.out + OUT_WGLUT), S5W, T_, S5W, G, c);
    EpiGlu E{(const bf16_t*)(p.ws + WS_GL), p.in[I_B_GLU], (bf16_t*)(p.ws + WS_CAT), (float*)(p.ws + WS_SSQ)};
    pg8::gemm_phase(lds, S5W, S5W, S5W, S, E);
}
__device__ __forceinline__ void fp_outproj(const Params& p, LAS unsigned char* lds) {
    pg8::DenseOrder S; S.init((const bf16_t*)(p.ws + WS_CAT), D_, (const bf16_t*)(p.ws + WS_WOUTT), D_, T_, D_, gridDim.x, blockIdx.x);
    EpiResid E{p.in[I_X], nullptr, nullptr, D_, (bf16_t*)(p.ws + WS_XB), (float*)(p.ws + WS_SSQ) + T_};
    pg8::gemm_phase(lds, D_, D_, D_, S, E);
}
__device__ __forceinline__ void fp_kv(const Params& p, LAS unsigned char* lds) {
    {
        pg8::DenseOrder S; S.init((const bf16_t*)(p.ws + WS_MEMN), D_, (const bf16_t*)((unsigned char*)p.out + OUT_WKT), D_, B_ * MEM, D_, gridDim.x, (blockIdx.x + gridDim.x - 192) % gridDim.x);
        EpiBf16Out E{(bf16_t*)(p.ws + WS_KMEM), D_, 1.f, 0};
        pg8::gemm_phase(lds, D_, D_, D_, S, E);
    }
    {
        pg8::DenseOrder S; S.init((const bf16_t*)(p.ws + WS_MEMN), D_, (const bf16_t*)((unsigned char*)p.out + OUT_WVT), D_, B_ * MEM, D_, gridDim.x, (blockIdx.x + gridDim.x - 224) % gridDim.x);
        EpiBf16Out E{(bf16_t*)(p.ws + WS_VMEM), D_, 1.f, 0};
        pg8::gemm_phase(lds, D_, D_, D_, S, E);
    }
}
struct AttnPreOrder {
    const char* Kmem; const char* Vmem; const char* WqB; const char* WoT; int G, c;
    __device__ bool next(int i, pg8::Unit& u) const {
        const int L = i * G + c; if (L >= 256) return false;
        const int x = L & 3, h = (L >> 2) & 3, b = (L >> 4) & 7;
        if (L < 128) { u.a = Kmem + ((size_t)(b * MEM) * D_ + h * XD) * 2; u.b = WqB + ((size_t)(x * 256) * D_ + h * XD) * 2; u.orow = 0; u.ocol = x * 256; u.aux = b * 4 + h; }
        else { u.a = WoT + ((size_t)(x * 256) * D_ + h * XD) * 2; u.b = Vmem + ((size_t)(b * MEM) * D_ + h * XD) * 2; u.orow = x * 256; u.ocol = h * XD; u.aux = 64 + b; }
        return true;
    }
};
struct EpiAttnPre {
    static constexpr bool PERM = true;
    bf16_t* Mq; bf16_t* VWT;
    __device__ __forceinline__ void operator()(const f32x4 (&acc)[2][2][4][2], const pg8::Unit& u, int wr, int wc, int fr, int fq) const {
        bf16_t* base = (u.aux < 64) ? Mq + (size_t)u.aux * MEM * D_ : VWT + (size_t)(u.aux - 64) * D_ * D_;
        const int row0 = u.orow + wr * 64 + fr, col0 = u.ocol + wc * 32 + 8 * fq;
#pragma unroll
        for (int ai = 0; ai < 2; ++ai)
#pragma unroll
            for (int m = 0; m < 4; ++m) { bf16_t* rowp = base + (size_t)(row0 + ai * 128 + m * 16) * D_ + col0;
#pragma unroll
                for (int bj = 0; bj < 2; ++bj) { const f32x4 v0 = acc[ai][bj][m][0], v1 = acc[ai][bj][m][1];
                    u32x4 w; w.x = pg8::cvt_pk_bf16(v0[0], v0[1]); w.y = pg8::cvt_pk_bf16(v0[2], v0[3]); w.z = pg8::cvt_pk_bf16(v1[0], v1[1]); w.w = pg8::cvt_pk_bf16(v1[2], v1[3]);
                    *(u32x4*)(rowp + bj * 128) = w; } }
    }
};
__device__ __forceinline__ void fp_attn_pre(const Params& p, LAS unsigned char* lds) {
    AttnPreOrder S{(const char*)(p.ws + WS_KMEM), (const char*)(p.ws + WS_VMEM), (const char*)(p.ws + WS_WQB), (const char*)(p.ws + WS_WOT), (int)gridDim.x, (int)blockIdx.x};
    EpiAttnPre E{(bf16_t*)(p.ws + WS_MQ), (bf16_t*)(p.ws + WS_VWT)};
    pg8::gemm_phase(lds, XD, D_, D_, S, E);
}
struct AttnSOrder {
    const char* Xb; const char* Mq; int G, c;
    __device__ bool next(int i, pg8::Unit& u) const {
        const int L = i * G + c; if (L >= B_ * XH * 8) return false;
        const int pm = L & 7, h = (L >> 3) & 3, b = L >> 5;
        u.a = Xb + (size_t)(b * S_ + pm * 256) * D_ * 2; u.b = Mq + (size_t)((b * 4 + h) * MEM) * D_ * 2; u.orow = b * S_ + pm * 256; u.ocol = h * XD; u.aux = 0; return true;
    }
};
struct AttnWoOrder {
    const char* Pm; const char* VWT; int G, c;
    __device__ bool next(int i, pg8::Unit& u) const {
        const int L = i * G + c; if (L >= 256) return false;
        const int pn = L & 3, pm = (L >> 2) & 7, b = L >> 5;
        u.a = Pm + (size_t)(b * S_ + pm * 256) * D_ * 2; u.b = VWT + ((size_t)b * D_ + pn * 256) * D_ * 2; u.orow = b * S_ + pm * 256; u.ocol = pn * 256; u.aux = 0; return true;
    }
};
__device__ __forceinline__ void fp_attn_fused(const Params& p, LAS unsigned char* lds) {
    const int L = blockIdx.x; if (L >= B_ * XH * 8) return;
    {
        AttnSOrder S{(const char*)(p.ws + WS_XB), (const char*)(p.ws + WS_MQ), (int)gridDim.x, L};
        EpiBf16RowScale E{(bf16_t*)(p.ws + WS_PB), D_, 0.0625f, (const float*)(p.ws + WS_SSQ) + T_};
        pg8::gemm_phase(lds, D_, D_, D_, S, E);
    }
    {
        const int THR = ltid(); const int lane = THR & 63, wid = THR >> 6;
        const int pm = L & 7, h = (L >> 3) & 3, b = L >> 5;
        bf16_t* base = (bf16_t*)(p.ws + WS_PB) + (size_t)(b * S_ + pm * 256 + wid * 32 + (lane >> 4)) * D_ + h * XD + (lane & 15) * 16;
        u4_t ra[8], rb[8];
#pragma unroll
        for (int i = 0; i < 8; ++i) { ra[i] = *(const u4_t*)(base + (size_t)(4 * i) * D_); rb[i] = *(const u4_t*)(base + (size_t)(4 * i) * D_ + 8); }
#pragma unroll
        for (int i = 0; i < 8; ++i) {
            float v[16];
#pragma unroll
            for (int k = 0; k < 4; ++k) { v[2 * k] = bflo(ra[i][k]); v[2 * k + 1] = bfhi(ra[i][k]); v[8 + 2 * k] = bflo(rb[i][k]); v[9 + 2 * k] = bfhi(rb[i][k]); }
            float mx = v[0];
#pragma unroll
            for (int k = 1; k < 16; ++k) mx = fmaxf(mx, v[k]);
            mx = dpp_max16(mx);
            float sum = 0.f;
#pragma unroll
            for (int k = 0; k < 16; ++k) { v[k] = __expf(v[k] - mx); sum += v[k]; }
            const float inv = 1.f / dpp_sum16(sum);
            u4_t wa, wb;
#pragma unroll
            for (int k = 0; k < 4; ++k) { wa[k] = pkbf(v[2 * k] * inv, v[2 * k + 1] * inv); wb[k] = pkbf(v[8 + 2 * k] * inv, v[9 + 2 * k] * inv); }
            *(u4_t*)(base + (size_t)(4 * i) * D_) = wa; *(u4_t*)(base + (size_t)(4 * i) * D_ + 8) = wb; }
    }
}
__device__ __forceinline__ void fp_woproj(const Params& p, LAS unsigned char* lds) {
    AttnWoOrder S{(const char*)(p.ws + WS_PB), (const char*)(p.ws + WS_VWT), (int)gridDim.x, (int)blockIdx.x};
    EpiResid E{nullptr, (const bf16_t*)(p.ws + WS_XB), nullptr, D_, (bf16_t*)(p.ws + WS_XB), nullptr};
    pg8::gemm_phase(lds, D_, D_, D_, S, E);
}
constexpr int LDS_TAB_OFF = pg8::STAGE_BYTES;
__device__ __forceinline__ void fp_moeup(const Params& p, LAS unsigned char* lds, float* smem) {
    int* tab = (int*)((unsigned char*)smem + LDS_TAB_OFF); moe_build_table(p, tab);
    MoeOrder<2> S{(const char*)(p.ws + WS_XS), (const char*)(p.ws + WS_WGUT), tab, D_, 512, D_, 128, (int)gridDim.x, (int)blockIdx.x};
    EpiMoeUp E{(bf16_t*)(p.ws + WS_HM)};
    pg8::gemm_phase(lds, D_, D_, D_, S, E);
}
__device__ __forceinline__ void fp_moedown(const Params& p, LAS unsigned char* lds, float* smem) {
    int* tab = (int*)((unsigned char*)smem + LDS_TAB_OFF); moe_build_table(p, tab);
    MoeOrder<4> S{(const char*)(p.ws + WS_HM), (const char*)(p.ws + WS_WDT), tab, DE, D_, DE, 256, (int)gridDim.x, (int)blockIdx.x};
    EpiBf16Out E{(bf16_t*)(p.ws + WS_XS), D_, 1.f, 0};
    pg8::gemm_phase(lds, DE, DE, DE, S, E);
}


#define XB_TMO      128
#define XB_XCNT(j)  (256  + 64 * (j))
#define XB_XSUB(j)  (1280 + 64 * (j))
#define XB_XGEN(j)  (2304 + 64 * (j))
#define XB_TOP      3328
#define XB_TOPGEN   3392
#define XCD_BAR_WORDS 3456
#define XB_SPIN_CAP (1u << 18)
__device__ __forceinline__ unsigned xb_ld(unsigned* p)              { return __hip_atomic_load(p, __ATOMIC_RELAXED, __HIP_MEMORY_SCOPE_AGENT); }
__device__ __forceinline__ unsigned xb_add(unsigned* p, unsigned v) { return __hip_atomic_fetch_add(p, v, __ATOMIC_RELAXED, __HIP_MEMORY_SCOPE_AGENT); }
__device__ __forceinline__ unsigned xb_xcc_id() { return (unsigned)__builtin_amdgcn_s_getreg((3 << 11) | 20) & 0xFu; }
#define XB_SPIN(cond, bar) do { unsigned _sp = 0; while (cond) { __builtin_amdgcn_s_sleep(1); \
    if ((++_sp & 255u) == 0u) { if (xb_ld(&(bar)[XB_TMO])) break; if (_sp > XB_SPIN_CAP) { atomicAdd(&(bar)[XB_TMO], 1u); break; } } } } while (0)
struct XcdBarrier { unsigned* bar; unsigned x; volatile LAS unsigned* st; unsigned G; };
__device__ __forceinline__ XcdBarrier xcd_barrier_post(unsigned* bar, volatile LAS unsigned* st, unsigned G) {
    XcdBarrier b; b.bar = bar; b.x = xb_xcc_id(); b.st = st; b.G = G;
    if (threadIdx.x == 0) (void)xb_add(&bar[XB_XCNT(b.x)], 1u);
    return b;
}
__device__ __forceinline__ void xcd_barrier_complete(unsigned* bar, unsigned x, const unsigned G, unsigned& nloc, unsigned& nx) {
    unsigned sum, cnt, mine, sp = 0u;
    for (;;) {
        sum = 0u; cnt = 0u; mine = 0u;
#pragma unroll
        for (unsigned j = 0; j < 16; ++j) { const unsigned c = xb_ld(&bar[XB_XCNT(j)]); sum += c; cnt += (c > 0u) ? 1u : 0u; mine = (j == x) ? c : mine; }
        if (sum == G) break;
        __builtin_amdgcn_s_sleep(1);
        if ((++sp & 255u) == 0u) { if (xb_ld(&bar[XB_TMO])) break; if (sp > XB_SPIN_CAP) { atomicAdd(&bar[XB_TMO], 1u); break; } }
    }
    nloc = mine > 0u ? mine : 1u; nx = cnt > 0u ? cnt : 1u;
}
__device__ __forceinline__ void xcd_barrier(const XcdBarrier& b) {
    asm volatile("s_waitcnt vmcnt(0)" ::: "memory");
    __syncthreads();
    if (threadIdx.x == 0) {
        unsigned* bar = b.bar;
        __builtin_amdgcn_s_waitcnt(0);
        unsigned nloc = b.st[0], nx = b.st[1];
        if (nloc == 0u) { xcd_barrier_complete(bar, b.x, b.G, nloc, nx); b.st[0] = nloc; b.st[1] = nx; }
        const unsigned old = xb_add(&bar[XB_XSUB(b.x)], 1u);
        const unsigned gen = old / nloc;
        if (old + 1u == (gen + 1u) * nloc) {
            __builtin_amdgcn_fence(__ATOMIC_RELEASE, "agent");
            asm volatile("s_waitcnt vmcnt(0)" ::: "memory");
            (void)xb_add(&bar[XB_TOP], 1u);
        }
        const unsigned target = (gen + 1u) * nx;
        asm volatile("buffer_inv sc1" ::: "memory");
        XB_SPIN(xb_ld(&bar[XB_TOP]) < target, bar);
        asm volatile("s_waitcnt vmcnt(0)" ::: "memory");
        __builtin_amdgcn_fence(__ATOMIC_ACQUIRE, "workgroup");
    }
    __syncthreads();
}

constexpr int LDS_BYTES = 147456;
constexpr int LDS_BARST_OFF = LDS_BYTES - 16;

__global__ void __launch_bounds__(NT, 2) mega_fwd(Params p) {
    __shared__ __attribute__((aligned(16))) unsigned char lds_raw[LDS_BYTES];
    float* smem = (float*)lds_raw; LAS unsigned char* lds = (LAS unsigned char*)lds_raw;
    cg::grid_group grid = cg::this_grid();
    if (threadIdx.x < 4) ((LAS unsigned*)(lds + LDS_BARST_OFF))[threadIdx.x] = 0u;
    __syncthreads();
    const XcdBarrier bar = xcd_barrier_post((unsigned*)(p.ws + WS_BAR), (volatile LAS unsigned*)(lds + LDS_BARST_OFF), gridDim.x);
#define GSYNC() xcd_barrier(bar)
    constexpr int GDNB_BLOCKS = B_ * NH * 2 * 2; const int s5G = (int)gridDim.x - GDNB_BLOCKS, s5c = (int)blockIdx.x - GDNB_BLOCKS;
    XcdBarrier bar2 = bar;
    if (s5c >= 0) bar2 = xcd_barrier_post((unsigned*)(p.ws + WS_BAR) + 4096, (volatile LAS unsigned*)(lds + LDS_BARST_OFF) + 2, (unsigned)s5G);
    if (p.ws == nullptr) grid.sync();
    ph_norm1(p, smem); ph_memnorm(p, smem); ph_prep0(p, smem); ph_s5mat(p, smem);  GSYNC();
    fp_inproj(p, lds); fp_kv(p, lds);  GSYNC();
    ph_prepa(p, smem); __syncthreads(); ph_gdna(p, smem);    GSYNC();
    if (s5c < 0) ph_gdnb(p, smem);
    else {
        for (int L = s5c; L < NG * 4; L += s5G) { fp_s5estep(p, lds, NG * 4, L); s5carry_unit(p, L >> 2, L & 3); fp_s5main(p, lds, NG * 4, L); }
        xcd_barrier(bar2); fp_glu(p, lds, s5G, s5c); }
    GSYNC();
    ph_gdncomb(p, smem); ph_prep1(p, smem); __syncthreads(); fp_attn_pre(p, lds); GSYNC();
    fp_outproj(p, lds); ph_prep2(p, smem); GSYNC();
    fp_attn_fused(p, lds); GSYNC();
    fp_woproj(p, lds);   GSYNC();
    ph_router(p, smem, bar);  GSYNC();
    fp_moeup(p, lds, smem);   GSYNC();
    fp_moedown(p, lds, smem); GSYNC();
    ph_final(p, smem);
}

extern "C" void kernel_launch(void* const* d_in, const int* in_sizes, int n_in, void* d_out, int out_size, void* d_ws, size_t ws_size, hipStream_t stream) {
    if (n_in != N_IN || out_size != T_ * D_ || ws_size < 256 * MiB) { fprintf(stderr, "kernel_launch: unexpected shapes n_in=%d out=%d ws=%zu\n", n_in, out_size, ws_size); return; }
    static int grid_blocks = 0;
    if (!grid_blocks) {
        int dev = 0, cus = 0, per_cu = 0;
        (void)hipGetDevice(&dev);
        (void)hipDeviceGetAttribute(&cus, hipDeviceAttributeMultiprocessorCount, dev);
        (void)hipOccupancyMaxActiveBlocksPerMultiprocessor(&per_cu, mega_fwd, NT, 0);
        if (per_cu < 1) { fprintf(stderr, "kernel_launch: occupancy query says %d blocks/CU\n", per_cu); per_cu = 1; }
        grid_blocks = cus;
    }
    Params p{};
    for (int i = 0; i < N_IN; ++i) p.in[i] = (const float*)d_in[i];
    p.out = (float*)d_out; p.ws = (unsigned char*)d_ws;
    (void)hipMemsetAsync((unsigned char*)d_ws + WS_BAR, 0, (4096 + XCD_BAR_WORDS) * 4, stream);
    void* args[] = {&p};
    hipError_t e = hipLaunchCooperativeKernel((void*)mega_fwd, dim3(grid_blocks), dim3(NT), args, 0, stream);
    if (e != hipSuccess) fprintf(stderr, "cooperative launch failed: %s (grid %d)\n", hipGetErrorString(e), grid_blocks);
}
```
